# Optimizing an MI355X kernel written in HIP

```python
import math
import jax, jax.numpy as jnp
from jax import lax
import numpy as np

D_MODEL = 1024
BATCH = 8
SEQ = 2048
DEPTH = 1
DEC_BATCH = 32
DEC_SEQ = 64
PAST_LEN = 2048

CHUNK = 64
N_HEADS = 16
HEAD_DIM = 64
N_KV_HEADS = 4
Q_PER_KV = N_HEADS // N_KV_HEADS
IDX_HEADS = 8
IDX_DIM = 64
TOPK_MAX = 256
QBLK = 128
ROPE_THETA = 10000.0
D_INNER = 2 * D_MODEL
SSM_HEAD_DIM = 64
SSM_HEADS = D_INNER // SSM_HEAD_DIM
SSM_GROUPS = 8
D_STATE = 128
CONV_W = 4
CONV_CH = D_INNER + 2 * SSM_GROUPS * D_STATE
SSD_CHUNK = CHUNK
D_FF = -(-8 * D_MODEL // (3 * 256)) * 256
EPS = 1e-6
IN_SIZES = (N_HEADS * HEAD_DIM, N_KV_HEADS * HEAD_DIM, N_KV_HEADS * HEAD_DIM, IDX_HEADS * IDX_DIM, IDX_DIM, IDX_HEADS, D_INNER, CONV_CH, SSM_HEADS, 2 * D_MODEL)
IN_DIM = sum(IN_SIZES)

kernel_name = 'dsa_ssd_hybrid_stream_step'


def rms_normalize(x):
    x32 = x.astype(jnp.float32)
    return (x32 * lax.rsqrt(jnp.mean(x32 * x32, axis=-1, keepdims=True) + EPS)).astype(x.dtype)


def rope(x, pos):
    half = x.shape[-1] // 2
    inv = ROPE_THETA ** (-jnp.arange(half, dtype=jnp.float32) / half)
    ang = pos.astype(jnp.float32)[:, None] * inv[None, :]
    cos = jnp.cos(ang)[:, None, :].astype(x.dtype)
    sin = jnp.sin(ang)[:, None, :].astype(x.dtype)
    x1, x2 = x[..., :half], x[..., half:]
    return jnp.concatenate([x1 * cos - x2 * sin, x2 * cos + x1 * sin], axis=-1)


def dsa_attention(q, qi, wi, qpos, k_all, v_all, ki_all):
    t = q.shape[1]
    n_keys = k_all.shape[1]
    topk = min(TOPK_MAX, n_keys // 4)
    qb = min(QBLK, t)
    nb = t // qb
    kpos = jnp.arange(n_keys)
    qpos_blocks = qpos.reshape(nb, qb)

    def one_seq(args):
        q_s, qi_s, wi_s, k_s, v_s, ki_s = args

        def one_block(bargs):
            qq, qqi, ww, pp = bargs
            logits = jnp.einsum('thd,sd->ths', qqi, ki_s).astype(jnp.float32) * (IDX_DIM ** -0.5)
            score = jnp.einsum('th,ths->ts', ww.astype(jnp.float32), jax.nn.relu(logits))
            limit = (pp // CHUNK + 1) * CHUNK
            score = jnp.where(kpos[None, :] < limit[:, None], score, -jnp.inf)
            _, idx = lax.top_k(score, topk)
            valid = idx < limit[:, None]
            ks = k_s[idx]
            vs = v_s[idx]
            qg = qq.reshape(qb, N_KV_HEADS, Q_PER_KV, HEAD_DIM)
            s = jnp.einsum('tkgd,tjkd->tkgj', qg, ks).astype(jnp.float32) * (HEAD_DIM ** -0.5)
            s = jnp.where(valid[:, None, None, :], s, -jnp.inf)
            p = jax.nn.softmax(s, axis=-1).astype(vs.dtype)
            return jnp.einsum('tkgj,tjkd->tkgd', p, vs).reshape(qb, N_HEADS * HEAD_DIM)

        out = lax.map(one_block, (q_s.reshape(nb, qb, N_HEADS, HEAD_DIM), qi_s.reshape(nb, qb, IDX_HEADS, IDX_DIM), wi_s.reshape(nb, qb, IDX_HEADS), qpos_blocks))
        return out.reshape(t, N_HEADS * HEAD_DIM)

    return lax.map(one_seq, (q, qi, wi, k_all, v_all, ki_all))


def causal_conv(full, w_conv, b_conv, t):
    out = b_conv
    for j in range(CONV_W):
        out = out + full[:, j:j + t] * w_conv[j]
    return out


def ssd_scan(x, dt, a, bm, cm, h0, chunk):
    b, l, nh, hp = x.shape
    g, n = bm.shape[2], bm.shape[3]
    r = nh // g
    nc = l // chunk
    xc = x.reshape(b, nc, chunk, g, r, hp)
    dtc = dt.reshape(b, nc, chunk, g, r)
    bc = bm.reshape(b, nc, chunk, g, n)
    cc = cm.reshape(b, nc, chunk, g, n)
    acs = jnp.cumsum(dtc * a.reshape(g, r), axis=2)
    diff = acs[:, :, :, None] - acs[:, :, None, :]
    causal = jnp.tril(jnp.ones((chunk, chunk), dtype=bool))[:, :, None, None]
    decay = jnp.exp(jnp.where(causal, diff, -jnp.inf))
    cb = jnp.einsum('bcign,bcjgn->bcijg', cc, bc)
    y_diag = jnp.einsum('bcijg,bcijgr,bcjgr,bcjgrp->bcigrp', cb, decay, dtc, xc)
    w_state = jnp.exp(acs[:, :, -1:] - acs) * dtc
    states = jnp.einsum('bcjgn,bcjgr,bcjgrp->bcgrpn', bc, w_state, xc)
    chunk_decay = jnp.exp(acs[:, :, -1])

    def step(h, inp):
        dec, st = inp
        return dec[..., None, None] * h + st, h

    h_last, h_prev = lax.scan(step, h0.reshape(b, g, r, hp, n), (jnp.transpose(chunk_decay, (1, 0, 2, 3)), jnp.transpose(states, (1, 0, 2, 3, 4, 5))))
    h_prev = jnp.transpose(h_prev, (1, 0, 2, 3, 4, 5))
    y_off = jnp.einsum('bcign,bcigr,bcgrpn->bcigrp', cc, jnp.exp(acs), h_prev)
    y = (y_diag + y_off).reshape(b, l, nh, hp)
    return y, h_last.reshape(b, nh, hp, n)


def layer(x, c, cache_k, cache_v, cache_ki, state_conv, state_ssm, w_ada, b_ada, g_norm_mix, g_norm_ffn, w_in, g_q, g_k, w_conv, b_conv, dt_bias, a_log, d_skip, g_ssm_norm, w_branch_attn, w_branch_ssm, w_out, w_gate_up, w_down):
    b, t, _ = x.shape
    pos = cache_k.shape[1] + jnp.arange(t)
    mod = (jax.nn.silu(c) @ w_ada + b_ada)[:, None, :]
    sh1, sc1, gt1, sh2, sc2, gt2 = jnp.split(mod, 6, axis=-1)
    h = rms_normalize(x) * g_norm_mix * (1.0 + sc1) + sh1
    offs = np.cumsum(IN_SIZES)[:-1].tolist()
    q, k, v, qi, ki, wi, z, xbc, dt, gate_logits = jnp.split(h @ w_in, offs, axis=-1)
    q = rope(rms_normalize(q.reshape(b, t, N_HEADS, HEAD_DIM)) * g_q, pos)
    k = rope(rms_normalize(k.reshape(b, t, N_KV_HEADS, HEAD_DIM)) * g_k, pos)
    v = v.reshape(b, t, N_KV_HEADS, HEAD_DIM)
    qi = rope(qi.reshape(b, t, IDX_HEADS, IDX_DIM), pos)
    ki = rope(ki[:, :, None, :], pos)[:, :, 0, :]
    wi = wi * (IDX_HEADS ** -0.5)
    o_attn = dsa_attention(q, qi, wi, pos, jnp.concatenate([cache_k, k], axis=1), jnp.concatenate([cache_v, v], axis=1), jnp.concatenate([cache_ki, ki], axis=1))
    full = jnp.concatenate([state_conv, xbc], axis=1)
    xbc_c = jax.nn.silu(causal_conv(full, w_conv, b_conv, t))
    xs, bm, cm = jnp.split(xbc_c, [D_INNER, D_INNER + SSM_GROUPS * D_STATE], axis=-1)
    xh = xs.reshape(b, t, SSM_HEADS, SSM_HEAD_DIM)
    dtp = jax.nn.softplus((dt + dt_bias).astype(jnp.float32))
    y, h_last = ssd_scan(xh.astype(jnp.float32), dtp, -jnp.exp(a_log.astype(jnp.float32)), bm.reshape(b, t, SSM_GROUPS, D_STATE).astype(jnp.float32), cm.reshape(b, t, SSM_GROUPS, D_STATE).astype(jnp.float32), state_ssm.astype(jnp.float32), min(SSD_CHUNK, t))
    y = (y.astype(x.dtype) + d_skip[:, None] * xh).reshape(b, t, D_INNER) * jax.nn.silu(z)
    y = rms_normalize(y.reshape(b, t, SSM_GROUPS, D_INNER // SSM_GROUPS)).reshape(b, t, D_INNER) * g_ssm_norm
    g_attn, g_ssm = jnp.split(jax.nn.sigmoid(gate_logits), 2, axis=-1)
    mixed = (g_attn * (o_attn @ w_branch_attn) + g_ssm * (y @ w_branch_ssm)) @ w_out
    x = x + gt1 * mixed
    h2 = rms_normalize(x) * g_norm_ffn * (1.0 + sc2) + sh2
    gate, up = jnp.split(h2 @ w_gate_up, 2, axis=-1)
    x = x + gt2 * ((jax.nn.silu(gate) * up) @ w_down)
    return x, k, v, ki, full[:, -(CONV_W - 1):], h_last.astype(x.dtype)


def setup_inputs(seed: int = 0) -> dict:
    key = jax.random.key(seed)
    ks = iter(jax.random.split(key, 40))
    f32 = jnp.float32

    def nrm(shape, scale):
        return jax.random.normal(next(ks), shape, f32) * scale

    def gain(shape):
        return 1.0 + nrm(shape, 0.02)

    dt0 = jnp.exp(jax.random.uniform(next(ks), (DEPTH, SSM_HEADS), f32, math.log(1e-3), math.log(1e-1)))
    dt_bias = dt0 + jnp.log(-jnp.expm1(-dt0))
    a_log = jnp.log(jax.random.uniform(next(ks), (DEPTH, SSM_HEADS), f32, 1.0, 16.0))
    return {
        'x_prompt': nrm((BATCH, SEQ, D_MODEL), 1.0),
        'x_sample': nrm((DEC_BATCH, DEC_SEQ, D_MODEL), 1.0),
        'cache_k': nrm((DEPTH, DEC_BATCH, PAST_LEN, N_KV_HEADS, HEAD_DIM), 1.0),
        'cache_v': nrm((DEPTH, DEC_BATCH, PAST_LEN, N_KV_HEADS, HEAD_DIM), 1.0),
        'cache_ki': nrm((DEPTH, DEC_BATCH, PAST_LEN, IDX_DIM), 1.0),
        'state_conv': nrm((DEPTH, DEC_BATCH, CONV_W - 1, CONV_CH), 1.0),
        'state_ssm': nrm((DEPTH, DEC_BATCH, SSM_HEADS, SSM_HEAD_DIM, D_STATE), 0.1),
        'c_prompt': nrm((BATCH, D_MODEL), 1.0),
        'c_sample': nrm((DEC_BATCH, D_MODEL), 1.0),
        'w_ada': nrm((DEPTH, D_MODEL, 6 * D_MODEL), 0.5 * D_MODEL ** -0.5),
        'b_ada': nrm((DEPTH, 6 * D_MODEL), 0.02),
        'g_norm_mix': gain((DEPTH, D_MODEL)),
        'g_norm_ffn': gain((DEPTH, D_MODEL)),
        'w_in': nrm((DEPTH, D_MODEL, IN_DIM), D_MODEL ** -0.5),
        'g_q': gain((DEPTH, HEAD_DIM)),
        'g_k': gain((DEPTH, HEAD_DIM)),
        'w_conv': nrm((DEPTH, CONV_W, CONV_CH), CONV_W ** -0.5),
        'b_conv': nrm((DEPTH, CONV_CH), 0.02),
        'dt_bias': dt_bias,
        'a_log': a_log,
        'd_skip': gain((DEPTH, SSM_HEADS)),
        'g_ssm_norm': gain((DEPTH, D_INNER)),
        'w_branch_attn': nrm((DEPTH, N_HEADS * HEAD_DIM, D_MODEL), (N_HEADS * HEAD_DIM) ** -0.5),
        'w_branch_ssm': nrm((DEPTH, D_INNER, D_MODEL), D_INNER ** -0.5),
        'w_out': nrm((DEPTH, D_MODEL, D_MODEL), D_MODEL ** -0.5),
        'w_gate_up': nrm((DEPTH, D_MODEL, 2 * D_FF), D_MODEL ** -0.5),
        'w_down': nrm((DEPTH, D_FF, D_MODEL), D_FF ** -0.5),
    }


def reference(x_prompt, x_sample, cache_k, cache_v, cache_ki, state_conv, state_ssm, c_prompt, c_sample, w_ada, b_ada, g_norm_mix, g_norm_ffn, w_in, g_q, g_k, w_conv, b_conv, dt_bias, a_log, d_skip, g_ssm_norm, w_branch_attn, w_branch_ssm, w_out, w_gate_up, w_down):
    bp = x_prompt.shape[0]
    dtype = x_prompt.dtype
    y_p, y_s = x_prompt, x_sample
    new_p = [[], [], [], [], []]
    new_s = [[], [], [], [], []]
    for l in range(DEPTH):
        lw = (w_ada[l], b_ada[l], g_norm_mix[l], g_norm_ffn[l], w_in[l], g_q[l], g_k[l], w_conv[l], b_conv[l], dt_bias[l], a_log[l], d_skip[l], g_ssm_norm[l], w_branch_attn[l], w_branch_ssm[l], w_out[l], w_gate_up[l], w_down[l])
        y_p, *st_p = layer(y_p, c_prompt, jnp.zeros((bp, 0, N_KV_HEADS, HEAD_DIM), dtype), jnp.zeros((bp, 0, N_KV_HEADS, HEAD_DIM), dtype), jnp.zeros((bp, 0, IDX_DIM), dtype), jnp.zeros((bp, CONV_W - 1, CONV_CH), dtype), jnp.zeros((bp, SSM_HEADS, SSM_HEAD_DIM, D_STATE), dtype), *lw)
        y_s, *st_s = layer(y_s, c_sample, cache_k[l], cache_v[l], cache_ki[l], state_conv[l], state_ssm[l], *lw)
        for acc, a in zip(new_p, st_p):
            acc.append(a)
        for acc, a in zip(new_s, st_s):
            acc.append(a)
    return (y_p, y_s, jnp.stack(new_p[0]), jnp.stack(new_p[1]), jnp.stack(new_p[2]), jnp.stack(new_p[3]), jnp.stack(new_p[4]), jnp.stack(new_s[0]), jnp.stack(new_s[1]), jnp.stack(new_s[2]), jnp.stack(new_s[3]), jnp.stack(new_s[4]))
```

```cpp
#include <hip/hip_runtime.h>
#include <hip/hip_cooperative_groups.h>
#include <cstdio>
#include <cstdint>
namespace cg = cooperative_groups;

namespace pg8 {
#define PG8_LAS __attribute__((address_space(3)))
typedef unsigned short bf16_t;
typedef short bf16x8 __attribute__((ext_vector_type(8)));
typedef float f32x4 __attribute__((ext_vector_type(4)));
typedef unsigned u32x4 __attribute__((ext_vector_type(4)));
constexpr int BM = 256, BK = 64, HALF = 128, HTB = HALF * BK * 2  , STAGE_BYTES = 8 * HTB, NXCD = 8, WGM = 8;

__host__ __device__ __forceinline__ int lds_byte(int r, int c) { const int st = (r >> 4) * 2 + (c >> 5), rr = r & 15, cc = c & 31, ob = rr * 64 + cc * 2; return st * 1024 + (ob ^ (((ob >> 9) & 1) << 5)); }
__host__ __device__ __forceinline__ void stage_rc(int b, int& R, int& C) { const int st = b / 1024, sb = b % 1024, swz = sb ^ (((sb >> 9) & 1) << 5); R = (st >> 1) * 16 + swz / 64; C = (st & 1) * 32 + (swz % 64) / 2; }
__host__ __device__ __forceinline__ int perm32(int rho) { const int n = rho >> 4, i = rho & 15; return 8 * (i >> 2) + 4 * n + (i & 3); }

struct Unit { int pm, pn; };
struct Gemm { const bf16_t* A; const bf16_t* Bt; int M, N, K; int ld = 0; int ncol = 0; };

struct StaticOrder {
    int nM, nN, nwg, G, c;
    __host__ __device__ void init(int M, int N, int G_, int c_) { nM = M / BM; nN = N / BM; nwg = nM * nN; G = G_; c = c_; }
    __host__ __device__ bool next(int i, Unit& u) const {
        const long L = (long)i * G + c; if (L >= nwg) return false;
        int wgid = (int)L; { const int q = nwg / NXCD, r = nwg % NXCD, xcd = wgid % NXCD, off = wgid / NXCD; wgid = (xcd < r ? xcd * (q + 1) : r * (q + 1) + (xcd - r) * q) + off; }
        const int nig = WGM * nN, gid = wgid / nig, fm = gid * WGM, gsz = (nM - fm) < WGM ? (nM - fm) : WGM;
        u.pm = fm + ((wgid % nig) % gsz); u.pn = (wgid % nig) / gsz; return true;
    }
    __device__ __forceinline__ void a_ready(const Unit&) const {}
    __device__ __forceinline__ void done(const Unit&) const {}
};
typedef float f32x2_t __attribute__((ext_vector_type(2)));
typedef __bf16 bf16x2_t __attribute__((ext_vector_type(2)));
__device__ __forceinline__ unsigned cvt_pk_bf16(float lo, float hi) { const bf16x2_t r = __builtin_convertvector((f32x2_t){lo, hi}, bf16x2_t); unsigned u; __builtin_memcpy(&u, &r, 4); return u; }
template <class Epi, class Sched, bool ALIGN_EPI = false, bool SP2 = false>
__device__ __forceinline__ void gemm_phase(PG8_LAS unsigned char* lds, const Gemm g, const Sched& S, const Epi& E) {
    const int tid = threadIdx.x, wid = __builtin_amdgcn_readfirstlane(tid >> 6), lane = tid & 63, wr = wid >> 2, wc = wid & 3, fr = lane & 15, fq = lane >> 4;
    const int K = g.ld ? g.ld : g.K, nt = g.K / BK;
    const int ncol = g.ncol ? g.ncol : (1 << 30); const size_t ksplit = (size_t)g.K * 2;
    unsigned voffA[2], voffB[2];
#pragma unroll
    for (int i = 0; i < 2; ++i) { int R, C; stage_rc(tid * 16 + i * 8192, R, C); const int Rb = Epi::PERM ? ((R & ~31) + perm32(R & 31)) : R;
        voffA[i] = (unsigned)(R * K + C) * 2u; voffB[i] = (unsigned)(Rb * K + C) * 2u; }
    const size_t kstep = (size_t)(BK * 2);
    const size_t hstep = (size_t)HALF * K * 2;
    const size_t tstep = 2 * hstep;
    const unsigned ldsw = (unsigned)wid * 1024u;
    const int aoff = lds_byte(wr * 64 + fr, fq * 8), boff = lds_byte(wc * 32 + fr, fq * 8);
#define PG8_SA(b, h) (((b) * 2 + (h)) * HTB)
#define PG8_SB(b, h) ((4 + (b) * 2 + (h)) * HTB)
#define PG8_STAGE(bufoff, gbase, voff) do { _Pragma("unroll") for (int _i = 0; _i < 2; ++_i) \
        __builtin_amdgcn_global_load_lds((const unsigned*)((const char*)(gbase) + (voff)[_i]), (PG8_LAS unsigned*)(lds + (bufoff) + ldsw + _i * 8192), 16, 0, 0); } while (0)
#define PG8_LDA(dst, b, h) do { _Pragma("unroll") for (int m = 0; m < 4; ++m) _Pragma("unroll") for (int k = 0; k < 2; ++k) dst[m][k] = *(const PG8_LAS bf16x8*)(lds + PG8_SA(b, h) + aoff + m * 2048 + k * 1024); } while (0)
#define PG8_LDB(dst, b, h) do { _Pragma("unroll") for (int n = 0; n < 2; ++n) _Pragma("unroll") for (int k = 0; k < 2; ++k) dst[n][k] = *(const PG8_LAS bf16x8*)(lds + PG8_SB(b, h) + boff + n * 2048 + k * 1024); } while (0)
#define PG8_MMA(ai, bj, At, Bt) do { __builtin_amdgcn_s_setprio(1); _Pragma("unroll") for (int m = 0; m < 4; ++m) _Pragma("unroll") for (int n = 0; n < 2; ++n) _Pragma("unroll") for (int k = 0; k < 2; ++k) \
        acc[ai][bj][m][n] = __builtin_amdgcn_mfma_f32_16x16x32_bf16(Bt[n][k], At[m][k], acc[ai][bj][m][n], 0, 0, 0); __builtin_amdgcn_s_setprio(0); } while (0)
#define PG8_WAIT_V(n) asm volatile("s_waitcnt vmcnt(" #n ")" ::: "memory")
#define PG8_WAIT_L(n) asm volatile("s_waitcnt lgkmcnt(" #n ")" ::: "memory")
#define PG8_BAR __builtin_amdgcn_s_barrier()
#define PG8_SCHED __builtin_amdgcn_sched_barrier(0)
    Unit cur, nxt; int ui = 0;
    if (!S.next(0, cur)) return;
    f32x4 acc[2][2][4][2];
#pragma unroll
    for (int a = 0; a < 2; ++a)
#pragma unroll
        for (int b = 0; b < 2; ++b)
#pragma unroll
            for (int m = 0; m < 4; ++m)
#pragma unroll
                for (int n = 0; n < 2; ++n) acc[a][b][m][n] = (f32x4){0.f, 0.f, 0.f, 0.f};
    bf16x8 At[4][2], B0[2][2], B1[2][2];
    const char* cA = (const char*)g.A + (size_t)cur.pm * tstep + (size_t)(cur.pn / ncol) * ksplit; const char* cB = (const char*)g.Bt + (size_t)(cur.pn % ncol) * tstep + (size_t)(cur.pn / ncol) * ksplit;
    S.a_ready(cur);
    if constexpr (SP2) {
        PG8_STAGE(PG8_SB(0, 0), cB, voffB); PG8_STAGE(PG8_SB(0, 1), cB + hstep, voffB); PG8_STAGE(PG8_SA(0, 0), cA, voffA); PG8_STAGE(PG8_SA(0, 1), cA + hstep, voffA);
        if (wr == 1) PG8_BAR;
        PG8_WAIT_V(2); PG8_BAR;
        PG8_STAGE(PG8_SB(1, 0), cB + kstep, voffB); PG8_STAGE(PG8_SA(1, 0), cA + kstep, voffA); PG8_STAGE(PG8_SB(1, 1), cB + hstep + kstep, voffB);
        PG8_WAIT_V(6); PG8_BAR;
    } else {
        PG8_STAGE(PG8_SB(0, 0), cB, voffB); PG8_STAGE(PG8_SA(0, 0), cA, voffA); PG8_STAGE(PG8_SB(0, 1), cB + hstep, voffB); PG8_STAGE(PG8_SA(0, 1), cA + hstep, voffA);
        if (wr == 1) PG8_BAR;
        PG8_WAIT_V(4); PG8_BAR;
        PG8_STAGE(PG8_SB(1, 0), cB + kstep, voffB); PG8_STAGE(PG8_SA(1, 0), cA + kstep, voffA); PG8_STAGE(PG8_SB(1, 1), cB + hstep + kstep, voffB);
        PG8_WAIT_V(6); PG8_BAR;
    }
    for (;;) {
        const bool has_next = S.next(ui + 1, nxt);
        const char* nA = has_next ? (const char*)g.A + (size_t)nxt.pm * tstep + (size_t)(nxt.pn / ncol) * ksplit : cA; const char* nB = has_next ? (const char*)g.Bt + (size_t)(nxt.pn % ncol) * tstep + (size_t)(nxt.pn / ncol) * ksplit : cB;
        for (int t = 0; t < nt; t += 2) {
            const bool last = (t == nt - 2);
            const char* a1 = cA + (size_t)(t + 1) * kstep;
            const char* a2 = last ? nA : cA + (size_t)(t + 2) * kstep; const char* b2 = last ? nB : cB + (size_t)(t + 2) * kstep;
            const char* a3 = a2 + kstep; const char* b3 = b2 + kstep;
            if (last && has_next) S.a_ready(nxt);
            if constexpr (SP2) {
            PG8_LDB(B0, 0, 0); PG8_LDB(B1, 0, 1); PG8_SCHED; PG8_LDA(At, 0, 0); PG8_STAGE(PG8_SA(1, 1), a1 + hstep, voffA);
            PG8_WAIT_V(8); PG8_WAIT_L(0); PG8_BAR; PG8_MMA(0, 0, At, B0); PG8_MMA(0, 1, At, B1); PG8_BAR; PG8_SCHED;
            PG8_LDA(At, 0, 1); PG8_STAGE(PG8_SB(0, 0), b2, voffB); PG8_STAGE(PG8_SB(0, 1), b2 + hstep, voffB); PG8_STAGE(PG8_SA(0, 0), a2, voffA);
            PG8_WAIT_V(8); PG8_WAIT_L(0); PG8_BAR; PG8_MMA(1, 0, At, B0); PG8_MMA(1, 1, At, B1); PG8_BAR; PG8_SCHED;
            PG8_LDB(B0, 1, 0); PG8_LDB(B1, 1, 1); PG8_SCHED; PG8_LDA(At, 1, 0); PG8_STAGE(PG8_SA(0, 1), a2 + hstep, voffA);
            PG8_WAIT_V(8); PG8_WAIT_L(0); PG8_BAR; PG8_MMA(0, 0, At, B0); PG8_MMA(0, 1, At, B1); PG8_BAR; PG8_SCHED;
            PG8_LDA(At, 1, 1); PG8_STAGE(PG8_SB(1, 0), b3, voffB); PG8_STAGE(PG8_SB(1, 1), b3 + hstep, voffB); PG8_STAGE(PG8_SA(1, 0), a3, voffA);
            PG8_WAIT_V(8); PG8_WAIT_L(0); PG8_BAR; PG8_MMA(1, 0, At, B0); PG8_MMA(1, 1, At, B1); PG8_BAR; PG8_SCHED;
            } else {
            PG8_LDB(B0, 0, 0); PG8_SCHED; PG8_LDA(At, 0, 0); PG8_STAGE(PG8_SA(1, 1), a1 + hstep, voffA);
            PG8_WAIT_L(8); PG8_BAR; PG8_WAIT_L(0); PG8_MMA(0, 0, At, B0); PG8_BAR; PG8_SCHED;
            PG8_LDB(B1, 0, 1); PG8_STAGE(PG8_SB(0, 0), b2, voffB);
            PG8_BAR; PG8_WAIT_L(0); PG8_MMA(0, 1, At, B1); PG8_BAR;
            PG8_LDA(At, 0, 1); PG8_STAGE(PG8_SA(0, 0), a2, voffA);
            PG8_BAR; PG8_WAIT_L(0); PG8_MMA(1, 0, At, B0); PG8_BAR; PG8_SCHED;
            PG8_STAGE(PG8_SB(0, 1), b2 + hstep, voffB);
            PG8_WAIT_V(6); PG8_BAR; PG8_MMA(1, 1, At, B1); PG8_BAR;
            PG8_LDB(B0, 1, 0); PG8_SCHED; PG8_LDA(At, 1, 0); PG8_STAGE(PG8_SA(0, 1), a2 + hstep, voffA);
            PG8_WAIT_L(8); PG8_BAR; PG8_WAIT_L(0); PG8_MMA(0, 0, At, B0); PG8_BAR; PG8_SCHED;
            PG8_LDB(B1, 1, 1); PG8_STAGE(PG8_SB(1, 0), b3, voffB);
            PG8_BAR; PG8_WAIT_L(0); PG8_MMA(0, 1, At, B1); PG8_BAR;
            PG8_LDA(At, 1, 1); PG8_STAGE(PG8_SA(1, 0), a3, voffA);
            PG8_BAR; PG8_WAIT_L(0); PG8_MMA(1, 0, At, B0); PG8_BAR; PG8_SCHED;
            PG8_STAGE(PG8_SB(1, 1), b3 + hstep, voffB);
            PG8_WAIT_V(6); PG8_BAR; PG8_MMA(1, 1, At, B1); PG8_BAR;
            }
        }
        if constexpr (ALIGN_EPI) { if (wr == 0) PG8_BAR; }
        if constexpr (!Epi::AFTER_DRAIN) { E(acc, cur, wr, wc, fr, fq); S.done(cur); }
        if (!has_next) break;
#pragma unroll
        for (int a = 0; a < 2; ++a)
#pragma unroll
            for (int b = 0; b < 2; ++b)
#pragma unroll
                for (int m = 0; m < 4; ++m)
#pragma unroll
                    for (int n = 0; n < 2; ++n) acc[a][b][m][n] = (f32x4){0.f, 0.f, 0.f, 0.f};
        cur = nxt; cA = nA; cB = nB; ++ui;
        if constexpr (ALIGN_EPI) { if (wr == 1) PG8_BAR; }
    }
    PG8_WAIT_V(0);
    if constexpr (!ALIGN_EPI) { if (wr == 0) PG8_BAR; }
    PG8_BAR;
    if constexpr (Epi::AFTER_DRAIN) { E.fused(acc, cur, wr, wc, fr, fq, lds, wid, lane); S.done(cur); }
#undef PG8_SA
#undef PG8_SB
#undef PG8_STAGE
#undef PG8_LDA
#undef PG8_LDB
#undef PG8_MMA
#undef PG8_WAIT_V
#undef PG8_WAIT_L
#undef PG8_BAR
#undef PG8_SCHED
}
}

constexpr int DM = 1024, NBP = 8, SEQ = 2048, NBS = 32, DSEQ = 64, PAST = 2048;
constexpr int TP = NBP * SEQ, TS = NBS * DSEQ, TT = TP + TS;
constexpr int NKP = 2048, NKS = 2112;
constexpr int DFF = 2816, DINNER = 2048, CONVC = 4096;
constexpr int IN_DIM = 10344;
constexpr int CQ = 0, CK = 1024, CV = 1280, CQI = 1536, CKI = 2048, CWI = 2112, CZ = 2120, CXBC = 4168, CDT = 8264, CGATE = 8296;
constexpr int NIN = 33 * 256;
constexpr float EPS = 1e-6f;
constexpr int MASKW = 68;
constexpr size_t O_Y = 0, O_KP = 18874368, O_VP = 23068672, O_KIP = 27262976, O_CONVP = 28311552, O_SSMP = 28409856,
                 O_KS = 30507008, O_VS = 31031296, O_KIS = 31555584, O_CONVS = 31686656, O_SSMS = 32079872;
constexpr size_t MiB = 1u << 20;
constexpr size_t WS_CTL = 0, WS_MOD = 1 * MiB, WS_ROPE = 2 * MiB, WS_WI = 3 * MiB, WS_DT = 4 * MiB;
constexpr size_t WS_WBA = 8 * MiB, WS_WOUT = 10 * MiB, WS_WBS = 12 * MiB, WS_WGU = 16 * MiB, WS_WDN = 27 * MiB, WS_WG = 33 * MiB, WS_WIN = 37 * MiB;
constexpr size_t WS_MASK = 37 * MiB, WS_SSQ = 43 * MiB;
constexpr size_t WS_H = 54 * MiB, WS_Q = 90 * MiB, WS_KP = 126 * MiB, WS_KS = 134 * MiB, WS_VTP = 167 * MiB, WS_VTS = 175 * MiB, WS_XBC = 208 * MiB;
constexpr size_t WS_PART = WS_XBC;
constexpr size_t WS_GATES = 208 * MiB, WS_P1 = 280 * MiB, WS_MIXED = 316 * MiB, WS_ACT = 208 * MiB, WS_END = 352 * MiB;
constexpr int LDS_BYTES = 147456;

#define LAS __attribute__((address_space(3)))
typedef unsigned short bf16;
typedef unsigned v4u __attribute__((ext_vector_type(4)));
typedef unsigned v2u __attribute__((ext_vector_type(2)));
typedef float f32x4 __attribute__((ext_vector_type(4)));
typedef float f32x16 __attribute__((ext_vector_type(16)));
typedef short bf16x8 __attribute__((ext_vector_type(8)));
typedef short bf16x4 __attribute__((ext_vector_type(4)));
using pg8::cvt_pk_bf16;
#define LDS_WAIT() asm volatile("s_waitcnt lgkmcnt(0)" ::: "memory")
__device__ __forceinline__ float bf2f(unsigned h) { return __uint_as_float(h << 16); }
__device__ __forceinline__ float wave_sum(float v) {
#pragma unroll
    for (int o = 1; o < 64; o <<= 1) v += __shfl_xor(v, o);
    return v;
}
__device__ __forceinline__ float silu_f(float v) { return v * __builtin_amdgcn_rcpf(1.f + __expf(-v)); }
__device__ __forceinline__ float sigmoid_f(float v) { return __builtin_amdgcn_rcpf(1.f + __expf(-v)); }
__device__ __forceinline__ v4u pack8(const float* a) { v4u o; o.x = cvt_pk_bf16(a[0], a[1]); o.y = cvt_pk_bf16(a[2], a[3]); o.z = cvt_pk_bf16(a[4], a[5]); o.w = cvt_pk_bf16(a[6], a[7]); return o; }

struct Params { const float* in[27]; float* out; unsigned char* ws; int ph_lo, ph_hi; };

__device__ __forceinline__ void tr_item(const float* __restrict__ W, int ldw, int srccol, int nvalid, bf16* WT, size_t ldd, int dstrow, int k0, LAS float* scr, int lane) {
#pragma unroll 8
    for (int i = 0; i < 32; ++i) { const int kk = 2 * i + (lane >> 5), c = lane & 31; scr[kk * 33 + c] = (c < nvalid) ? W[(size_t)(k0 + kk) * ldw + srccol + c] : 0.f; }
    LDS_WAIT();
    const int c = lane & 7;
#pragma unroll
    for (int j = 0; j < 4; ++j) { const int n = (lane >> 3) + 8 * j; const LAS float* s = scr + (8 * c) * 33 + n;
        v4u o; o.x = cvt_pk_bf16(s[0 * 33], s[1 * 33]); o.y = cvt_pk_bf16(s[2 * 33], s[3 * 33]); o.z = cvt_pk_bf16(s[4 * 33], s[5 * 33]); o.w = cvt_pk_bf16(s[6 * 33], s[7 * 33]);
        *(v4u*)(WT + (size_t)(dstrow + n) * ldd + k0 + 8 * c) = o; }
    LDS_WAIT();
}

__device__ __forceinline__ void phase0(const Params& p, LAS unsigned char* lds, int tid, int lane, int wave) {
    const int G = gridDim.x, bx = blockIdx.x;
    unsigned char* ws = p.ws;
    {
        LAS float* sc = (LAS float*)lds;
        const float* w_ada = p.in[9];
        float* part = (float*)(ws + WS_PART);
        for (int it = bx; it < 192; it += G) {
            const int ks = it / 24, cb = it % 24;
            __syncthreads();
            for (int i = tid; i < 40 * 128; i += 512) { const int r = i >> 7, k = i & 127; const float c = (r < 8) ? p.in[7][r * DM + ks * 128 + k] : p.in[8][(r - 8) * DM + ks * 128 + k]; sc[i] = silu_f(c); }
            __syncthreads();
            const int col = cb * 256 + (tid & 255), rh = tid >> 8;
            float a[20];
#pragma unroll
            for (int r = 0; r < 20; ++r) a[r] = 0.f;
            const float* wp = w_ada + (size_t)(ks * 128) * 6144 + col;
            for (int k = 0; k < 128; ++k) { const float w = wp[(size_t)k * 6144];
#pragma unroll
                for (int r = 0; r < 20; ++r) a[r] += sc[(rh * 20 + r) * 128 + k] * w; }
#pragma unroll
            for (int r = 0; r < 20; ++r) part[((size_t)ks * 40 + rh * 20 + r) * 6144 + col] = a[r];
        }
        __syncthreads();
    }
    {
        LAS float* scr = (LAS float*)(lds + wave * 8704);
        const int gw = bx * 8 + wave, NGW = G * 8;
        constexpr int I_IN = 16 * 264, I_G = 16 * 64, I_BA = 16 * 32, I_OUT = 16 * 32, I_BS = 32 * 32, I_GU = 16 * 176, I_DN = 44 * 32;
        constexpr int NIT = I_IN + I_G + I_BA + I_OUT + I_BS + I_GU + I_DN;
        for (int it = gw; it < NIT; it += NGW) {
            int r = it;
            if (r < I_IN) { const int kb = r / 264, rg = r % 264, pn = rg >> 3, w8 = rg & 7, bj = w8 >> 2, wc = w8 & 3; int src, nv = 32;
                if (pn < 8) src = 256 * pn + 64 * wc + 32 * bj;
                else if (pn == 8) { if (wc == 0) src = CKI + 32 * bj; else if (wc == 1) { if (bj == 0) { src = CWI; nv = 8; } else src = CDT; } else { src = 0; nv = 0; } }
                else if (pn < 17) src = CZ + (rg - 72) * 32; else src = CXBC + (rg - 136) * 32;
                tr_item(p.in[13], IN_DIM, src, nv, (bf16*)(ws + WS_WIN), 1024, rg * 32, kb * 64, scr, lane); continue; } r -= I_IN;
            if (r < I_G) { const int kb = r / 64, rg = r % 64; tr_item(p.in[13], IN_DIM, CGATE + rg * 32, 32, (bf16*)(ws + WS_WG), 1024, rg * 32, kb * 64, scr, lane); continue; } r -= I_G;
            if (r < I_BA) { const int kb = r / 32, rg = r % 32; tr_item(p.in[22], 1024, rg * 32, 32, (bf16*)(ws + WS_WBA), 1024, rg * 32, kb * 64, scr, lane); continue; } r -= I_BA;
            if (r < I_OUT) { const int kb = r / 32, rg = r % 32; tr_item(p.in[24], 1024, rg * 32, 32, (bf16*)(ws + WS_WOUT), 1024, rg * 32, kb * 64, scr, lane); continue; } r -= I_OUT;
            if (r < I_BS) { const int kb = r / 32, rg = r % 32; tr_item(p.in[23], 1024, rg * 32, 32, (bf16*)(ws + WS_WBS), 2048, rg * 32, kb * 64, scr, lane); continue; } r -= I_BS;
            if (r < I_GU) { const int kb = r / 176, rg = r % 176, pt = rg >> 3, w8 = rg & 7, half = w8 >> 2, r4 = w8 & 3;
                tr_item(p.in[25], 2 * DFF, half * DFF + 128 * pt + 32 * r4, 32, (bf16*)(ws + WS_WGU), 1024, rg * 32, kb * 64, scr, lane); continue; } r -= I_GU;
            { const int kb = r / 32, rg = r % 32; tr_item(p.in[26], 1024, rg * 32, 32, (bf16*)(ws + WS_WDN), DFF, rg * 32, kb * 64, scr, lane); }
        }
    }
    {
        const int gt = bx * 512 + tid, NGT = G * 512;
        const float* cki = p.in[4]; bf16* KIS = (bf16*)(p.out + O_SSMS) + (size_t)TT * 512 + (size_t)NBP * NKP * 64;
        for (int i = gt; i < 524288; i += NGT) { const size_t e = (size_t)i * 8; const int d = (int)(e & 63), s = (int)((e >> 6) & 2047), b = (int)(e >> 17);
            const f32x4 x0 = *(const f32x4*)(cki + e), x1 = *(const f32x4*)(cki + e + 4);
            v4u o; o.x = cvt_pk_bf16(x0[0], x0[1]); o.y = cvt_pk_bf16(x0[2], x0[3]); o.z = cvt_pk_bf16(x1[0], x1[1]); o.w = cvt_pk_bf16(x1[2], x1[3]);
            *(v4u*)(KIS + ((size_t)b * NKS + s) * 64 + d) = o; }
        float* rope = (float*)(ws + WS_ROPE);
        for (int i = gt; i < NKS * 32; i += NGT) { const int pos = i >> 5, j = i & 31;
            double invd = 1.0; for (int k = 0; k < j; ++k) invd *= 0.74989420933245582;
            const float inv = (float)invd; const float ang = (float)pos * inv;
            const double x = (double)ang; const double q = __builtin_rint(x * 0.63661977236758134); const double r = x - q * 1.5707963267948966; const double r2 = r * r;
            const double sn = r * (1.0 + r2 * (-1.0 / 6 + r2 * (1.0 / 120 + r2 * (-1.0 / 5040 + r2 * (1.0 / 362880 + r2 * (-1.0 / 39916800))))));
            const double cs = 1.0 + r2 * (-0.5 + r2 * (1.0 / 24 + r2 * (-1.0 / 720 + r2 * (1.0 / 40320 + r2 * (-1.0 / 3628800 + r2 * (1.0 / 479001600))))));
            const int iq = ((int)q) & 3; double so, co;
            if (iq == 0) { so = sn; co = cs; } else if (iq == 1) { so = cs; co = -sn; } else if (iq == 2) { so = -sn; co = -cs; } else { so = -cs; co = sn; }
            rope[i] = (float)co; rope[NKS * 32 + i] = (float)so; }
    }
}

template <bool FROM_PART>
__device__ __forceinline__ void normmod_phase(const Params& p, LAS unsigned char* lds, int tid, int lane, int wave, const float* xp, const float* xs, const float* g, int off_sh, int off_sc, bf16* H) {
    const int bx = blockIdx.x, G = gridDim.x;
    unsigned char* ws = p.ws;
    const float* part = (const float*)(ws + WS_PART); const float* b_ada = p.in[10]; float* MOD = (float*)(ws + WS_MOD);
    LAS float* lsh = (LAS float*)lds; LAS float* lsc = lsh + 1024;
    if (FROM_PART) {
        for (int it = bx; it < 240; it += G) { const int row = it / 6, seg = it % 6;
            for (int c = tid; c < 1024; c += 512) { float v = b_ada[seg * 1024 + c];
#pragma unroll
                for (int ks = 0; ks < 8; ++ks) v += part[((size_t)ks * 40 + row) * 6144 + seg * 1024 + c];
                MOD[row * 6144 + seg * 1024 + c] = v; } }
    }
    const int rows_per = (TT + G - 1) / G;
    const int r_lo = bx * rows_per, r_hi = (r_lo + rows_per < TT) ? r_lo + rows_per : TT;
    int r = r_lo;
    while (r < r_hi) {
        const int mrow = (r < TP) ? (r >> 11) : 8 + ((r - TP) >> 6);
        const int gend = (r < TP) ? ((r >> 11) + 1) << 11 : TP + ((((r - TP) >> 6) + 1) << 6);
        const int e = gend < r_hi ? gend : r_hi;
        __syncthreads();
        for (int c = tid; c < 1024; c += 512) {
            float vsh, vsc;
            if (FROM_PART) { vsh = b_ada[off_sh + c]; vsc = b_ada[off_sc + c];
#pragma unroll
                for (int ks = 0; ks < 8; ++ks) { vsh += part[((size_t)ks * 40 + mrow) * 6144 + off_sh + c]; vsc += part[((size_t)ks * 40 + mrow) * 6144 + off_sc + c]; } }
            else { vsh = MOD[mrow * 6144 + off_sh + c]; vsc = MOD[mrow * 6144 + off_sc + c]; }
            lsh[c] = vsh; lsc[c] = (1.f + vsc) * g[c];
        }
        __syncthreads();
        for (int row = r + wave; row < e; row += 8) {
            const float* xr = (row < TP) ? xp + (size_t)row * DM : xs + (size_t)(row - TP) * DM;
            f32x4 v[4]; float s = 0.f;
#pragma unroll
            for (int j = 0; j < 4; ++j) { v[j] = *(const f32x4*)(xr + 4 * lane + 256 * j); s += (v[j][0] * v[j][0] + v[j][1] * v[j][1]) + (v[j][2] * v[j][2] + v[j][3] * v[j][3]); }
            const float rstd = rsqrtf(wave_sum(s) * (1.f / DM) + EPS);
#pragma unroll
            for (int j = 0; j < 4; ++j) { const int c = 4 * lane + 256 * j; const f32x4 a = *(const LAS f32x4*)(lsc + c), b = *(const LAS f32x4*)(lsh + c);
                v2u o; o.x = cvt_pk_bf16(v[j][0] * rstd * a[0] + b[0], v[j][1] * rstd * a[1] + b[1]); o.y = cvt_pk_bf16(v[j][2] * rstd * a[2] + b[2], v[j][3] * rstd * a[3] + b[3]);
                *(v2u*)(H + (size_t)row * DM + c) = o; }
        }
        r = e;
    }
    __syncthreads();
}

#define EPI_ROWS_BEGIN \
    _Pragma("unroll") for (int ai = 0; ai < 2; ++ai) _Pragma("unroll") for (int m = 0; m < 4; ++m) { \
        const int row = u.pm * 256 + ai * 128 + wr * 64 + m * 16 + fr; float a[8], b[8]; \
        _Pragma("unroll") for (int e = 0; e < 4; ++e) { a[e] = acc[ai][0][m][0][e]; a[4 + e] = acc[ai][0][m][1][e]; b[e] = acc[ai][1][m][0][e]; b[4 + e] = acc[ai][1][m][1][e]; }
#define EPI_ROWS_END }

#define EPI_LOADROW(AI, M) { _Pragma("unroll") for (int e = 0; e < 4; ++e) { a[e] = acc[AI][0][M][0][e]; a[4 + e] = acc[AI][0][M][1][e]; b[e] = acc[AI][1][M][0][e]; b[4 + e] = acc[AI][1][M][1][e]; } }
#define EPI_ROWS_LOOP_BEGIN \
    _Pragma("unroll 1") for (int rr = 0; rr < 8; ++rr) { \
        const int row = u.pm * 256 + (rr >> 2) * 128 + wr * 64 + (rr & 3) * 16 + fr; float a[8], b[8]; \
        switch (rr) { case 0: EPI_LOADROW(0, 0) break; case 1: EPI_LOADROW(0, 1) break; case 2: EPI_LOADROW(0, 2) break; case 3: EPI_LOADROW(0, 3) break; \
                      case 4: EPI_LOADROW(1, 0) break; case 5: EPI_LOADROW(1, 1) break; case 6: EPI_LOADROW(1, 2) break; default: EPI_LOADROW(1, 3) break; }

struct EpiIn {
    static constexpr bool PERM = true, AFTER_DRAIN = false;
    bf16 *Q, *KP, *KS, *VTP, *VTS, *QI, *KIP, *KIS, *Z, *XBC; float *WI, *DT, *out; const float *gq, *gk, *dtb, *rope;
    __device__ __forceinline__ void operator()(const f32x4 (&acc)[2][2][4][2], const pg8::Unit& u, int wr, int wc, int fr, int fq) const {
        const int pn = u.pn;
        if (pn == 8 && wc >= 2) return;
        EPI_ROWS_LOOP_BEGIN
            const bool isS = row >= TP; int sb, t, pos;
            if (!isS) { sb = row >> 11; t = row & 2047; pos = t; } else { const int s = row - TP; sb = s >> 6; t = s & 63; pos = PAST + t; }
            if (pn >= 17) {
                const int col = 256 * (pn - 17) + 32 * wc + 8 * fq;
                *(v4u*)(XBC + (size_t)row * CONVC + col) = pack8(a); *(v4u*)(XBC + (size_t)row * CONVC + col + 128) = pack8(b);
                const int L = isS ? DSEQ : SEQ;
                if (t >= L - 3) { float* o = out + (isS ? O_CONVS : O_CONVP) + (size_t)(sb * 3 + (t - (L - 3))) * CONVC + col;
                    *(f32x4*)(o) = (f32x4){a[0], a[1], a[2], a[3]}; *(f32x4*)(o + 4) = (f32x4){a[4], a[5], a[6], a[7]};
                    *(f32x4*)(o + 128) = (f32x4){b[0], b[1], b[2], b[3]}; *(f32x4*)(o + 132) = (f32x4){b[4], b[5], b[6], b[7]}; }
            } else if (pn >= 9) {
                const int col = 256 * (pn - 9) + 32 * wc + 8 * fq;
#pragma unroll
                for (int e = 0; e < 8; ++e) { a[e] = silu_f(a[e]); b[e] = silu_f(b[e]); }
                *(v4u*)(Z + (size_t)row * DINNER + col) = pack8(a); *(v4u*)(Z + (size_t)row * DINNER + col + 128) = pack8(b);
            } else if (pn == 8 && wc == 1) {
                if (fq == 0) { float* w = WI + (size_t)row * 8; const float sc = 0.35355339059327373f * 0.125f;
                    *(f32x4*)w = (f32x4){a[0] * sc, a[1] * sc, a[2] * sc, a[3] * sc}; *(f32x4*)(w + 4) = (f32x4){a[4] * sc, a[5] * sc, a[6] * sc, a[7] * sc}; }
                float d[8];
#pragma unroll
                for (int e = 0; e < 8; ++e) { const float x = b[e] + dtb[8 * fq + e]; d[e] = x > 20.f ? x : log1pf(__expf(x)); }
                float* o = DT + (size_t)row * 32 + 8 * fq; *(f32x4*)o = (f32x4){d[0], d[1], d[2], d[3]}; *(f32x4*)(o + 4) = (f32x4){d[4], d[5], d[6], d[7]};
            } else if (pn == 5) {
                float* o = out + (isS ? O_VS + ((size_t)(row - TP) * 4 + wc) * 64 : O_VP + ((size_t)row * 4 + wc) * 64) + 8 * fq;
                *(f32x4*)(o) = (f32x4){a[0], a[1], a[2], a[3]}; *(f32x4*)(o + 4) = (f32x4){a[4], a[5], a[6], a[7]};
                *(f32x4*)(o + 32) = (f32x4){b[0], b[1], b[2], b[3]}; *(f32x4*)(o + 36) = (f32x4){b[4], b[5], b[6], b[7]};
                bf16* vb = (isS ? VTS + ((size_t)(sb * 4 + wc) * DSEQ + t) * 64 : VTP + ((size_t)(sb * 4 + wc) * NKP + t) * 64) + 8 * fq;
                *(v4u*)vb = pack8(a); *(v4u*)(vb + 32) = pack8(b);
            } else {
                if (pn <= 4) { float ss = 0.f;
#pragma unroll
                    for (int e = 0; e < 8; ++e) ss += a[e] * a[e] + b[e] * b[e];
                    ss += __shfl_xor(ss, 16); ss += __shfl_xor(ss, 32);
                    const float rstd = rsqrtf(ss * (1.f / 64.f) + EPS); const float* g = (pn < 4) ? gq : gk;
#pragma unroll
                    for (int e = 0; e < 8; ++e) { a[e] *= rstd * g[8 * fq + e]; b[e] *= rstd * g[32 + 8 * fq + e]; } }
                { const float* cp = rope + (size_t)pos * 32 + 8 * fq; const float* sp = cp + NKS * 32;
#pragma unroll
                  for (int e = 0; e < 8; ++e) { const float c = cp[e], s = sp[e], x1 = a[e], x2 = b[e]; a[e] = x1 * c - x2 * s; b[e] = x2 * c + x1 * s; } }
                if (pn < 4) { const float qs = 0.125f * 1.4426950408889634f;
#pragma unroll
                    for (int e = 0; e < 8; ++e) { a[e] *= qs; b[e] *= qs; }
                    bf16* q = Q + (size_t)row * DM + (4 * pn + wc) * 64 + 8 * fq; *(v4u*)q = pack8(a); *(v4u*)(q + 32) = pack8(b); }
                else if (pn == 4) {
                    float* o = out + (isS ? O_KS + ((size_t)(row - TP) * 4 + wc) * 64 : O_KP + ((size_t)row * 4 + wc) * 64) + 8 * fq;
                    *(f32x4*)(o) = (f32x4){a[0], a[1], a[2], a[3]}; *(f32x4*)(o + 4) = (f32x4){a[4], a[5], a[6], a[7]};
                    *(f32x4*)(o + 32) = (f32x4){b[0], b[1], b[2], b[3]}; *(f32x4*)(o + 36) = (f32x4){b[4], b[5], b[6], b[7]};
                    bf16* kb = (isS ? KS + ((size_t)(sb * 4 + wc) * DSEQ + t) * 64 : KP + ((size_t)(sb * 4 + wc) * NKP + t) * 64) + 8 * fq;
                    *(v4u*)kb = pack8(a); *(v4u*)(kb + 32) = pack8(b);
                } else if (pn < 8) { bf16* q = QI + (size_t)row * 512 + (4 * (pn - 6) + wc) * 64 + 8 * fq; *(v4u*)q = pack8(a); *(v4u*)(q + 32) = pack8(b); }
                else {
                    float* o = out + (isS ? O_KIS + (size_t)(row - TP) * 64 : O_KIP + (size_t)row * 64) + 8 * fq;
                    *(f32x4*)(o) = (f32x4){a[0], a[1], a[2], a[3]}; *(f32x4*)(o + 4) = (f32x4){a[4], a[5], a[6], a[7]};
                    *(f32x4*)(o + 32) = (f32x4){b[0], b[1], b[2], b[3]}; *(f32x4*)(o + 36) = (f32x4){b[4], b[5], b[6], b[7]};
                    bf16* kb = (isS ? KIS + ((size_t)sb * NKS + pos) * 64 : KIP + (size_t)row * 64) + 8 * fq;
                    *(v4u*)kb = pack8(a); *(v4u*)(kb + 32) = pack8(b);
                }
            }
        EPI_ROWS_END
    }
};

__device__ __forceinline__ void unpack8(const v4u w, float* f) {
    f[0] = __uint_as_float(w.x << 16); f[1] = __uint_as_float(w.x & 0xffff0000u); f[2] = __uint_as_float(w.y << 16); f[3] = __uint_as_float(w.y & 0xffff0000u);
    f[4] = __uint_as_float(w.z << 16); f[5] = __uint_as_float(w.z & 0xffff0000u); f[6] = __uint_as_float(w.w << 16); f[7] = __uint_as_float(w.w & 0xffff0000u);
}
__device__ __forceinline__ int mod_row(int row) { return (row < TP) ? (row >> 11) : 8 + ((row - TP) >> 6); }

struct EpiGates {
    static constexpr bool PERM = true, AFTER_DRAIN = false; bf16* G;
    __device__ __forceinline__ void operator()(const f32x4 (&acc)[2][2][4][2], const pg8::Unit& u, int wr, int wc, int fr, int fq) const {
        EPI_ROWS_BEGIN
            const int col = 256 * u.pn + 32 * wc + 8 * fq;
#pragma unroll
            for (int e = 0; e < 8; ++e) { a[e] = sigmoid_f(a[e]); b[e] = sigmoid_f(b[e]); }
            *(v4u*)(G + (size_t)row * 2048 + col) = pack8(a); *(v4u*)(G + (size_t)row * 2048 + col + 128) = pack8(b);
        EPI_ROWS_END
    }
};
struct EpiP1 {
    static constexpr bool PERM = true, AFTER_DRAIN = false; const bf16* G; bf16* P1;
    __device__ __forceinline__ void operator()(const f32x4 (&acc)[2][2][4][2], const pg8::Unit& u, int wr, int wc, int fr, int fq) const {
        EPI_ROWS_BEGIN
            const int col = 256 * u.pn + 32 * wc + 8 * fq;
            *(v4u*)(P1 + (size_t)row * DM + col) = pack8(a); *(v4u*)(P1 + (size_t)row * DM + col + 128) = pack8(b);
        EPI_ROWS_END
    }
};
struct EpiMixed {
    static constexpr bool PERM = true, AFTER_DRAIN = false; const bf16* G; const bf16* P1; bf16* MX;
    __device__ __forceinline__ void operator()(const f32x4 (&acc)[2][2][4][2], const pg8::Unit& u, int wr, int wc, int fr, int fq) const {
        EPI_ROWS_BEGIN
            const int col = 256 * u.pn + 32 * wc + 8 * fq; float g0[8], g1[8], p0[8], p1[8], h0[8], h1[8];
            unpack8(*(const v4u*)(G + (size_t)row * 2048 + 1024 + col), g0); unpack8(*(const v4u*)(G + (size_t)row * 2048 + 1024 + col + 128), g1);
            unpack8(*(const v4u*)(G + (size_t)row * 2048 + col), h0); unpack8(*(const v4u*)(G + (size_t)row * 2048 + col + 128), h1);
            unpack8(*(const v4u*)(P1 + (size_t)row * DM + col), p0); unpack8(*(const v4u*)(P1 + (size_t)row * DM + col + 128), p1);
#pragma unroll
            for (int e = 0; e < 8; ++e) { a[e] = p0[e] * h0[e] + a[e] * g0[e]; b[e] = p1[e] * h1[e] + b[e] * g1[e]; }
            *(v4u*)(MX + (size_t)row * DM + col) = pack8(a); *(v4u*)(MX + (size_t)row * DM + col + 128) = pack8(b);
        EPI_ROWS_END
    }
};
struct EpiRes {
    static constexpr bool PERM = true, AFTER_DRAIN = false; const float* xp; const float* xs; const float* MOD; int moff; float* out;
    __device__ __forceinline__ void operator()(const f32x4 (&acc)[2][2][4][2], const pg8::Unit& u, int wr, int wc, int fr, int fq) const {
        EPI_ROWS_BEGIN
            const int col = 256 * u.pn + 32 * wc + 8 * fq;
            const float* xr = ((row < TP) ? xp + (size_t)row * DM : xs + (size_t)(row - TP) * DM) + col;
            const float* mr = MOD + (size_t)mod_row(row) * 6144 + moff + col; float* o = out + (size_t)row * DM + col;
#pragma unroll
            for (int hh = 0; hh < 2; ++hh) { const float* v = hh ? b : a;
#pragma unroll
                for (int q = 0; q < 2; ++q) { const f32x4 x = *(const f32x4*)(xr + 128 * hh + 4 * q), g = *(const f32x4*)(mr + 128 * hh + 4 * q);
                    *(f32x4*)(o + 128 * hh + 4 * q) = (f32x4){x[0] + g[0] * v[4 * q], x[1] + g[1] * v[4 * q + 1], x[2] + g[2] * v[4 * q + 2], x[3] + g[3] * v[4 * q + 3]}; } }
        EPI_ROWS_END
    }
};
struct EpiResAdd {
    static constexpr bool PERM = true, AFTER_DRAIN = false; const float* MOD; int moff; float* out;
    __device__ __forceinline__ void operator()(const f32x4 (&acc)[2][2][4][2], const pg8::Unit& u, int wr, int wc, int fr, int fq) const {
        EPI_ROWS_BEGIN
            const int col = 256 * (u.pn & 3) + 32 * wc + 8 * fq;
            const float* mr = MOD + (size_t)mod_row(row) * 6144 + moff + col; float* o = out + (size_t)row * DM + col;
#pragma unroll
            for (int e = 0; e < 8; ++e) { unsafeAtomicAdd(o + e, mr[e] * a[e]); unsafeAtomicAdd(o + 128 + e, mr[128 + e] * b[e]); }
        EPI_ROWS_END
    }
};
struct EpiAct {
    static constexpr bool PERM = true, AFTER_DRAIN = false; bf16* ACT;
    __device__ __forceinline__ void operator()(const f32x4 (&acc)[2][2][4][2], const pg8::Unit& u, int wr, int wc, int fr, int fq) const {
        EPI_ROWS_BEGIN
            const int col = 128 * u.pn + 32 * wc + 8 * fq;
#pragma unroll
            for (int e = 0; e < 8; ++e) a[e] = silu_f(a[e]) * b[e];
            *(v4u*)(ACT + (size_t)row * DFF + col) = pack8(a);
        EPI_ROWS_END
    }
};

__device__ __forceinline__ void ynorm_phase(const Params& p, int lane, int wave, bf16* Y, const float* SSQ) {
    const float* gn = p.in[21];
    const int gw = blockIdx.x * 8 + wave, NGW = gridDim.x * 8;
    for (int row = gw; row < TT; row += NGW) {
#pragma unroll
        for (int j = 0; j < 4; ++j) { const int c = 8 * lane + 512 * j, g = c >> 8;
            const f32x4 s = *(const f32x4*)(SSQ + (size_t)row * 32 + 4 * g);
            const float rstd = rsqrtf(((s[0] + s[1]) + (s[2] + s[3])) * (1.f / 256.f) + EPS);
            float y[8]; unpack8(*(const v4u*)(Y + (size_t)row * DINNER + c), y);
            const f32x4 g0 = *(const f32x4*)(gn + c), g1 = *(const f32x4*)(gn + c + 4);
            y[0] *= rstd * g0[0]; y[1] *= rstd * g0[1]; y[2] *= rstd * g0[2]; y[3] *= rstd * g0[3]; y[4] *= rstd * g1[0]; y[5] *= rstd * g1[1]; y[6] *= rstd * g1[2]; y[7] *= rstd * g1[3];
            *(v4u*)(Y + (size_t)row * DINNER + c) = pack8(y); }
    }
}

__device__ __forceinline__ void conv_stream(bf16* base, float (&h0)[8], float (&h1)[8], float (&h2)[8], const float* wconv, const float* bconv, int col) {
    float w[4][8], bias[8];
#pragma unroll
    for (int j = 0; j < 4; ++j) { const f32x4 w0 = *(const f32x4*)(wconv + j * CONVC + col), w1 = *(const f32x4*)(wconv + j * CONVC + col + 4);
        w[j][0] = w0[0]; w[j][1] = w0[1]; w[j][2] = w0[2]; w[j][3] = w0[3]; w[j][4] = w1[0]; w[j][5] = w1[1]; w[j][6] = w1[2]; w[j][7] = w1[3]; }
    { const f32x4 b0 = *(const f32x4*)(bconv + col), b1 = *(const f32x4*)(bconv + col + 4);
      bias[0] = b0[0]; bias[1] = b0[1]; bias[2] = b0[2]; bias[3] = b0[3]; bias[4] = b1[0]; bias[5] = b1[1]; bias[6] = b1[2]; bias[7] = b1[3]; }
    for (int r0 = 0; r0 < 64; r0 += 8) {
        v4u raw[8];
#pragma unroll
        for (int k = 0; k < 8; ++k) raw[k] = *(const v4u*)(base + (size_t)(r0 + k) * CONVC);
#pragma unroll
        for (int k = 0; k < 8; ++k) { float x[8], o[8]; unpack8(raw[k], x);
#pragma unroll
            for (int e = 0; e < 8; ++e) { o[e] = silu_f(bias[e] + w[0][e] * h0[e] + w[1][e] * h1[e] + w[2][e] * h2[e] + w[3][e] * x[e]); h0[e] = h1[e]; h1[e] = h2[e]; h2[e] = x[e]; }
            *(v4u*)(base + (size_t)(r0 + k) * CONVC) = pack8(o); }
    }
}
__device__ __forceinline__ void conv_phase(const Params& p, int tid, bf16* XBC) {
    const float* wconv = p.in[16]; const float* bconv = p.in[17];
    const int G = gridDim.x, bx = blockIdx.x;
    for (int it = bx; it < 256; it += G) {
        const int b = it >> 5, cb = it & 31, cg = tid & 15, run = tid >> 4, col = cb * 128 + cg * 8;
        bf16* base = XBC + (size_t)(b * SEQ + run * 64) * CONVC + col;
        float h0[8], h1[8], h2[8];
        if (run > 0) { unpack8(*(const v4u*)(base - 3 * CONVC), h0); unpack8(*(const v4u*)(base - 2 * CONVC), h1); unpack8(*(const v4u*)(base - CONVC), h2); }
        else {
#pragma unroll
            for (int e = 0; e < 8; ++e) { h0[e] = 0.f; h1[e] = 0.f; h2[e] = 0.f; } }
        __syncthreads();
        conv_stream(base, h0, h1, h2, wconv, bconv, col);
        __syncthreads();
    }
    for (int i = bx * 512 + tid; i < NBS * 512; i += G * 512) {
        const int b = i >> 9, col = (i & 511) * 8;
        bf16* base = XBC + (size_t)(TP + b * DSEQ) * CONVC + col;
        const float* sp = p.in[5] + (size_t)b * 3 * CONVC + col;
        float h0[8], h1[8], h2[8];
#pragma unroll
        for (int e = 0; e < 8; ++e) { h0[e] = sp[e]; h1[e] = sp[CONVC + e]; h2[e] = sp[2 * CONVC + e]; }
        conv_stream(base, h0, h1, h2, wconv, bconv, col);
    }
}

#define MFMA32(a, b, c) __builtin_amdgcn_mfma_f32_32x32x16_bf16((a), (b), (c), 0, 0, 0)
typedef short s16x4 __attribute__((ext_vector_type(4)));
#ifndef TR_SLOW
#define TR_SLOW 0
#endif
__device__ __forceinline__ bf16x8 tr_frag(const LAS bf16* tile, int pitch, int ra, int rb, int col, int lane) {
#if TR_SLOW
    bf16x8 r;
#pragma unroll
    for (int e = 0; e < 4; ++e) { r[e] = (short)tile[(ra + e) * pitch + col]; r[4 + e] = (short)tile[(rb + e) * pitch + col]; }
    return r;
#else
    const int tq = (lane & 15) >> 2, tp = lane & 3, cb = (col & ~15) + 4 * tp;
    const s16x4 lo = __builtin_amdgcn_ds_read_tr16_b64_v4i16((LAS s16x4*)(tile + (ra + tq) * pitch + cb)), hi = __builtin_amdgcn_ds_read_tr16_b64_v4i16((LAS s16x4*)(tile + (rb + tq) * pitch + cb));
    return (bf16x8){lo[0], lo[1], lo[2], lo[3], hi[0], hi[1], hi[2], hi[3]};
#endif
}
constexpr int SS_TILE = 44032, SS_XN = 0, SS_BN = 9216, SS_CN = 26624, SS_HS = 88064, SS_HSZ = 17408, SS_ACS = 122880, SS_SQ = 126976;
__device__ __forceinline__ void ssd_unit(const Params& p, LAS unsigned char* lds, int tid, int lane, int wave, bool isS, int b, int h,
                                         const bf16* XBC, const float* DT, bf16* Y, float* SSQ) {
    const int g = h >> 2, nch = isS ? 1 : 32, tok0 = isS ? TP + b * DSEQ : b * SEQ;
    const float a_h = -__expf(p.in[19][h]), d_h = p.in[20][h];
    LAS float* acs = (LAS float*)(lds + SS_ACS + wave * 512); LAS float* dtv = acs + 64;
    const int l32 = lane & 31, hf = lane >> 5, blk = (lane >> 4) & 1, tq = (lane & 15) >> 2, tp = lane & 3;
    const bool ywave = wave < 4; const int w4 = wave & 3;
    f32x16 hs0, hs1;
    float* sout = p.out + (isS ? O_SSMS : O_SSMP) + ((size_t)(b * 32 + h) * 64) * 128;
#pragma unroll
    for (int i = 0; i < 16; ++i) { hs0[i] = 0.f; hs1[i] = 0.f; }
    if (isS && !ywave) { const float* s0 = p.in[6] + ((size_t)(b * 32 + h) * 64) * 128;
#pragma unroll
        for (int i = 0; i < 16; ++i) { const int pr = 8 * (i >> 2) + 4 * hf + (i & 3); hs0[i] = s0[(size_t)pr * 128 + 32 * w4 + l32]; hs1[i] = s0[(size_t)(32 + pr) * 128 + 32 * w4 + l32]; } }
    int soff[5]; int goff[5];
#pragma unroll
    for (int k = 0; k < 5; ++k) { const int pc = tid + 512 * k;
        if (pc < 512) { const int r = pc >> 3, s8 = pc & 7; soff[k] = SS_XN + (r * 72 + 8 * s8) * 2; goff[k] = r * CONVC + h * 64 + 8 * s8; }
        else if (pc < 1536) { const int q = pc - 512, r = q >> 4, s8 = q & 15; soff[k] = SS_BN + (r * 136 + 8 * s8) * 2; goff[k] = r * CONVC + 2048 + g * 128 + 8 * s8; }
        else { const int q = pc - 1536, r = q >> 4, s8 = q & 15; soff[k] = SS_CN + (r * 136 + 8 * s8) * 2; goff[k] = r * CONVC + 3072 + g * 128 + 8 * s8; } }
    v4u stg[5]; float dtn; v2u zn[4];
    const int pt = wave >> 1, it = wave & 1, irow = 32 * it + l32;
#pragma unroll
    for (int k = 0; k < 5; ++k) stg[k] = *(const v4u*)(XBC + (size_t)tok0 * CONVC + goff[k]);
    dtn = DT[(size_t)(tok0 + lane) * 32 + h];
    if (ywave) {
#pragma unroll
        for (int q = 0; q < 4; ++q) zn[q] = *(const v2u*)(Y + (size_t)(tok0 + irow) * DINNER + h * 64 + 32 * pt + 8 * q + 4 * hf); }
#pragma unroll
    for (int k = 0; k < 5; ++k) *(LAS v4u*)(lds + soff[k]) = stg[k];
    if (!ywave) { LAS bf16* Hs = (LAS bf16*)(lds + SS_HS);
#pragma unroll
        for (int i = 0; i < 16; ++i) { const int pr = 8 * (i >> 2) + 4 * hf + (i & 3);
            Hs[pr * 136 + 32 * w4 + l32] = (bf16)(cvt_pk_bf16(hs0[i], 0.f) & 0xffffu); Hs[(32 + pr) * 136 + 32 * w4 + l32] = (bf16)(cvt_pk_bf16(hs1[i], 0.f) & 0xffffu); } }
    __syncthreads();
    for (int c = 0; c < nch; ++c) {
        const int tokc = tok0 + 64 * c, buf = c & 1;
        LAS unsigned char* tb = lds + buf * SS_TILE;
        const LAS bf16* Xn = (const LAS bf16*)(tb + SS_XN); const LAS bf16* Bn = (const LAS bf16*)(tb + SS_BN); const LAS bf16* Cn = (const LAS bf16*)(tb + SS_CN);
        const LAS bf16* Hs = (const LAS bf16*)(lds + SS_HS + buf * SS_HSZ);
        const float dtc = dtn; float av = dtc * a_h;
#pragma unroll
        for (int o = 1; o < 64; o <<= 1) { const float t = __shfl_up(av, o); if (lane >= o) av += t; }
        acs[lane] = av; dtv[lane] = dtc;
        const v2u zc0 = zn[0], zc1 = zn[1], zc2 = zn[2], zc3 = zn[3];
        const bool more = (c + 1 < nch);
        if (more) {
#pragma unroll
            for (int k = 0; k < 5; ++k) stg[k] = *(const v4u*)(XBC + (size_t)(tokc + 64) * CONVC + goff[k]);
            dtn = DT[(size_t)(tokc + 64 + lane) * 32 + h];
            if (ywave) {
#pragma unroll
                for (int q = 0; q < 4; ++q) zn[q] = *(const v2u*)(Y + (size_t)(tokc + 64 + irow) * DINNER + h * 64 + 32 * pt + 8 * q + 4 * hf); }
        }
        if (ywave) {
            const int prow = 32 * pt + l32;
            f32x16 yo;
#pragma unroll
            for (int i = 0; i < 16; ++i) yo[i] = 0.f;
#pragma unroll
            for (int ks = 0; ks < 8; ++ks) { const bf16x8 av8 = *(const LAS bf16x8*)(Hs + prow * 136 + 16 * ks + 8 * hf), bv8 = *(const LAS bf16x8*)(Cn + irow * 136 + 16 * ks + 8 * hf); yo = MFMA32(av8, bv8, yo); }
            const float ai = acs[irow]; const float ei = __expf(ai);
#pragma unroll
            for (int i = 0; i < 16; ++i) yo[i] *= ei;
            for (int jt = 0; jt <= it; ++jt) {
                f32x16 s;
#pragma unroll
                for (int i = 0; i < 16; ++i) s[i] = 0.f;
#pragma unroll
                for (int ks = 0; ks < 8; ++ks) { const bf16x8 av8 = *(const LAS bf16x8*)(Bn + (32 * jt + l32) * 136 + 16 * ks + 8 * hf), bv8 = *(const LAS bf16x8*)(Cn + irow * 136 + 16 * ks + 8 * hf); s = MFMA32(av8, bv8, s); }
                float mv[16];
#pragma unroll
                for (int i = 0; i < 16; ++i) { const int j = 32 * jt + 8 * (i >> 2) + 4 * hf + (i & 3); mv[i] = (j <= irow) ? s[i] * __expf(ai - acs[j]) * dtv[j] : 0.f; }
#pragma unroll
                for (int jj = 0; jj < 2; ++jj) {
                    const v4u pk = pack8(mv + 8 * jj); bf16x8 bv8; __builtin_memcpy(&bv8, &pk, 16);
                    const int ja = 32 * jt + 16 * jj + 4 * hf;
                    const bf16x8 av8 = tr_frag(Xn, 72, ja, ja + 8, 32 * pt + l32, lane);
                    yo = MFMA32(av8, bv8, yo);
                }
            }
            float sq = 0.f; bf16* zp = Y + (size_t)(tokc + irow) * DINNER + h * 64 + 32 * pt + 4 * hf;
#pragma unroll
            for (int q = 0; q < 4; ++q) { const int p4 = 32 * pt + 8 * q + 4 * hf;
                const v2u xr = *(const LAS v2u*)(Xn + irow * 72 + p4); const v2u zr = (q == 0) ? zc0 : (q == 1) ? zc1 : (q == 2) ? zc2 : zc3;
                const float x0 = bf2f(xr.x & 0xffffu), x1 = __uint_as_float(xr.x & 0xffff0000u), x2 = bf2f(xr.y & 0xffffu), x3 = __uint_as_float(xr.y & 0xffff0000u);
                const float z0 = bf2f(zr.x & 0xffffu), z1 = __uint_as_float(zr.x & 0xffff0000u), z2 = bf2f(zr.y & 0xffffu), z3 = __uint_as_float(zr.y & 0xffff0000u);
                const float y0 = (yo[4 * q] + d_h * x0) * z0, y1 = (yo[4 * q + 1] + d_h * x1) * z1, y2 = (yo[4 * q + 2] + d_h * x2) * z2, y3 = (yo[4 * q + 3] + d_h * x3) * z3;
                sq += (y0 * y0 + y1 * y1) + (y2 * y2 + y3 * y3);
                v2u o; o.x = cvt_pk_bf16(y0, y1); o.y = cvt_pk_bf16(y2, y3); *(v2u*)(zp + 8 * q) = o; }
            ((LAS float*)(lds + SS_SQ))[buf * 256 + (pt * 2 + hf) * 64 + irow] = sq;
        } else {
            const float a63 = acs[63]; const float dec = __expf(a63);
#pragma unroll
            for (int i = 0; i < 16; ++i) { hs0[i] *= dec; hs1[i] *= dec; }
#pragma unroll
            for (int ks = 0; ks < 4; ++ks) {
                const int j0 = 16 * ks + 8 * hf;
                const bf16x8 bv8 = tr_frag(Bn, 136, j0, j0 + 4, 32 * w4 + l32, lane);
                float wj[8];
#pragma unroll
                for (int e = 0; e < 8; ++e) wj[e] = __expf(a63 - acs[j0 + e]) * dtv[j0 + e];
#pragma unroll
                for (int ptt = 0; ptt < 2; ++ptt) {
                    const bf16x8 xr = tr_frag(Xn, 72, j0, j0 + 4, 32 * ptt + l32, lane);
                    v4u xu; __builtin_memcpy(&xu, &xr, 16); float xf[8]; unpack8(xu, xf);
#pragma unroll
                    for (int e = 0; e < 8; ++e) xf[e] *= wj[e];
                    const v4u xp = pack8(xf); bf16x8 av8; __builtin_memcpy(&av8, &xp, 16);
                    if (ptt == 0) hs0 = MFMA32(av8, bv8, hs0); else hs1 = MFMA32(av8, bv8, hs1);
                }
            }
            if (more) { LAS bf16* Hn = (LAS bf16*)(lds + SS_HS + (buf ^ 1) * SS_HSZ);
#pragma unroll
                for (int i = 0; i < 16; ++i) { const int pr = 8 * (i >> 2) + 4 * hf + (i & 3);
                    Hn[pr * 136 + 32 * w4 + l32] = (bf16)(cvt_pk_bf16(hs0[i], 0.f) & 0xffffu); Hn[(32 + pr) * 136 + 32 * w4 + l32] = (bf16)(cvt_pk_bf16(hs1[i], 0.f) & 0xffffu); } }
        }
        if (more) {
#pragma unroll
            for (int k = 0; k < 5; ++k) *(LAS v4u*)(lds + (buf ^ 1) * SS_TILE + soff[k]) = stg[k]; }
        __syncthreads();
        if (tid < 64) { const LAS float* sq = (const LAS float*)(lds + SS_SQ) + buf * 256; SSQ[(size_t)(tokc + tid) * 32 + h] = (sq[tid] + sq[64 + tid]) + (sq[128 + tid] + sq[192 + tid]); }
    }
    if (!ywave) {
#pragma unroll
        for (int i = 0; i < 16; ++i) { const int pr = 8 * (i >> 2) + 4 * hf + (i & 3); sout[(size_t)pr * 128 + 32 * w4 + l32] = hs0[i]; sout[(size_t)(32 + pr) * 128 + 32 * w4 + l32] = hs1[i]; } }
    __syncthreads();
}

constexpr int SCW = 2116;
__device__ __forceinline__ unsigned sortable(float x) { x += 0.0f; const unsigned b = __float_as_uint(x); return (b & 0x80000000u) ? ~b : (b | 0x80000000u); }
__device__ __forceinline__ void topk_unit(LAS unsigned char* lds, int tid, int lane, int wave, bool isS, int b, int qb,
                                          const bf16* QI, const bf16* KIP, const bf16* KIS, const float* WI, unsigned* MASK) {
    const int tok0 = isS ? TP + b * DSEQ + qb * 16 : b * SEQ + qb * 16;
    const int pos0 = (isS ? PAST : 0) + qb * 16, limit = ((pos0 >> 6) + 1) << 6, nslots = limit >> 6, ntile = limit >> 4;
    const bf16* KI = isS ? KIS + (size_t)b * NKS * 64 : KIP + (size_t)b * NKP * 64;
    LAS float* sc = (LAS float*)lds;
    const int l16 = lane & 15, kg = lane >> 4;
    if (limit > 256) {
        bf16x8 qf[8][2]; float wq[8];
#pragma unroll
        for (int hd = 0; hd < 8; ++hd) {
#pragma unroll
            for (int ks = 0; ks < 2; ++ks) qf[hd][ks] = *(const bf16x8*)(QI + (size_t)(tok0 + l16) * 512 + hd * 64 + 32 * ks + 8 * kg);
            wq[hd] = WI[(size_t)(tok0 + l16) * 8 + hd]; }
        for (int kt = wave; kt < ntile; kt += 8) {
            const bf16x8 a0 = *(const bf16x8*)(KI + (size_t)(16 * kt + l16) * 64 + 8 * kg), a1 = *(const bf16x8*)(KI + (size_t)(16 * kt + l16) * 64 + 32 + 8 * kg);
            f32x4 s = (f32x4){0.f, 0.f, 0.f, 0.f};
#pragma unroll
            for (int hd = 0; hd < 8; ++hd) { f32x4 c = (f32x4){0.f, 0.f, 0.f, 0.f};
                c = __builtin_amdgcn_mfma_f32_16x16x32_bf16(a0, qf[hd][0], c, 0, 0, 0); c = __builtin_amdgcn_mfma_f32_16x16x32_bf16(a1, qf[hd][1], c, 0, 0, 0);
#pragma unroll
                for (int i = 0; i < 4; ++i) s[i] += wq[hd] * fmaxf(c[i], 0.f); }
            *(LAS f32x4*)(sc + l16 * SCW + 16 * kt + 4 * kg) = s;
        }
    }
    __syncthreads();
    for (int qq = 0; qq < 2; ++qq) {
        const int q = 2 * wave + qq; unsigned* mrow = MASK + (size_t)(tok0 + q) * MASKW;
        if (limit <= 256) {
            if (lane < 33) { const unsigned v = (lane < nslots) ? 0xffffffffu : 0u; mrow[2 * lane] = v; mrow[2 * lane + 1] = v; }
            continue;
        }
        unsigned u[33];
#pragma unroll
        for (int j = 0; j < 33; ++j) u[j] = (j < nslots) ? sortable(sc[q * SCW + 64 * j + lane]) : 0u;
        const int ng = (nslots + 10) / 11;
#define CNT_GE(dst, val) do { int _c = 0; \
            _Pragma("unroll") for (int j = 0; j < 11; ++j) _c += __popcll(__ballot(u[j] >= (val))); \
            if (ng > 1) { _Pragma("unroll") for (int j = 11; j < 22; ++j) _c += __popcll(__ballot(u[j] >= (val))); } \
            if (ng > 2) { _Pragma("unroll") for (int j = 22; j < 33; ++j) _c += __popcll(__ballot(u[j] >= (val))); } \
            dst = _c; } while (0)
        unsigned thr = 0u; bool exact = false;
        for (int bit = 31; bit >= 0; --bit) { const unsigned cand = thr | (1u << bit); int cnt; CNT_GE(cnt, cand);
            if (cnt >= 256) thr = cand;
            if (cnt == 256) { exact = true; break; } }
        int rem = 0;
        if (!exact) { int cgt; CNT_GE(cgt, thr + 1u); rem = 256 - cgt; }
#pragma unroll
        for (int j = 0; j < 33; ++j) {
            unsigned long long wv;
            if (exact) wv = __ballot(u[j] >= thr);
            else { const unsigned long long gt = __ballot(u[j] > thr); unsigned long long eq = __ballot(u[j] == thr), sel = 0ull;
                const int pe = __popcll(eq);
                if (pe <= rem) { sel = eq; rem -= pe; }
                else { while (rem > 0) { const unsigned long long low = eq & (0ull - eq); sel |= low; eq ^= low; --rem; } }
                wv = gt | sel; }
            if (lane == 0) { mrow[2 * j] = (unsigned)wv; mrow[2 * j + 1] = (unsigned)(wv >> 32); }
        }
#undef CNT_GE
    }
    __syncthreads();
}

constexpr int AT_K = 0, AT_V = 18432, AT_M = 36864;
__device__ __forceinline__ void attn_unit(LAS unsigned char* lds, int tid, int lane, int wave, bool isS, int b, int c, int kvh,
                                          bf16* Q, const bf16* KP, const bf16* KSn, const bf16* VP, const bf16* VSn, const float* CK, const float* CV, const unsigned* MASK) {
    const int tok0 = isS ? TP + b * DSEQ : b * SEQ + 64 * c;
    const int limit = isS ? NKS : 64 * (c + 1), nt = limit >> 6;
    const bf16* Kb = isS ? KSn + (size_t)(b * 4 + kvh) * DSEQ * 64 : KP + (size_t)(b * 4 + kvh) * NKP * 64;
    const bf16* Vb = isS ? VSn + (size_t)(b * 4 + kvh) * DSEQ * 64 : VP + (size_t)(b * 4 + kvh) * NKP * 64;
    const float* Kc = CK + ((size_t)b * PAST * 4 + kvh) * 64; const float* Vc32 = CV + ((size_t)b * PAST * 4 + kvh) * 64;
    LAS bf16* Kt = (LAS bf16*)(lds + AT_K); LAS bf16* Vt = (LAS bf16*)(lds + AT_V); LAS unsigned* MK = (LAS unsigned*)(lds + AT_M);
    const int l32 = lane & 31, hf = lane >> 5, r = 32 * wave + l32, tl = r >> 2, gq = r & 3;
    bf16* qp = Q + (size_t)(tok0 + tl) * DM + (kvh * 4 + gq) * 64;
    bf16x8 qf[4];
#pragma unroll
    for (int ks = 0; ks < 4; ++ks) qf[ks] = *(const bf16x8*)(qp + hf * 32 + 8 * ks);
    for (int i = tid; i < 64 * MASKW; i += 512) MK[i] = MASK[(size_t)tok0 * MASKW + i];
    const int srow = tid >> 3, sseg = tid & 7;
    v4u kr0, kr1, vr0, vr1;
#define AT_LOAD(kt_) do { if (isS && (kt_) < 32) { const float* kp_ = Kc + (size_t)(64 * (kt_) + srow) * 256 + 8 * sseg; const float* vp_ = Vc32 + (size_t)(64 * (kt_) + srow) * 256 + 8 * sseg; \
            kr0 = *(const v4u*)kp_; kr1 = *(const v4u*)(kp_ + 4); vr0 = *(const v4u*)vp_; vr1 = *(const v4u*)(vp_ + 4); } \
        else { const int kk_ = isS ? srow : 64 * (kt_) + srow; kr0 = *(const v4u*)(Kb + (size_t)kk_ * 64 + 8 * sseg); vr0 = *(const v4u*)(Vb + (size_t)kk_ * 64 + 8 * sseg); } } while (0)
#define AT_STORE(kt_, buf_) do { v4u ko_ = kr0, vo_ = vr0; \
        if (isS && (kt_) < 32) { ko_.x = cvt_pk_bf16(__uint_as_float(kr0.x), __uint_as_float(kr0.y)); ko_.y = cvt_pk_bf16(__uint_as_float(kr0.z), __uint_as_float(kr0.w)); ko_.z = cvt_pk_bf16(__uint_as_float(kr1.x), __uint_as_float(kr1.y)); ko_.w = cvt_pk_bf16(__uint_as_float(kr1.z), __uint_as_float(kr1.w)); \
            vo_.x = cvt_pk_bf16(__uint_as_float(vr0.x), __uint_as_float(vr0.y)); vo_.y = cvt_pk_bf16(__uint_as_float(vr0.z), __uint_as_float(vr0.w)); vo_.z = cvt_pk_bf16(__uint_as_float(vr1.x), __uint_as_float(vr1.y)); vo_.w = cvt_pk_bf16(__uint_as_float(vr1.z), __uint_as_float(vr1.w)); } \
        *(LAS v4u*)(Kt + (buf_) * 4608 + srow * 72 + 8 * sseg) = ko_; *(LAS v4u*)(Vt + (buf_) * 4608 + srow * 72 + 8 * sseg) = vo_; } while (0)
    AT_LOAD(0); AT_STORE(0, 0);
    __syncthreads();
    f32x16 o0, o1;
#pragma unroll
    for (int i = 0; i < 16; ++i) { o0[i] = 0.f; o1[i] = 0.f; }
    float lpart = 0.f;
    for (int kt = 0; kt < nt; ++kt) {
        const int buf = kt & 1;
        if (kt + 1 < nt) AT_LOAD(kt + 1);
        const LAS bf16* Kc2 = Kt + buf * 4608; const LAS bf16* Vc = Vt + buf * 4608;
        f32x16 s0, s1;
#pragma unroll
        for (int i = 0; i < 16; ++i) { s0[i] = 0.f; s1[i] = 0.f; }
#pragma unroll
        for (int ks = 0; ks < 4; ++ks) { const bf16x8 a0 = *(const LAS bf16x8*)(Kc2 + l32 * 72 + hf * 32 + 8 * ks), a1 = *(const LAS bf16x8*)(Kc2 + (32 + l32) * 72 + hf * 32 + 8 * ks);
            s0 = MFMA32(a0, qf[ks], s0); s1 = MFMA32(a1, qf[ks], s1); }
        const unsigned w0 = MK[tl * MASKW + 2 * kt] >> (4 * hf), w1 = MK[tl * MASKW + 2 * kt + 1] >> (4 * hf);
        float p0[16], p1[16], ls = 0.f;
#pragma unroll
        for (int i = 0; i < 16; ++i) { const int bp = 8 * (i >> 2) + (i & 3);
            p0[i] = ((w0 >> bp) & 1u) ? __builtin_amdgcn_exp2f(s0[i]) : 0.f; p1[i] = ((w1 >> bp) & 1u) ? __builtin_amdgcn_exp2f(s1[i]) : 0.f; ls += p0[i] + p1[i]; }
        lpart += ls;
#pragma unroll
        for (int sub = 0; sub < 2; ++sub)
#pragma unroll
            for (int jj = 0; jj < 2; ++jj) {
                const v4u pk = pack8((sub ? p1 : p0) + 8 * jj); bf16x8 bv; __builtin_memcpy(&bv, &pk, 16);
                const int ja = 32 * sub + 16 * jj + 4 * hf;
                const bf16x8 av0 = tr_frag(Vc, 72, ja, ja + 8, l32, lane), av1 = tr_frag(Vc, 72, ja, ja + 8, 32 + l32, lane);
                o0 = MFMA32(av0, bv, o0); o1 = MFMA32(av1, bv, o1);
            }
        if (kt + 1 < nt) AT_STORE(kt + 1, buf ^ 1);
        __syncthreads();
    }
#undef AT_LOAD
#undef AT_STORE
    const float lt = lpart + __shfl_xor(lpart, 32), inv = 1.f / lt;
#pragma unroll
    for (int q = 0; q < 4; ++q) {
        v2u a; a.x = cvt_pk_bf16(o0[4 * q] * inv, o0[4 * q + 1] * inv); a.y = cvt_pk_bf16(o0[4 * q + 2] * inv, o0[4 * q + 3] * inv); *(v2u*)(qp + 8 * q + 4 * hf) = a;
        v2u c2; c2.x = cvt_pk_bf16(o1[4 * q] * inv, o1[4 * q + 1] * inv); c2.y = cvt_pk_bf16(o1[4 * q + 2] * inv, o1[4 * q + 3] * inv); *(v2u*)(qp + 32 + 8 * q + 4 * hf) = c2;
    }
    __syncthreads();
}
constexpr int NPHASES = 12;

#ifdef NOSSD
#define SSDCALL(...) (void)0
#else
#define SSDCALL ssd_unit
#endif
#ifdef NOATT
#define ATTCALL(...) (void)0
#else
#define ATTCALL attn_unit
#endif
#define XB_TMO      128
#define XB_XCNT(j)  (256  + 64 * (j))
#define XB_XSUB(j)  (1280 + 64 * (j))
#define XB_XGEN(j)  (2304 + 64 * (j))
#define XB_TOP      3328
#define XB_TOPGEN   3392
#define XCD_BAR_WORDS 3456
#define XB_SPIN_CAP (1u << 18)

__device__ __forceinline__ unsigned xb_ld(unsigned* p)              { return __hip_atomic_load(p, __ATOMIC_RELAXED, __HIP_MEMORY_SCOPE_AGENT); }
__device__ __forceinline__ unsigned xb_add(unsigned* p, unsigned v) { return __hip_atomic_fetch_add(p, v, __ATOMIC_RELAXED, __HIP_MEMORY_SCOPE_AGENT); }
__device__ __forceinline__ unsigned xb_xcc_id() { return (unsigned)__builtin_amdgcn_s_getreg((3 << 11) | 20) & 0xFu; }
#define XB_SPIN(cond, bar) do { unsigned _sp = 0; while (cond) { __builtin_amdgcn_s_sleep(1); \
    if ((++_sp & 255u) == 0u) { if (xb_ld(&(bar)[XB_TMO])) break; if (_sp > XB_SPIN_CAP) { atomicAdd(&(bar)[XB_TMO], 1u); break; } } } } while (0)

struct XcdBarrier {
    unsigned* bar; unsigned x;
    volatile LAS unsigned* st;
};

__device__ __forceinline__ XcdBarrier xcd_barrier_post(unsigned* bar, volatile LAS unsigned* st) {
    XcdBarrier b; b.bar = bar; b.x = xb_xcc_id(); b.st = st;
    if (threadIdx.x == 0) (void)xb_add(&bar[XB_XCNT(b.x)], 1u);
    return b;
}
__device__ __forceinline__ void xcd_barrier_complete(unsigned* bar, unsigned x, unsigned& nloc, unsigned& nx) {
    const unsigned G = gridDim.x * gridDim.y * gridDim.z;
    unsigned sum, cnt, mine, sp = 0u;
    for (;;) {
        sum = 0u; cnt = 0u; mine = 0u;
#pragma unroll
        for (unsigned j = 0; j < 16; ++j) { const unsigned c = xb_ld(&bar[XB_XCNT(j)]); sum += c; cnt += (c > 0u) ? 1u : 0u; mine = (j == x) ? c : mine; }
        if (sum == G) break;
        __builtin_amdgcn_s_sleep(1);
        if ((++sp & 255u) == 0u) { if (xb_ld(&bar[XB_TMO])) break; if (sp > XB_SPIN_CAP) { atomicAdd(&bar[XB_TMO], 1u); break; } }
    }
    nloc = mine > 0u ? mine : 1u; nx = cnt > 0u ? cnt : 1u;
}

__device__ __forceinline__ void xcd_barrier(const XcdBarrier& b) {
    asm volatile("s_waitcnt vmcnt(0)" ::: "memory");
    __syncthreads();
    if (threadIdx.x == 0) {
        unsigned* bar = b.bar;
        __builtin_amdgcn_s_waitcnt(0);
        unsigned nloc = b.st[0], nx = b.st[1];
        if (nloc == 0u) { xcd_barrier_complete(bar, b.x, nloc, nx); b.st[0] = nloc; b.st[1] = nx; }
        const unsigned old = xb_add(&bar[XB_XSUB(b.x)], 1u);
        const unsigned gen = old / nloc;
        if (old + 1u == (gen + 1u) * nloc) {
            __builtin_amdgcn_fence(__ATOMIC_RELEASE, "agent");
            asm volatile("s_waitcnt vmcnt(0)" ::: "memory");
            const unsigned og = xb_add(&bar[XB_TOP], 1u);
            const unsigned tg = og / nx;
            if (og + 1u == (tg + 1u) * nx) xb_add(&bar[XB_TOPGEN], 1u);
            else XB_SPIN(xb_ld(&bar[XB_TOPGEN]) == tg, bar);
            __builtin_amdgcn_fence(__ATOMIC_ACQUIRE, "agent");
            xb_add(&bar[XB_XGEN(b.x)], 1u);
            asm volatile("s_waitcnt vmcnt(0)" ::: "memory");
        } else {
            XB_SPIN(xb_ld(&bar[XB_XGEN(b.x)]) == gen, bar);
            __builtin_amdgcn_fence(__ATOMIC_ACQUIRE, "agent");
            asm volatile("s_waitcnt vmcnt(0)" ::: "memory");
        }
    }
    __syncthreads();
}

__global__ void __launch_bounds__(512) mega(Params p) {
    extern __shared__ __attribute__((aligned(16))) unsigned char lds_raw[];
    LAS unsigned char* lds = (LAS unsigned char*)lds_raw;
    cg::grid_group grid = cg::this_grid();
    const int tid = threadIdx.x, lane = tid & 63, wave = __builtin_amdgcn_readfirstlane(tid >> 6);
    unsigned char* ws = p.ws;
#define IN(k) (p.ph_hi > (k))
#define SEAM(k) xcd_barrier(xbar)
    volatile LAS unsigned* xst = (volatile LAS unsigned*)(lds + LDS_BYTES - 16);
    if (tid < 4) xst[tid] = 0u;
    __syncthreads();
    if (p.ph_hi < 0) grid.sync();
    XcdBarrier xbar = xcd_barrier_post((unsigned*)(ws + WS_CTL), xst);
    bf16* Hb = (bf16*)(ws + WS_H);
    bf16* QIb = (bf16*)(p.out + O_SSMS); bf16* KIPb = QIb + (size_t)TT * 512; bf16* KISb = KIPb + (size_t)NBP * NKP * 64;
    bf16* Zb = (bf16*)(p.out + O_Y);

    if (IN(0)) phase0(p, lds, tid, lane, wave);
    SEAM(0);
    if (IN(1)) normmod_phase<true>(p, lds, tid, lane, wave, p.in[0], p.in[1], p.in[11], 0, 1024, Hb);
    SEAM(1);
    if (IN(2)) {
        pg8::Gemm g{Hb, (const bf16*)(ws + WS_WIN), TT, NIN, DM}; pg8::StaticOrder S; S.init(TT, NIN, gridDim.x, (int)blockIdx.x);
        EpiIn E{(bf16*)(ws + WS_Q), (bf16*)(ws + WS_KP), (bf16*)(ws + WS_KS), (bf16*)(ws + WS_VTP), (bf16*)(ws + WS_VTS), QIb, KIPb, KISb, Zb, (bf16*)(ws + WS_XBC),
                (float*)(ws + WS_WI), (float*)(ws + WS_DT), p.out, p.in[14], p.in[15], p.in[18], (const float*)(ws + WS_ROPE)};
        pg8::gemm_phase<EpiIn, pg8::StaticOrder, true, true>(lds, g, S, E);
    }
    SEAM(2);
    bf16* Qb = (bf16*)(ws + WS_Q); unsigned* MASKb = (unsigned*)(ws + WS_MASK); float* SSQb = (float*)(ws + WS_SSQ);
    bf16* GATESb = (bf16*)(ws + WS_GATES); bf16* P1b = (bf16*)(ws + WS_P1); bf16* MXb = (bf16*)(ws + WS_MIXED); bf16* ACTb = (bf16*)(ws + WS_ACT);
    const float* MODb = (const float*)(ws + WS_MOD);
    const int G = gridDim.x, bx = blockIdx.x;
    const int bxr = ((G & 7) == 0) ? ((G >> 3) - 1 - (bx >> 3)) * 8 + (bx & 7) : G - 1 - bx;
    if (IN(3)) {
        conv_phase(p, tid, (bf16*)(ws + WS_XBC));
        __syncthreads();
        for (int rd = 0; rd * G < 1152; ++rd) { const int u = rd * G + ((rd & 1) ? bxr : bx); if (u >= 1152) continue;
            bool us; int ub, uq;
            if (u < 128) { us = true; ub = u >> 2; uq = u & 3; } else { const int v = u - 128; us = false; ub = v & 7; uq = 127 - (v >> 3); }
            topk_unit(lds, tid, lane, wave, us, ub, uq, QIb, KIPb, KISb, (const float*)(ws + WS_WI), MASKb); }
    }
    SEAM(3);
    if (IN(4)) {
        for (int rd = 0; rd * G < 2432; ++rd) { const int u = rd * G + ((rd & 1) ? bxr : bx); if (u >= 2432) continue;
            int kind, ub, uc, uh; bool us;
            if (u < 256) { kind = 0; us = false; const int gi = ((u >> 5) << 3) + (u & 7); ub = gi >> 3; uh = ((gi & 7) << 2) + ((u >> 3) & 3); uc = 0; }
            else if (u < 384) { const int v = u - 256; kind = 1; us = true; ub = v >> 2; uh = v & 3; uc = 0; }
            else if (u < 1408) { const int v = u - 384, w = v & 31; kind = 1; us = false; ub = w >> 2; uh = w & 3; uc = 31 - (v >> 5); }
            else { const int v = u - 1408; kind = 0; us = true; const int gi = ((v >> 5) << 3) + (v & 7); ub = gi >> 3; uh = ((gi & 7) << 2) + ((v >> 3) & 3); uc = 0; }
            if (kind == 0) SSDCALL(p, lds, tid, lane, wave, us, ub, uh, (const bf16*)(ws + WS_XBC), (const float*)(ws + WS_DT), Zb, SSQb);
            else ATTCALL(lds, tid, lane, wave, us, ub, uc, uh, Qb, (const bf16*)(ws + WS_KP), (const bf16*)(ws + WS_KS), (const bf16*)(ws + WS_VTP), (const bf16*)(ws + WS_VTS), p.in[2], p.in[3], MASKb); }
    }
    SEAM(4);
    if (IN(5)) {
        ynorm_phase(p, lane, wave, Zb, SSQb);
        __syncthreads();
        { pg8::Gemm g{Hb, (const bf16*)(ws + WS_WG), TT, 2048, DM}; pg8::StaticOrder S; S.init(TT, 2048, G, bx);
          EpiGates E{GATESb};
          pg8::gemm_phase<EpiGates, pg8::StaticOrder, true, true>(lds, g, S, E); }
        { pg8::Gemm g{Qb, (const bf16*)(ws + WS_WBA), TT, DM, DM}; pg8::StaticOrder S; S.init(TT, DM, G, G - 1 - bx);
          EpiP1 E{GATESb, P1b};
          pg8::gemm_phase<EpiP1, pg8::StaticOrder, true, true>(lds, g, S, E); }
    }
    SEAM(5);
    if (IN(7)) {
        pg8::Gemm g{Zb, (const bf16*)(ws + WS_WBS), TT, DM, DINNER}; pg8::StaticOrder S; S.init(TT, DM, G, bx);
        EpiMixed E{GATESb, P1b, MXb};
        pg8::gemm_phase<EpiMixed, pg8::StaticOrder, true, true>(lds, g, S, E);
    }
    SEAM(7);
    if (IN(8)) {
        pg8::Gemm g{MXb, (const bf16*)(ws + WS_WOUT), TT, DM, DM}; pg8::StaticOrder S; S.init(TT, DM, G, bx);
        EpiRes E{p.in[0], p.in[1], MODb, 2048, p.out};
        pg8::gemm_phase<EpiRes, pg8::StaticOrder, true, true>(lds, g, S, E);
    }
    SEAM(8);
    if (IN(9)) normmod_phase<false>(p, lds, tid, lane, wave, p.out, p.out + (size_t)TP * DM, p.in[12], 3072, 4096, Hb);
    SEAM(9);
    if (IN(10)) {
        pg8::Gemm g{Hb, (const bf16*)(ws + WS_WGU), TT, 2 * DFF, DM}; pg8::StaticOrder S; S.init(TT, 2 * DFF, G, bx);
        EpiAct E{ACTb};
        pg8::gemm_phase<EpiAct, pg8::StaticOrder, true, true>(lds, g, S, E);
    }
    SEAM(10);
    if (IN(11)) {
        pg8::Gemm g{ACTb, (const bf16*)(ws + WS_WDN), TT, DM, DFF}; pg8::StaticOrder S; S.init(TT, DM, G, bx);
        EpiRes E{p.out, p.out + (size_t)TP * DM, MODb, 5120, p.out};
        pg8::gemm_phase<EpiRes, pg8::StaticOrder, true, true>(lds, g, S, E);
    }
#undef IN
#undef SEAM
}

extern "C" void kernel_launch(void* const* d_in, const int* in_sizes, int n_in, void* d_out, int out_size, void* d_ws, size_t ws_size, hipStream_t stream) {
    static int grid = 0;
    if (grid == 0) {
        if (n_in != 27 || ws_size < WS_END) { fprintf(stderr, "kernel_launch: unexpected n_in %d / ws %zu\n", n_in, ws_size); grid = -1; return; }
        int dev = 0, cus = 0, per_cu = 0;
        hipGetDevice(&dev); hipDeviceGetAttribute(&cus, hipDeviceAttributeMultiprocessorCount, dev);
        hipFuncSetAttribute((const void*)mega, hipFuncAttributeMaxDynamicSharedMemorySize, LDS_BYTES);
        hipOccupancyMaxActiveBlocksPerMultiprocessor(&per_cu, (const void*)mega, 512, LDS_BYTES);
        (void)hipGetLastError();
        if (per_cu < 1) per_cu = 1;
        grid = cus;
    }
    if (grid < 0) return;
    Params prm{};
    for (int i = 0; i < 27; ++i) prm.in[i] = (const float*)d_in[i];
    prm.out = (float*)d_out; prm.ws = (unsigned char*)d_ws; prm.ph_lo = 0; prm.ph_hi = NPHASES;
    (void)hipMemsetAsync((char*)d_ws + WS_CTL, 0, 16384, stream);
    void* args[] = {&prm};
    hipError_t e = hipLaunchCooperativeKernel((const void*)mega, dim3(grid), dim3(512), args, LDS_BYTES, stream);
    if (e != hipSuccess) fprintf(stderr, "cooperative launch failed: %s (grid %d)\n", hipGetErrorString(e), grid);
}
```

```cpp
#include <hip/hip_runtime.h>
#include <hip/hip_cooperative_groups.h>
#include <cstdio>
#include <cstdint>
namespace cg = cooperative_groups;

namespace pg8 {
#define PG8_LAS __attribute__((address_space(3)))
typedef unsigned short bf16_t;
typedef short bf16x8 __attribute__((ext_vector_type(8)));
typedef float f32x4 __attribute__((ext_vector_type(4)));
typedef unsigned u32x4 __attribute__((ext_vector_type(4)));
constexpr int BM = 256, BK = 64, HALF = 128, HTB = HALF * BK * 2  , STAGE_BYTES = 8 * HTB, NXCD = 8, WGM = 8;

__host__ __device__ __forceinline__ int lds_byte(int r, int c) { const int st = (r >> 4) * 2 + (c >> 5), rr = r & 15, cc = c & 31, ob = rr * 64 + cc * 2; return st * 1024 + (ob ^ (((ob >> 9) & 1) << 5)); }
__host__ __device__ __forceinline__ void stage_rc(int b, int& R, int& C) { const int st = b / 1024, sb = b % 1024, swz = sb ^ (((sb >> 9) & 1) << 5); R = (st >> 1) * 16 + swz / 64; C = (st & 1) * 32 + (swz % 64) / 2; }
__host__ __device__ __forceinline__ int perm32(int rho) { const int n = rho >> 4, i = rho & 15; return 8 * (i >> 2) + 4 * n + (i & 3); }

struct Unit { int pm, pn; };
struct Gemm { const bf16_t* A; const bf16_t* Bt; int M, N, K; int ld = 0; int ncol = 0; };

struct StaticOrder {
    int nM, nN, nwg, G, c;
    __host__ __device__ void init(int M, int N, int G_, int c_) { nM = M / BM; nN = N / BM; nwg = nM * nN; G = G_; c = c_; }
    __host__ __device__ bool next(int i, Unit& u) const {
        const long L = (long)i * G + c; if (L >= nwg) return false;
        int wgid = (int)L; { const int q = nwg / NXCD, r = nwg % NXCD, xcd = wgid % NXCD, off = wgid / NXCD; wgid = (xcd < r ? xcd * (q + 1) : r * (q + 1) + (xcd - r) * q) + off; }
        const int nig = WGM * nN, gid = wgid / nig, fm = gid * WGM, gsz = (nM - fm) < WGM ? (nM - fm) : WGM;
        u.pm = fm + ((wgid % nig) % gsz); u.pn = (wgid % nig) / gsz; return true;
    }
    __device__ __forceinline__ void a_ready(const Unit&) const {}
    __device__ __forceinline__ void done(const Unit&) const {}
};
typedef float f32x2_t __attribute__((ext_vector_type(2)));
typedef __bf16 bf16x2_t __attribute__((ext_vector_type(2)));
__device__ __forceinline__ unsigned cvt_pk_bf16(float lo, float hi) { const bf16x2_t r = __builtin_convertvector((f32x2_t){lo, hi}, bf16x2_t); unsigned u; __builtin_memcpy(&u, &r, 4); return u; }
template <class Epi, class Sched, bool ALIGN_EPI = false, bool SP2 = false>
__device__ __forceinline__ void gemm_phase(PG8_LAS unsigned char* lds, const Gemm g, const Sched& S, const Epi& E) {
    const int tid = threadIdx.x, wid = __builtin_amdgcn_readfirstlane(tid >> 6), lane = tid & 63, wr = wid >> 2, wc = wid & 3, fr = lane & 15, fq = lane >> 4;
    const int K = g.ld ? g.ld : g.K, nt = g.K / BK;
    const int ncol = g.ncol ? g.ncol : (1 << 30); const size_t ksplit = (size_t)g.K * 2;
    unsigned voffA[2], voffB[2];
#pragma unroll
    for (int i = 0; i < 2; ++i) { int R, C; stage_rc(tid * 16 + i * 8192, R, C); const int Rb = Epi::PERM ? ((R & ~31) + perm32(R & 31)) : R;
        voffA[i] = (unsigned)(R * K + C) * 2u; voffB[i] = (unsigned)(Rb * K + C) * 2u; }
    const size_t kstep = (size_t)(BK * 2);
    const size_t hstep = (size_t)HALF * K * 2;
    const size_t tstep = 2 * hstep;
    const unsigned ldsw = (unsigned)wid * 1024u;
    const int aoff = lds_byte(wr * 64 + fr, fq * 8), boff = lds_byte(wc * 32 + fr, fq * 8);
#define PG8_SA(b, h) (((b) * 2 + (h)) * HTB)
#define PG8_SB(b, h) ((4 + (b) * 2 + (h)) * HTB)
#define PG8_STAGE(bufoff, gbase, voff) do { _Pragma("unroll") for (int _i = 0; _i < 2; ++_i) \
        __builtin_amdgcn_global_load_lds((const unsigned*)((const char*)(gbase) + (voff)[_i]), (PG8_LAS unsigned*)(lds + (bufoff) + ldsw + _i * 8192), 16, 0, 0); } while (0)
#define PG8_LDA(dst, b, h) do { _Pragma("unroll") for (int m = 0; m < 4; ++m) _Pragma("unroll") for (int k = 0; k < 2; ++k) dst[m][k] = *(const PG8_LAS bf16x8*)(lds + PG8_SA(b, h) + aoff + m * 2048 + k * 1024); } while (0)
#define PG8_LDB(dst, b, h) do { _Pragma("unroll") for (int n = 0; n < 2; ++n) _Pragma("unroll") for (int k = 0; k < 2; ++k) dst[n][k] = *(const PG8_LAS bf16x8*)(lds + PG8_SB(b, h) + boff + n * 2048 + k * 1024); } while (0)
#define PG8_MMA(ai, bj, At, Bt) do { __builtin_amdgcn_s_setprio(1); _Pragma("unroll") for (int m = 0; m < 4; ++m) _Pragma("unroll") for (int n = 0; n < 2; ++n) _Pragma("unroll") for (int k = 0; k < 2; ++k) \
        acc[ai][bj][m][n] = __builtin_amdgcn_mfma_f32_16x16x32_bf16(Bt[n][k], At[m][k], acc[ai][bj][m][n], 0, 0, 0); __builtin_amdgcn_s_setprio(0); } while (0)
#define PG8_WAIT_V(n) asm volatile("s_waitcnt vmcnt(" #n ")" ::: "memory")
#define PG8_WAIT_L(n) asm volatile("s_waitcnt lgkmcnt(" #n ")" ::: "memory")
#define PG8_BAR __builtin_amdgcn_s_barrier()
#define PG8_SCHED __builtin_amdgcn_sched_barrier(0)
    Unit cur, nxt; int ui = 0;
    if (!S.next(0, cur)) return;
    f32x4 acc[2][2][4][2];
#pragma unroll
    for (int a = 0; a < 2; ++a)
#pragma unroll
        for (int b = 0; b < 2; ++b)
#pragma unroll
            for (int m = 0; m < 4; ++m)
#pragma unroll
                for (int n = 0; n < 2; ++n) acc[a][b][m][n] = (f32x4){0.f, 0.f, 0.f, 0.f};
    bf16x8 At[4][2], B0[2][2], B1[2][2];
    const char* cA = (const char*)g.A + (size_t)cur.pm * tstep + (size_t)(cur.pn / ncol) * ksplit; const char* cB = (const char*)g.Bt + (size_t)(cur.pn % ncol) * tstep + (size_t)(cur.pn / ncol) * ksplit;
    S.a_ready(cur);
    if constexpr (SP2) {
        PG8_STAGE(PG8_SB(0, 0), cB, voffB); PG8_STAGE(PG8_SB(0, 1), cB + hstep, voffB); PG8_STAGE(PG8_SA(0, 0), cA, voffA); PG8_STAGE(PG8_SA(0, 1), cA + hstep, voffA);
        if (wr == 1) PG8_BAR;
        PG8_WAIT_V(2); PG8_BAR;
        PG8_STAGE(PG8_SB(1, 0), cB + kstep, voffB); PG8_STAGE(PG8_SA(1, 0), cA + kstep, voffA); PG8_STAGE(PG8_SB(1, 1), cB + hstep + kstep, voffB);
        PG8_WAIT_V(6); PG8_BAR;
    } else {
        PG8_STAGE(PG8_SB(0, 0), cB, voffB); PG8_STAGE(PG8_SA(0, 0), cA, voffA); PG8_STAGE(PG8_SB(0, 1), cB + hstep, voffB); PG8_STAGE(PG8_SA(0, 1), cA + hstep, voffA);
        if (wr == 1) PG8_BAR;
        PG8_WAIT_V(4); PG8_BAR;
        PG8_STAGE(PG8_SB(1, 0), cB + kstep, voffB); PG8_STAGE(PG8_SA(1, 0), cA + kstep, voffA); PG8_STAGE(PG8_SB(1, 1), cB + hstep + kstep, voffB);
        PG8_WAIT_V(6); PG8_BAR;
    }
    for (;;) {
        const bool has_next = S.next(ui + 1, nxt);
        const char* nA = has_next ? (const char*)g.A + (size_t)nxt.pm * tstep + (size_t)(nxt.pn / ncol) * ksplit : cA; const char* nB = has_next ? (const char*)g.Bt + (size_t)(nxt.pn % ncol) * tstep + (size_t)(nxt.pn / ncol) * ksplit : cB;
        for (int t = 0; t < nt; t += 2) {
            const bool last = (t == nt - 2);
            const char* a1 = cA + (size_t)(t + 1) * kstep;
            const char* a2 = last ? nA : cA + (size_t)(t + 2) * kstep; const char* b2 = last ? nB : cB + (size_t)(t + 2) * kstep;
            const char* a3 = a2 + kstep; const char* b3 = b2 + kstep;
            if (last && has_next) S.a_ready(nxt);
            if constexpr (SP2) {
            PG8_LDB(B0, 0, 0); PG8_LDB(B1, 0, 1); PG8_SCHED; PG8_LDA(At, 0, 0); PG8_STAGE(PG8_SA(1, 1), a1 + hstep, voffA);
            PG8_WAIT_V(8); PG8_WAIT_L(0); PG8_BAR; PG8_MMA(0, 0, At, B0); PG8_MMA(0, 1, At, B1); PG8_BAR; PG8_SCHED;
            PG8_LDA(At, 0, 1); PG8_STAGE(PG8_SB(0, 0), b2, voffB); PG8_STAGE(PG8_SB(0, 1), b2 + hstep, voffB); PG8_STAGE(PG8_SA(0, 0), a2, voffA);
            PG8_WAIT_V(8); PG8_WAIT_L(0); PG8_BAR; PG8_MMA(1, 0, At, B0); PG8_MMA(1, 1, At, B1); PG8_BAR; PG8_SCHED;
            PG8_LDB(B0, 1, 0); PG8_LDB(B1, 1, 1); PG8_SCHED; PG8_LDA(At, 1, 0); PG8_STAGE(PG8_SA(0, 1), a2 + hstep, voffA);
            PG8_WAIT_V(8); PG8_WAIT_L(0); PG8_BAR; PG8_MMA(0, 0, At, B0); PG8_MMA(0, 1, At, B1); PG8_BAR; PG8_SCHED;
            PG8_LDA(At, 1, 1); PG8_STAGE(PG8_SB(1, 0), b3, voffB); PG8_STAGE(PG8_SB(1, 1), b3 + hstep, voffB); PG8_STAGE(PG8_SA(1, 0), a3, voffA);
            PG8_WAIT_V(8); PG8_WAIT_L(0); PG8_BAR; PG8_MMA(1, 0, At, B0); PG8_MMA(1, 1, At, B1); PG8_BAR; PG8_SCHED;
            } else {
            PG8_LDB(B0, 0, 0); PG8_SCHED; PG8_LDA(At, 0, 0); PG8_STAGE(PG8_SA(1, 1), a1 + hstep, voffA);
            PG8_WAIT_L(8); PG8_BAR; PG8_WAIT_L(0); PG8_MMA(0, 0, At, B0); PG8_BAR; PG8_SCHED;
            PG8_LDB(B1, 0, 1); PG8_STAGE(PG8_SB(0, 0), b2, voffB);
            PG8_BAR; PG8_WAIT_L(0); PG8_MMA(0, 1, At, B1); PG8_BAR;
            PG8_LDA(At, 0, 1); PG8_STAGE(PG8_SA(0, 0), a2, voffA);
            PG8_BAR; PG8_WAIT_L(0); PG8_MMA(1, 0, At, B0); PG8_BAR; PG8_SCHED;
            PG8_STAGE(PG8_SB(0, 1), b2 + hstep, voffB);
            PG8_WAIT_V(6); PG8_BAR; PG8_MMA(1, 1, At, B1); PG8_BAR;
            PG8_LDB(B0, 1, 0); PG8_SCHED; PG8_LDA(At, 1, 0); PG8_STAGE(PG8_SA(0, 1), a2 + hstep, voffA);
            PG8_WAIT_L(8); PG8_BAR; PG8_WAIT_L(0); PG8_MMA(0, 0, At, B0); PG8_BAR; PG8_SCHED;
            PG8_LDB(B1, 1, 1); PG8_STAGE(PG8_SB(1, 0), b3, voffB);
            PG8_BAR; PG8_WAIT_L(0); PG8_MMA(0, 1, At, B1); PG8_BAR;
            PG8_LDA(At, 1, 1); PG8_STAGE(PG8_SA(1, 0), a3, voffA);
            PG8_BAR; PG8_WAIT_L(0); PG8_MMA(1, 0, At, B0); PG8_BAR; PG8_SCHED;
            PG8_STAGE(PG8_SB(1, 1), b3 + hstep, voffB);
            PG8_WAIT_V(6); PG8_BAR; PG8_MMA(1, 1, At, B1); PG8_BAR;
            }
        }
        if constexpr (ALIGN_EPI) { if (wr == 0) PG8_BAR; }
        if constexpr (!Epi::AFTER_DRAIN) { E(acc, cur, wr, wc, fr, fq); S.done(cur); }
        if (!has_next) break;
#pragma unroll
        for (int a = 0; a < 2; ++a)
#pragma unroll
            for (int b = 0; b < 2; ++b)
#pragma unroll
                for (int m = 0; m < 4; ++m)
#pragma unroll
                    for (int n = 0; n < 2; ++n) acc[a][b][m][n] = (f32x4){0.f, 0.f, 0.f, 0.f};
        cur = nxt; cA = nA; cB = nB; ++ui;
        if constexpr (ALIGN_EPI) { if (wr == 1) PG8_BAR; }
    }
    PG8_WAIT_V(0);
    if constexpr (!ALIGN_EPI) { if (wr == 0) PG8_BAR; }
    PG8_BAR;
    if constexpr (Epi::AFTER_DRAIN) { E.fused(acc, cur, wr, wc, fr, fq, lds, wid, lane); S.done(cur); }
#undef PG8_SA
#undef PG8_SB
#undef PG8_STAGE
#undef PG8_LDA
#undef PG8_LDB
#undef PG8_MMA
#undef PG8_WAIT_V
#undef PG8_WAIT_L
#undef PG8_BAR
#undef PG8_SCHED
}
}

constexpr int DM = 1024, NBP = 8, SEQ = 2048, NBS = 32, DSEQ = 64, PAST = 2048;
constexpr int TP = NBP * SEQ, TS = NBS * DSEQ, TT = TP + TS;
constexpr int NKP = 2048, NKS = 2112;
constexpr int DFF = 2816, DINNER = 2048, CONVC = 4096;
constexpr int IN_DIM = 10344;
constexpr int CQ = 0, CK = 1024, CV = 1280, CQI = 1536, CKI = 2048, CWI = 2112, CZ = 2120, CXBC = 4168, CDT = 8264, CGATE = 8296;
constexpr int NIN = 33 * 256;
constexpr float EPS = 1e-6f;
constexpr int MASKW = 68;
constexpr size_t O_Y = 0, O_KP = 18874368, O_VP = 23068672, O_KIP = 27262976, O_CONVP = 28311552, O_SSMP = 28409856,
                 O_KS = 30507008, O_VS = 31031296, O_KIS = 31555584, O_CONVS = 31686656, O_SSMS = 32079872;
constexpr size_t MiB = 1u << 20;
constexpr size_t WS_CTL = 0, WS_MOD = 1 * MiB, WS_ROPE = 2 * MiB, WS_WI = 3 * MiB, WS_DT = 4 * MiB;
constexpr size_t WS_WBA = 8 * MiB, WS_WOUT = 10 * MiB, WS_WBS = 12 * MiB, WS_WGU = 16 * MiB, WS_WDN = 27 * MiB, WS_WG = 33 * MiB, WS_WIN = 37 * MiB;
constexpr size_t WS_MASK = 37 * MiB, WS_SSQ = 43 * MiB;
constexpr size_t WS_H = 54 * MiB, WS_Q = 90 * MiB, WS_KP = 126 * MiB, WS_KS = 134 * MiB, WS_VTP = 167 * MiB, WS_VTS = 175 * MiB, WS_XBC = 208 * MiB;
constexpr size_t WS_PART = WS_XBC;
constexpr size_t WS_GATES = 208 * MiB, WS_P1 = 280 * MiB, WS_MIXED = 316 * MiB, WS_ACT = 208 * MiB, WS_END = 352 * MiB;
constexpr int LDS_BYTES = 147456;

#define LAS __attribute__((address_space(3)))
typedef unsigned short bf16;
typedef unsigned v4u __attribute__((ext_vector_type(4)));
typedef unsigned v2u __attribute__((ext_vector_type(2)));
typedef float f32x4 __attribute__((ext_vector_type(4)));
typedef float f32x16 __attribute__((ext_vector_type(16)));
typedef short bf16x8 __attribute__((ext_vector_type(8)));
typedef short bf16x4 __attribute__((ext_vector_type(4)));
using pg8::cvt_pk_bf16;
#define LDS_WAIT() asm volatile("s_waitcnt lgkmcnt(0)" ::: "memory")
__device__ __forceinline__ float bf2f(unsigned h) { return __uint_as_float(h << 16); }
__device__ __forceinline__ float wave_sum(float v) {
#pragma unroll
    for (int o = 1; o < 64; o <<= 1) v += __shfl_xor(v, o);
    return v;
}
__device__ __forceinline__ float silu_f(float v) { return v * __builtin_amdgcn_rcpf(1.f + __expf(-v)); }
__device__ __forceinline__ float sigmoid_f(float v) { return __builtin_amdgcn_rcpf(1.f + __expf(-v)); }
__device__ __forceinline__ v4u pack8(const float* a) { v4u o; o.x = cvt_pk_bf16(a[0], a[1]); o.y = cvt_pk_bf16(a[2], a[3]); o.z = cvt_pk_bf16(a[4], a[5]); o.w = cvt_pk_bf16(a[6], a[7]); return o; }

struct Params { const float* in[27]; float* out; unsigned char* ws; int ph_lo, ph_hi; };

__device__ __forceinline__ void tr_item(const float* __restrict__ W, int ldw, int srccol, int nvalid, bf16* WT, size_t ldd, int dstrow, int k0, LAS float* scr, int lane) {
#pragma unroll 8
    for (int i = 0; i < 32; ++i) { const int kk = 2 * i + (lane >> 5), c = lane & 31; scr[kk * 33 + c] = (c < nvalid) ? W[(size_t)(k0 + kk) * ldw + srccol + c] : 0.f; }
    LDS_WAIT();
    const int c = lane & 7;
#pragma unroll
    for (int j = 0; j < 4; ++j) { const int n = (lane >> 3) + 8 * j; const LAS float* s = scr + (8 * c) * 33 + n;
        v4u o; o.x = cvt_pk_bf16(s[0 * 33], s[1 * 33]); o.y = cvt_pk_bf16(s[2 * 33], s[3 * 33]); o.z = cvt_pk_bf16(s[4 * 33], s[5 * 33]); o.w = cvt_pk_bf16(s[6 * 33], s[7 * 33]);
        *(v4u*)(WT + (size_t)(dstrow + n) * ldd + k0 + 8 * c) = o; }
    LDS_WAIT();
}

__device__ __forceinline__ void phase0(const Params& p, LAS unsigned char* lds, int tid, int lane, int wave) {
    const int G = gridDim.x, bx = blockIdx.x;
    unsigned char* ws = p.ws;
    {
        LAS float* sc = (LAS float*)lds;
        const float* w_ada = p.in[9];
        float* part = (float*)(ws + WS_PART);
        for (int it = bx; it < 192; it += G) {
            const int ks = it / 24, cb = it % 24;
            __syncthreads();
            for (int i = tid; i < 40 * 128; i += 512) { const int r = i >> 7, k = i & 127; const float c = (r < 8) ? p.in[7][r * DM + ks * 128 + k] : p.in[8][(r - 8) * DM + ks * 128 + k]; sc[i] = silu_f(c); }
            __syncthreads();
            const int col = cb * 256 + (tid & 255), rh = tid >> 8;
            float a[20];
#pragma unroll
            for (int r = 0; r < 20; ++r) a[r] = 0.f;
            const float* wp = w_ada + (size_t)(ks * 128) * 6144 + col;
            for (int k0 = 0; k0 < 128; k0 += 8) {
                float w8[8];
#pragma unroll
                for (int i = 0; i < 8; ++i) w8[i] = wp[(size_t)(k0 + i) * 6144];
#pragma unroll
                for (int r = 0; r < 20; ++r) { const f32x4 s0 = *(const LAS f32x4*)(sc + (rh * 20 + r) * 128 + k0), s1 = *(const LAS f32x4*)(sc + (rh * 20 + r) * 128 + k0 + 4);
                    a[r] += (s0[0] * w8[0] + s0[1] * w8[1]) + (s0[2] * w8[2] + s0[3] * w8[3]) + (s1[0] * w8[4] + s1[1] * w8[5]) + (s1[2] * w8[6] + s1[3] * w8[7]); }
            }
#pragma unroll
            for (int r = 0; r < 20; ++r) part[((size_t)ks * 40 + rh * 20 + r) * 6144 + col] = a[r];
        }
        __syncthreads();
    }
    {
        LAS float* scr = (LAS float*)(lds + wave * 8704);
        const int gw = bx * 8 + wave, NGW = G * 8;
        constexpr int I_IN = 16 * 264, I_G = 16 * 64, I_BA = 16 * 32, I_OUT = 16 * 32, I_BS = 32 * 32, I_GU = 16 * 176, I_DN = 44 * 32;
        constexpr int NIT = I_IN + I_G + I_BA + I_OUT + I_BS + I_GU + I_DN;
        for (int it = gw; it < NIT; it += NGW) {
            int r = it;
            if (r < I_IN) { const int kb = r / 264, rg = r % 264, pn = rg >> 3, w8 = rg & 7, bj = w8 >> 2, wc = w8 & 3; int src, nv = 32;
                if (pn < 8) src = 256 * pn + 64 * wc + 32 * bj;
                else if (pn == 8) { if (wc == 0) src = CKI + 32 * bj; else if (wc == 1) { if (bj == 0) { src = CWI; nv = 8; } else src = CDT; } else { src = 0; nv = 0; } }
                else if (pn < 17) src = CZ + (rg - 72) * 32; else src = CXBC + (rg - 136) * 32;
                tr_item(p.in[13], IN_DIM, src, nv, (bf16*)(ws + WS_WIN), 1024, rg * 32, kb * 64, scr, lane); continue; } r -= I_IN;
            if (r < I_G) { const int kb = r / 64, rg = r % 64; tr_item(p.in[13], IN_DIM, CGATE + rg * 32, 32, (bf16*)(ws + WS_WG), 1024, rg * 32, kb * 64, scr, lane); continue; } r -= I_G;
            if (r < I_BA) { const int kb = r / 32, rg = r % 32; tr_item(p.in[22], 1024, rg * 32, 32, (bf16*)(ws + WS_WBA), 1024, rg * 32, kb * 64, scr, lane); continue; } r -= I_BA;
            if (r < I_OUT) { const int kb = r / 32, rg = r % 32; tr_item(p.in[24], 1024, rg * 32, 32, (bf16*)(ws + WS_WOUT), 1024, rg * 32, kb * 64, scr, lane); continue; } r -= I_OUT;
            if (r < I_BS) { const int kb = r / 32, rg = r % 32; tr_item(p.in[23], 1024, rg * 32, 32, (bf16*)(ws + WS_WBS), 2048, rg * 32, kb * 64, scr, lane); continue; } r -= I_BS;
            if (r < I_GU) { const int kb = r / 176, rg = r % 176, pt = rg >> 3, w8 = rg & 7, half = w8 >> 2, r4 = w8 & 3;
                tr_item(p.in[25], 2 * DFF, half * DFF + 128 * pt + 32 * r4, 32, (bf16*)(ws + WS_WGU), 1024, rg * 32, kb * 64, scr, lane); continue; } r -= I_GU;
            { const int kb = r / 32, rg = r % 32; tr_item(p.in[26], 1024, rg * 32, 32, (bf16*)(ws + WS_WDN), DFF, rg * 32, kb * 64, scr, lane); }
        }
    }
    {
        const int gt = bx * 512 + tid, NGT = G * 512;
        const float* cki = p.in[4]; bf16* KIS = (bf16*)(p.out + O_SSMS) + (size_t)TT * 512 + (size_t)NBP * NKP * 64;
        for (int i = gt; i < 524288; i += NGT) { const size_t e = (size_t)i * 8; const int d = (int)(e & 63), s = (int)((e >> 6) & 2047), b = (int)(e >> 17);
            const f32x4 x0 = *(const f32x4*)(cki + e), x1 = *(const f32x4*)(cki + e + 4);
            v4u o; o.x = cvt_pk_bf16(x0[0], x0[1]); o.y = cvt_pk_bf16(x0[2], x0[3]); o.z = cvt_pk_bf16(x1[0], x1[1]); o.w = cvt_pk_bf16(x1[2], x1[3]);
            *(v4u*)(KIS + ((size_t)b * NKS + s) * 64 + d) = o; }
        float* rope = (float*)(ws + WS_ROPE);
        for (int i = gt; i < NKS * 32; i += NGT) { const int pos = i >> 5, j = i & 31;
            double invd = 1.0; for (int k = 0; k < j; ++k) invd *= 0.74989420933245582;
            const float inv = (float)invd; const float ang = (float)pos * inv;
            const double x = (double)ang; const double q = __builtin_rint(x * 0.63661977236758134); const double r = x - q * 1.5707963267948966; const double r2 = r * r;
            const double sn = r * (1.0 + r2 * (-1.0 / 6 + r2 * (1.0 / 120 + r2 * (-1.0 / 5040 + r2 * (1.0 / 362880 + r2 * (-1.0 / 39916800))))));
            const double cs = 1.0 + r2 * (-0.5 + r2 * (1.0 / 24 + r2 * (-1.0 / 720 + r2 * (1.0 / 40320 + r2 * (-1.0 / 3628800 + r2 * (1.0 / 479001600))))));
            const int iq = ((int)q) & 3; double so, co;
            if (iq == 0) { so = sn; co = cs; } else if (iq == 1) { so = cs; co = -sn; } else if (iq == 2) { so = -sn; co = -cs; } else { so = -cs; co = sn; }
            rope[i] = (float)co; rope[NKS * 32 + i] = (float)so; }
    }
}

template <bool FROM_PART>
__device__ __forceinline__ void normmod_phase(const Params& p, LAS unsigned char* lds, int tid, int lane, int wave, const float* xp, const float* xs, const float* g, int off_sh, int off_sc, bf16* H) {
    const int bx = blockIdx.x, G = gridDim.x;
    unsigned char* ws = p.ws;
    const float* part = (const float*)(ws + WS_PART); const float* b_ada = p.in[10]; float* MOD = (float*)(ws + WS_MOD);
    LAS float* lsh = (LAS float*)lds; LAS float* lsc = lsh + 1024;
    if (FROM_PART) {
        for (int it = bx; it < 240; it += G) { const int row = it / 6, seg = it % 6;
            for (int c = tid; c < 1024; c += 512) { float v = b_ada[seg * 1024 + c];
#pragma unroll
                for (int ks = 0; ks < 8; ++ks) v += part[((size_t)ks * 40 + row) * 6144 + seg * 1024 + c];
                MOD[row * 6144 + seg * 1024 + c] = v; } }
    }
    const int rows_per = (TT + G - 1) / G;
    const int r_lo = bx * rows_per, r_hi = (r_lo + rows_per < TT) ? r_lo + rows_per : TT;
    int r = r_lo;
    while (r < r_hi) {
        const int mrow = (r < TP) ? (r >> 11) : 8 + ((r - TP) >> 6);
        const int gend = (r < TP) ? ((r >> 11) + 1) << 11 : TP + ((((r - TP) >> 6) + 1) << 6);
        const int e = gend < r_hi ? gend : r_hi;
        __syncthreads();
        for (int c = tid; c < 1024; c += 512) {
            float vsh, vsc;
            if (FROM_PART) { vsh = b_ada[off_sh + c]; vsc = b_ada[off_sc + c];
#pragma unroll
                for (int ks = 0; ks < 8; ++ks) { vsh += part[((size_t)ks * 40 + mrow) * 6144 + off_sh + c]; vsc += part[((size_t)ks * 40 + mrow) * 6144 + off_sc + c]; } }
            else { vsh = MOD[mrow * 6144 + off_sh + c]; vsc = MOD[mrow * 6144 + off_sc + c]; }
            lsh[c] = vsh; lsc[c] = (1.f + vsc) * g[c];
        }
        __syncthreads();
        for (int row = r + wave; row < e; row += 8) {
            const float* xr = (row < TP) ? xp + (size_t)row * DM : xs + (size_t)(row - TP) * DM;
            f32x4 v[4]; float s = 0.f;
#pragma unroll
            for (int j = 0; j < 4; ++j) { v[j] = *(const f32x4*)(xr + 4 * lane + 256 * j); s += (v[j][0] * v[j][0] + v[j][1] * v[j][1]) + (v[j][2] * v[j][2] + v[j][3] * v[j][3]); }
            const float rstd = rsqrtf(wave_sum(s) * (1.f / DM) + EPS);
#pragma unroll
            for (int j = 0; j < 4; ++j) { const int c = 4 * lane + 256 * j; const f32x4 a = *(const LAS f32x4*)(lsc + c), b = *(const LAS f32x4*)(lsh + c);
                v2u o; o.x = cvt_pk_bf16(v[j][0] * rstd * a[0] + b[0], v[j][1] * rstd * a[1] + b[1]); o.y = cvt_pk_bf16(v[j][2] * rstd * a[2] + b[2], v[j][3] * rstd * a[3] + b[3]);
                *(v2u*)(H + (size_t)row * DM + c) = o; }
        }
        r = e;
    }
    __syncthreads();
}

#define EPI_ROWS_BEGIN \
    _Pragma("unroll") for (int ai = 0; ai < 2; ++ai) _Pragma("unroll") for (int m = 0; m < 4; ++m) { \
        const int row = u.pm * 256 + ai * 128 + wr * 64 + m * 16 + fr; float a[8], b[8]; \
        _Pragma("unroll") for (int e = 0; e < 4; ++e) { a[e] = acc[ai][0][m][0][e]; a[4 + e] = acc[ai][0][m][1][e]; b[e] = acc[ai][1][m][0][e]; b[4 + e] = acc[ai][1][m][1][e]; }
#define EPI_ROWS_END }

#define EPI_LOADROW(AI, M) { _Pragma("unroll") for (int e = 0; e < 4; ++e) { a[e] = acc[AI][0][M][0][e]; a[4 + e] = acc[AI][0][M][1][e]; b[e] = acc[AI][1][M][0][e]; b[4 + e] = acc[AI][1][M][1][e]; } }
#define EPI_ROWS_LOOP_BEGIN \
    _Pragma("unroll 1") for (int rr = 0; rr < 8; ++rr) { \
        const int row = u.pm * 256 + (rr >> 2) * 128 + wr * 64 + (rr & 3) * 16 + fr; float a[8], b[8]; \
        switch (rr) { case 0: EPI_LOADROW(0, 0) break; case 1: EPI_LOADROW(0, 1) break; case 2: EPI_LOADROW(0, 2) break; case 3: EPI_LOADROW(0, 3) break; \
                      case 4: EPI_LOADROW(1, 0) break; case 5: EPI_LOADROW(1, 1) break; case 6: EPI_LOADROW(1, 2) break; default: EPI_LOADROW(1, 3) break; }

struct EpiIn {
    static constexpr bool PERM = true, AFTER_DRAIN = false;
    bf16 *Q, *KP, *KS, *VTP, *VTS, *QI, *KIP, *KIS, *Z, *XBC; float *WI, *DT, *out; const float *gq, *gk, *dtb, *rope;
    __device__ __forceinline__ void operator()(const f32x4 (&acc)[2][2][4][2], const pg8::Unit& u, int wr, int wc, int fr, int fq) const {
        const int pn = u.pn;
        if (pn == 8 && wc >= 2) return;
        EPI_ROWS_LOOP_BEGIN
            const bool isS = row >= TP; int sb, t, pos;
            if (!isS) { sb = row >> 11; t = row & 2047; pos = t; } else { const int s = row - TP; sb = s >> 6; t = s & 63; pos = PAST + t; }
            if (pn >= 17) {
                const int col = 256 * (pn - 17) + 32 * wc + 8 * fq;
                *(v4u*)(XBC + (size_t)row * CONVC + col) = pack8(a); *(v4u*)(XBC + (size_t)row * CONVC + col + 128) = pack8(b);
                const int L = isS ? DSEQ : SEQ;
                if (t >= L - 3) { float* o = out + (isS ? O_CONVS : O_CONVP) + (size_t)(sb * 3 + (t - (L - 3))) * CONVC + col;
                    *(f32x4*)(o) = (f32x4){a[0], a[1], a[2], a[3]}; *(f32x4*)(o + 4) = (f32x4){a[4], a[5], a[6], a[7]};
                    *(f32x4*)(o + 128) = (f32x4){b[0], b[1], b[2], b[3]}; *(f32x4*)(o + 132) = (f32x4){b[4], b[5], b[6], b[7]}; }
            } else if (pn >= 9) {
                const int col = 256 * (pn - 9) + 32 * wc + 8 * fq;
#pragma unroll
                for (int e = 0; e < 8; ++e) { a[e] = silu_f(a[e]); b[e] = silu_f(b[e]); }
                *(v4u*)(Z + (size_t)row * DINNER + col) = pack8(a); *(v4u*)(Z + (size_t)row * DINNER + col + 128) = pack8(b);
            } else if (pn == 8 && wc == 1) {
                if (fq == 0) { float* w = WI + (size_t)row * 8; const float sc = 0.35355339059327373f * 0.125f;
                    *(f32x4*)w = (f32x4){a[0] * sc, a[1] * sc, a[2] * sc, a[3] * sc}; *(f32x4*)(w + 4) = (f32x4){a[4] * sc, a[5] * sc, a[6] * sc, a[7] * sc}; }
                float d[8];
#pragma unroll
                for (int e = 0; e < 8; ++e) { const float x = b[e] + dtb[8 * fq + e]; d[e] = x > 20.f ? x : log1pf(__expf(x)); }
                float* o = DT + (size_t)row * 32 + 8 * fq; *(f32x4*)o = (f32x4){d[0], d[1], d[2], d[3]}; *(f32x4*)(o + 4) = (f32x4){d[4], d[5], d[6], d[7]};
            } else if (pn == 5) {
                float* o = out + (isS ? O_VS + ((size_t)(row - TP) * 4 + wc) * 64 : O_VP + ((size_t)row * 4 + wc) * 64) + 8 * fq;
                *(f32x4*)(o) = (f32x4){a[0], a[1], a[2], a[3]}; *(f32x4*)(o + 4) = (f32x4){a[4], a[5], a[6], a[7]};
                *(f32x4*)(o + 32) = (f32x4){b[0], b[1], b[2], b[3]}; *(f32x4*)(o + 36) = (f32x4){b[4], b[5], b[6], b[7]};
                bf16* vb = (isS ? VTS + ((size_t)(sb * 4 + wc) * DSEQ + t) * 64 : VTP + ((size_t)(sb * 4 + wc) * NKP + t) * 64) + 8 * fq;
                *(v4u*)vb = pack8(a); *(v4u*)(vb + 32) = pack8(b);
            } else {
                if (pn <= 4) { float ss = 0.f;
#pragma unroll
                    for (int e = 0; e < 8; ++e) ss += a[e] * a[e] + b[e] * b[e];
                    ss += __shfl_xor(ss, 16); ss += __shfl_xor(ss, 32);
                    const float rstd = rsqrtf(ss * (1.f / 64.f) + EPS); const float* g = (pn < 4) ? gq : gk;
#pragma unroll
                    for (int e = 0; e < 8; ++e) { a[e] *= rstd * g[8 * fq + e]; b[e] *= rstd * g[32 + 8 * fq + e]; } }
                { const float* cp = rope + (size_t)pos * 32 + 8 * fq; const float* sp = cp + NKS * 32;
#pragma unroll
                  for (int e = 0; e < 8; ++e) { const float c = cp[e], s = sp[e], x1 = a[e], x2 = b[e]; a[e] = x1 * c - x2 * s; b[e] = x2 * c + x1 * s; } }
                if (pn < 4) { const float qs = 0.125f * 1.4426950408889634f;
#pragma unroll
                    for (int e = 0; e < 8; ++e) { a[e] *= qs; b[e] *= qs; }
                    bf16* q = Q + (size_t)row * DM + (4 * pn + wc) * 64 + 8 * fq; *(v4u*)q = pack8(a); *(v4u*)(q + 32) = pack8(b); }
                else if (pn == 4) {
                    float* o = out + (isS ? O_KS + ((size_t)(row - TP) * 4 + wc) * 64 : O_KP + ((size_t)row * 4 + wc) * 64) + 8 * fq;
                    *(f32x4*)(o) = (f32x4){a[0], a[1], a[2], a[3]}; *(f32x4*)(o + 4) = (f32x4){a[4], a[5], a[6], a[7]};
                    *(f32x4*)(o + 32) = (f32x4){b[0], b[1], b[2], b[3]}; *(f32x4*)(o + 36) = (f32x4){b[4], b[5], b[6], b[7]};
                    bf16* kb = (isS ? KS + ((size_t)(sb * 4 + wc) * DSEQ + t) * 64 : KP + ((size_t)(sb * 4 + wc) * NKP + t) * 64) + 8 * fq;
                    *(v4u*)kb = pack8(a); *(v4u*)(kb + 32) = pack8(b);
                } else if (pn < 8) { bf16* q = QI + (size_t)row * 512 + (4 * (pn - 6) + wc) * 64 + 8 * fq; *(v4u*)q = pack8(a); *(v4u*)(q + 32) = pack8(b); }
                else {
                    float* o = out + (isS ? O_KIS + (size_t)(row - TP) * 64 : O_KIP + (size_t)row * 64) + 8 * fq;
                    *(f32x4*)(o) = (f32x4){a[0], a[1], a[2], a[3]}; *(f32x4*)(o + 4) = (f32x4){a[4], a[5], a[6], a[7]};
                    *(f32x4*)(o + 32) = (f32x4){b[0], b[1], b[2], b[3]}; *(f32x4*)(o + 36) = (f32x4){b[4], b[5], b[6], b[7]};
                    bf16* kb = (isS ? KIS + ((size_t)sb * NKS + pos) * 64 : KIP + (size_t)row * 64) + 8 * fq;
                    *(v4u*)kb = pack8(a); *(v4u*)(kb + 32) = pack8(b);
                }
            }
        EPI_ROWS_END
    }
};

__device__ __forceinline__ void unpack8(const v4u w, float* f) {
    f[0] = __uint_as_float(w.x << 16); f[1] = __uint_as_float(w.x & 0xffff0000u); f[2] = __uint_as_float(w.y << 16); f[3] = __uint_as_float(w.y & 0xffff0000u);
    f[4] = __uint_as_float(w.z << 16); f[5] = __uint_as_float(w.z & 0xffff0000u); f[6] = __uint_as_float(w.w << 16); f[7] = __uint_as_float(w.w & 0xffff0000u);
}
__device__ __forceinline__ int mod_row(int row) { return (row < TP) ? (row >> 11) : 8 + ((row - TP) >> 6); }

struct EpiGates {
    static constexpr bool PERM = true, AFTER_DRAIN = false; bf16* G;
    __device__ __forceinline__ void operator()(const f32x4 (&acc)[2][2][4][2], const pg8::Unit& u, int wr, int wc, int fr, int fq) const {
        EPI_ROWS_BEGIN
            const int col = 256 * u.pn + 32 * wc + 8 * fq;
#pragma unroll
            for (int e = 0; e < 8; ++e) { a[e] = sigmoid_f(a[e]); b[e] = sigmoid_f(b[e]); }
            *(v4u*)(G + (size_t)row * 2048 + col) = pack8(a); *(v4u*)(G + (size_t)row * 2048 + col + 128) = pack8(b);
        EPI_ROWS_END
    }
};
struct EpiP1 {
    static constexpr bool PERM = true, AFTER_DRAIN = false; const bf16* G; bf16* P1;
    __device__ __forceinline__ void operator()(const f32x4 (&acc)[2][2][4][2], const pg8::Unit& u, int wr, int wc, int fr, int fq) const {
        EPI_ROWS_BEGIN
            const int col = 256 * u.pn + 32 * wc + 8 * fq;
            *(v4u*)(P1 + (size_t)row * DM + col) = pack8(a); *(v4u*)(P1 + (size_t)row * DM + col + 128) = pack8(b);
        EPI_ROWS_END
    }
};
struct EpiMixed {
    static constexpr bool PERM = true, AFTER_DRAIN = false; const bf16* G; const bf16* P1; bf16* MX;
    __device__ __forceinline__ void operator()(const f32x4 (&acc)[2][2][4][2], const pg8::Unit& u, int wr, int wc, int fr, int fq) const {
        EPI_ROWS_BEGIN
            const int col = 256 * u.pn + 32 * wc + 8 * fq; float g0[8], g1[8], p0[8], p1[8], h0[8], h1[8];
            unpack8(*(const v4u*)(G + (size_t)row * 2048 + 1024 + col), g0); unpack8(*(const v4u*)(G + (size_t)row * 2048 + 1024 + col + 128), g1);
            unpack8(*(const v4u*)(G + (size_t)row * 2048 + col), h0); unpack8(*(const v4u*)(G + (size_t)row * 2048 + col + 128), h1);
            unpack8(*(const v4u*)(P1 + (size_t)row * DM + col), p0); unpack8(*(const v4u*)(P1 + (size_t)row * DM + col + 128), p1);
#pragma unroll
            for (int e = 0; e < 8; ++e) { a[e] = p0[e] * h0[e] + a[e] * g0[e]; b[e] = p1[e] * h1[e] + b[e] * g1[e]; }
            *(v4u*)(MX + (size_t)row * DM + col) = pack8(a); *(v4u*)(MX + (size_t)row * DM + col + 128) = pack8(b);
        EPI_ROWS_END
    }
};
struct EpiRes {
    static constexpr bool PERM = true, AFTER_DRAIN = false; const float* xp; const float* xs; const float* MOD; int moff; float* out;
    __device__ __forceinline__ void operator()(const f32x4 (&acc)[2][2][4][2], const pg8::Unit& u, int wr, int wc, int fr, int fq) const {
        EPI_ROWS_BEGIN
            const int col = 256 * u.pn + 32 * wc + 8 * fq;
            const float* xr = ((row < TP) ? xp + (size_t)row * DM : xs + (size_t)(row - TP) * DM) + col;
            const float* mr = MOD + (size_t)mod_row(row) * 6144 + moff + col; float* o = out + (size_t)row * DM + col;
#pragma unroll
            for (int hh = 0; hh < 2; ++hh) { const float* v = hh ? b : a;
#pragma unroll
                for (int q = 0; q < 2; ++q) { const f32x4 x = *(const f32x4*)(xr + 128 * hh + 4 * q), g = *(const f32x4*)(mr + 128 * hh + 4 * q);
                    *(f32x4*)(o + 128 * hh + 4 * q) = (f32x4){x[0] + g[0] * v[4 * q], x[1] + g[1] * v[4 * q + 1], x[2] + g[2] * v[4 * q + 2], x[3] + g[3] * v[4 * q + 3]}; } }
        EPI_ROWS_END
    }
};
struct EpiResAdd {
    static constexpr bool PERM = true, AFTER_DRAIN = false; const float* MOD; int moff; float* out;
    __device__ __forceinline__ void operator()(const f32x4 (&acc)[2][2][4][2], const pg8::Unit& u, int wr, int wc, int fr, int fq) const {
        EPI_ROWS_BEGIN
            const int col = 256 * (u.pn & 3) + 32 * wc + 8 * fq;
            const float* mr = MOD + (size_t)mod_row(row) * 6144 + moff + col; float* o = out + (size_t)row * DM + col;
#pragma unroll
            for (int e = 0; e < 8; ++e) { unsafeAtomicAdd(o + e, mr[e] * a[e]); unsafeAtomicAdd(o + 128 + e, mr[128 + e] * b[e]); }
        EPI_ROWS_END
    }
};
struct EpiAct {
    static constexpr bool PERM = true, AFTER_DRAIN = false; bf16* ACT;
    __device__ __forceinline__ void operator()(const f32x4 (&acc)[2][2][4][2], const pg8::Unit& u, int wr, int wc, int fr, int fq) const {
        EPI_ROWS_BEGIN
            const int col = 128 * u.pn + 32 * wc + 8 * fq;
#pragma unroll
            for (int e = 0; e < 8; ++e) a[e] = silu_f(a[e]) * b[e];
            *(v4u*)(ACT + (size_t)row * DFF + col) = pack8(a);
        EPI_ROWS_END
    }
};

__device__ __forceinline__ void ynorm_phase(const Params& p, int lane, int wave, bf16* Y, const float* SSQ) {
    const float* gn = p.in[21];
    const int gw = blockIdx.x * 8 + wave, NGW = gridDim.x * 8;
    for (int row = gw; row < TT; row += NGW) {
#pragma unroll
        for (int j = 0; j < 4; ++j) { const int c = 8 * lane + 512 * j, g = c >> 8;
            const f32x4 s = *(const f32x4*)(SSQ + (size_t)row * 32 + 4 * g);
            const float rstd = rsqrtf(((s[0] + s[1]) + (s[2] + s[3])) * (1.f / 256.f) + EPS);
            float y[8]; unpack8(*(const v4u*)(Y + (size_t)row * DINNER + c), y);
            const f32x4 g0 = *(const f32x4*)(gn + c), g1 = *(const f32x4*)(gn + c + 4);
            y[0] *= rstd * g0[0]; y[1] *= rstd * g0[1]; y[2] *= rstd * g0[2]; y[3] *= rstd * g0[3]; y[4] *= rstd * g1[0]; y[5] *= rstd * g1[1]; y[6] *= rstd * g1[2]; y[7] *= rstd * g1[3];
            *(v4u*)(Y + (size_t)row * DINNER + c) = pack8(y); }
    }
}

__device__ __forceinline__ void conv_stream(bf16* base, float (&h0)[8], float (&h1)[8], float (&h2)[8], const float* wconv, const float* bconv, int col) {
    float w[4][8], bias[8];
#pragma unroll
    for (int j = 0; j < 4; ++j) { const f32x4 w0 = *(const f32x4*)(wconv + j * CONVC + col), w1 = *(const f32x4*)(wconv + j * CONVC + col + 4);
        w[j][0] = w0[0]; w[j][1] = w0[1]; w[j][2] = w0[2]; w[j][3] = w0[3]; w[j][4] = w1[0]; w[j][5] = w1[1]; w[j][6] = w1[2]; w[j][7] = w1[3]; }
    { const f32x4 b0 = *(const f32x4*)(bconv + col), b1 = *(const f32x4*)(bconv + col + 4);
      bias[0] = b0[0]; bias[1] = b0[1]; bias[2] = b0[2]; bias[3] = b0[3]; bias[4] = b1[0]; bias[5] = b1[1]; bias[6] = b1[2]; bias[7] = b1[3]; }
    for (int r0 = 0; r0 < 64; r0 += 8) {
        v4u raw[8];
#pragma unroll
        for (int k = 0; k < 8; ++k) raw[k] = *(const v4u*)(base + (size_t)(r0 + k) * CONVC);
#pragma unroll
        for (int k = 0; k < 8; ++k) { float x[8], o[8]; unpack8(raw[k], x);
#pragma unroll
            for (int e = 0; e < 8; ++e) { o[e] = silu_f(bias[e] + w[0][e] * h0[e] + w[1][e] * h1[e] + w[2][e] * h2[e] + w[3][e] * x[e]); h0[e] = h1[e]; h1[e] = h2[e]; h2[e] = x[e]; }
            *(v4u*)(base + (size_t)(r0 + k) * CONVC) = pack8(o); }
    }
}
__device__ __forceinline__ void conv_phase(const Params& p, int tid, bf16* XBC) {
    const float* wconv = p.in[16]; const float* bconv = p.in[17];
    const int G = gridDim.x, bx = blockIdx.x;
    for (int it = bx; it < 256; it += G) {
        const int b = it >> 5, cb = it & 31, cg = tid & 15, run = tid >> 4, col = cb * 128 + cg * 8;
        bf16* base = XBC + (size_t)(b * SEQ + run * 64) * CONVC + col;
        float h0[8], h1[8], h2[8];
        if (run > 0) { unpack8(*(const v4u*)(base - 3 * CONVC), h0); unpack8(*(const v4u*)(base - 2 * CONVC), h1); unpack8(*(const v4u*)(base - CONVC), h2); }
        else {
#pragma unroll
            for (int e = 0; e < 8; ++e) { h0[e] = 0.f; h1[e] = 0.f; h2[e] = 0.f; } }
        __syncthreads();
        conv_stream(base, h0, h1, h2, wconv, bconv, col);
        __syncthreads();
    }
    for (int i = bx * 512 + tid; i < NBS * 512; i += G * 512) {
        const int b = i >> 9, col = (i & 511) * 8;
        bf16* base = XBC + (size_t)(TP + b * DSEQ) * CONVC + col;
        const float* sp = p.in[5] + (size_t)b * 3 * CONVC + col;
        float h0[8], h1[8], h2[8];
#pragma unroll
        for (int e = 0; e < 8; ++e) { h0[e] = sp[e]; h1[e] = sp[CONVC + e]; h2[e] = sp[2 * CONVC + e]; }
        conv_stream(base, h0, h1, h2, wconv, bconv, col);
    }
}

#define MFMA32(a, b, c) __builtin_amdgcn_mfma_f32_32x32x16_bf16((a), (b), (c), 0, 0, 0)
typedef short s16x4 __attribute__((ext_vector_type(4)));
#ifndef TR_SLOW
#define TR_SLOW 0
#endif
__device__ __forceinline__ bf16x8 tr_frag(const LAS bf16* tile, int pitch, int ra, int rb, int col, int lane) {
#if TR_SLOW
    bf16x8 r;
#pragma unroll
    for (int e = 0; e < 4; ++e) { r[e] = (short)tile[(ra + e) * pitch + col]; r[4 + e] = (short)tile[(rb + e) * pitch + col]; }
    return r;
#else
    const int tq = (lane & 15) >> 2, tp = lane & 3, cb = (col & ~15) + 4 * tp;
    const s16x4 lo = __builtin_amdgcn_ds_read_tr16_b64_v4i16((LAS s16x4*)(tile + (ra + tq) * pitch + cb)), hi = __builtin_amdgcn_ds_read_tr16_b64_v4i16((LAS s16x4*)(tile + (rb + tq) * pitch + cb));
    return (bf16x8){lo[0], lo[1], lo[2], lo[3], hi[0], hi[1], hi[2], hi[3]};
#endif
}
constexpr int SS_TILE = 44032, SS_XN = 0, SS_BN = 9216, SS_CN = 26624, SS_HS = 88064, SS_HSZ = 17408, SS_ACS = 122880, SS_SQ = 126976;
__device__ __forceinline__ void ssd_unit(const Params& p, LAS unsigned char* lds, int tid, int lane, int wave, bool isS, int b, int h,
                                         const bf16* XBC, const float* DT, bf16* Y, float* SSQ) {
    const int g = h >> 2, nch = isS ? 1 : 32, tok0 = isS ? TP + b * DSEQ : b * SEQ;
    const float a_h = -__expf(p.in[19][h]), d_h = p.in[20][h];
    LAS float* acs = (LAS float*)(lds + SS_ACS + wave * 512); LAS float* dtv = acs + 64;
    const int l32 = lane & 31, hf = lane >> 5, blk = (lane >> 4) & 1, tq = (lane & 15) >> 2, tp = lane & 3;
    const bool ywave = wave < 4; const int w4 = wave & 3;
    f32x16 hs0, hs1;
    float* sout = p.out + (isS ? O_SSMS : O_SSMP) + ((size_t)(b * 32 + h) * 64) * 128;
#pragma unroll
    for (int i = 0; i < 16; ++i) { hs0[i] = 0.f; hs1[i] = 0.f; }
    if (isS && !ywave) { const float* s0 = p.in[6] + ((size_t)(b * 32 + h) * 64) * 128;
#pragma unroll
        for (int i = 0; i < 16; ++i) { const int pr = 8 * (i >> 2) + 4 * hf + (i & 3); hs0[i] = s0[(size_t)pr * 128 + 32 * w4 + l32]; hs1[i] = s0[(size_t)(32 + pr) * 128 + 32 * w4 + l32]; } }
    int soff[5]; int goff[5];
#pragma unroll
    for (int k = 0; k < 5; ++k) { const int pc = tid + 512 * k;
        if (pc < 512) { const int r = pc >> 3, s8 = pc & 7; soff[k] = SS_XN + (r * 72 + 8 * s8) * 2; goff[k] = r * CONVC + h * 64 + 8 * s8; }
        else if (pc < 1536) { const int q = pc - 512, r = q >> 4, s8 = q & 15; soff[k] = SS_BN + (r * 136 + 8 * s8) * 2; goff[k] = r * CONVC + 2048 + g * 128 + 8 * s8; }
        else { const int q = pc - 1536, r = q >> 4, s8 = q & 15; soff[k] = SS_CN + (r * 136 + 8 * s8) * 2; goff[k] = r * CONVC + 3072 + g * 128 + 8 * s8; } }
    v4u stg[5]; float dtn; v2u zn[4];
    const int pt = wave >> 1, it = wave & 1, irow = 32 * it + l32;
#pragma unroll
    for (int k = 0; k < 5; ++k) stg[k] = *(const v4u*)(XBC + (size_t)tok0 * CONVC + goff[k]);
    dtn = DT[(size_t)(tok0 + lane) * 32 + h];
    if (ywave) {
#pragma unroll
        for (int q = 0; q < 4; ++q) zn[q] = *(const v2u*)(Y + (size_t)(tok0 + irow) * DINNER + h * 64 + 32 * pt + 8 * q + 4 * hf); }
#pragma unroll
    for (int k = 0; k < 5; ++k) *(LAS v4u*)(lds + soff[k]) = stg[k];
    if (!ywave) { LAS bf16* Hs = (LAS bf16*)(lds + SS_HS);
#pragma unroll
        for (int i = 0; i < 16; ++i) { const int pr = 8 * (i >> 2) + 4 * hf + (i & 3);
            Hs[pr * 136 + 32 * w4 + l32] = (bf16)(cvt_pk_bf16(hs0[i], 0.f) & 0xffffu); Hs[(32 + pr) * 136 + 32 * w4 + l32] = (bf16)(cvt_pk_bf16(hs1[i], 0.f) & 0xffffu); } }
    __syncthreads();
    for (int c = 0; c < nch; ++c) {
        const int tokc = tok0 + 64 * c, buf = c & 1;
        LAS unsigned char* tb = lds + buf * SS_TILE;
        const LAS bf16* Xn = (const LAS bf16*)(tb + SS_XN); const LAS bf16* Bn = (const LAS bf16*)(tb + SS_BN); const LAS bf16* Cn = (const LAS bf16*)(tb + SS_CN);
        const LAS bf16* Hs = (const LAS bf16*)(lds + SS_HS + buf * SS_HSZ);
        const float dtc = dtn; float av = dtc * a_h;
#pragma unroll
        for (int o = 1; o < 64; o <<= 1) { const float t = __shfl_up(av, o); if (lane >= o) av += t; }
        acs[lane] = av; dtv[lane] = dtc;
        const v2u zc0 = zn[0], zc1 = zn[1], zc2 = zn[2], zc3 = zn[3];
        const bool more = (c + 1 < nch);
        if (more) {
#pragma unroll
            for (int k = 0; k < 5; ++k) stg[k] = *(const v4u*)(XBC + (size_t)(tokc + 64) * CONVC + goff[k]);
            dtn = DT[(size_t)(tokc + 64 + lane) * 32 + h];
            if (ywave) {
#pragma unroll
                for (int q = 0; q < 4; ++q) zn[q] = *(const v2u*)(Y + (size_t)(tokc + 64 + irow) * DINNER + h * 64 + 32 * pt + 8 * q + 4 * hf); }
        }
        if (ywave) {
            const int prow = 32 * pt + l32;
            f32x16 yo;
#pragma unroll
            for (int i = 0; i < 16; ++i) yo[i] = 0.f;
#pragma unroll
            for (int ks = 0; ks < 8; ++ks) { const bf16x8 av8 = *(const LAS bf16x8*)(Hs + prow * 136 + 16 * ks + 8 * hf), bv8 = *(const LAS bf16x8*)(Cn + irow * 136 + 16 * ks + 8 * hf); yo = MFMA32(av8, bv8, yo); }
            const float ai = acs[irow]; const float ei = __expf(ai);
#pragma unroll
            for (int i = 0; i < 16; ++i) yo[i] *= ei;
            for (int jt = 0; jt <= it; ++jt) {
                f32x16 s;
#pragma unroll
                for (int i = 0; i < 16; ++i) s[i] = 0.f;
#pragma unroll
                for (int ks = 0; ks < 8; ++ks) { const bf16x8 av8 = *(const LAS bf16x8*)(Bn + (32 * jt + l32) * 136 + 16 * ks + 8 * hf), bv8 = *(const LAS bf16x8*)(Cn + irow * 136 + 16 * ks + 8 * hf); s = MFMA32(av8, bv8, s); }
                float mv[16];
#pragma unroll
                for (int i = 0; i < 16; ++i) { const int j = 32 * jt + 8 * (i >> 2) + 4 * hf + (i & 3); mv[i] = (j <= irow) ? s[i] * __expf(ai - acs[j]) * dtv[j] : 0.f; }
#pragma unroll
                for (int jj = 0; jj < 2; ++jj) {
                    const v4u pk = pack8(mv + 8 * jj); bf16x8 bv8; __builtin_memcpy(&bv8, &pk, 16);
                    const int ja = 32 * jt + 16 * jj + 4 * hf;
                    const bf16x8 av8 = tr_frag(Xn, 72, ja, ja + 8, 32 * pt + l32, lane);
                    yo = MFMA32(av8, bv8, yo);
                }
            }
            float sq = 0.f; bf16* zp = Y + (size_t)(tokc + irow) * DINNER + h * 64 + 32 * pt + 4 * hf;
#pragma unroll
            for (int q = 0; q < 4; ++q) { const int p4 = 32 * pt + 8 * q + 4 * hf;
                const v2u xr = *(const LAS v2u*)(Xn + irow * 72 + p4); const v2u zr = (q == 0) ? zc0 : (q == 1) ? zc1 : (q == 2) ? zc2 : zc3;
                const float x0 = bf2f(xr.x & 0xffffu), x1 = __uint_as_float(xr.x & 0xffff0000u), x2 = bf2f(xr.y & 0xffffu), x3 = __uint_as_float(xr.y & 0xffff0000u);
                const float z0 = bf2f(zr.x & 0xffffu), z1 = __uint_as_float(zr.x & 0xffff0000u), z2 = bf2f(zr.y & 0xffffu), z3 = __uint_as_float(zr.y & 0xffff0000u);
                const float y0 = (yo[4 * q] + d_h * x0) * z0, y1 = (yo[4 * q + 1] + d_h * x1) * z1, y2 = (yo[4 * q + 2] + d_h * x2) * z2, y3 = (yo[4 * q + 3] + d_h * x3) * z3;
                sq += (y0 * y0 + y1 * y1) + (y2 * y2 + y3 * y3);
                v2u o; o.x = cvt_pk_bf16(y0, y1); o.y = cvt_pk_bf16(y2, y3); *(v2u*)(zp + 8 * q) = o; }
            ((LAS float*)(lds + SS_SQ))[buf * 256 + (pt * 2 + hf) * 64 + irow] = sq;
        } else {
            const float a63 = acs[63]; const float dec = __expf(a63);
#pragma unroll
            for (int i = 0; i < 16; ++i) { hs0[i] *= dec; hs1[i] *= dec; }
#pragma unroll
            for (int ks = 0; ks < 4; ++ks) {
                const int j0 = 16 * ks + 8 * hf;
                const bf16x8 bv8 = tr_frag(Bn, 136, j0, j0 + 4, 32 * w4 + l32, lane);
                float wj[8];
#pragma unroll
                for (int e = 0; e < 8; ++e) wj[e] = __expf(a63 - acs[j0 + e]) * dtv[j0 + e];
#pragma unroll
                for (int ptt = 0; ptt < 2; ++ptt) {
                    const bf16x8 xr = tr_frag(Xn, 72, j0, j0 + 4, 32 * ptt + l32, lane);
                    v4u xu; __builtin_memcpy(&xu, &xr, 16); float xf[8]; unpack8(xu, xf);
#pragma unroll
                    for (int e = 0; e < 8; ++e) xf[e] *= wj[e];
                    const v4u xp = pack8(xf); bf16x8 av8; __builtin_memcpy(&av8, &xp, 16);
                    if (ptt == 0) hs0 = MFMA32(av8, bv8, hs0); else hs1 = MFMA32(av8, bv8, hs1);
                }
            }
            if (more) { LAS bf16* Hn = (LAS bf16*)(lds + SS_HS + (buf ^ 1) * SS_HSZ);
#pragma unroll
                for (int i = 0; i < 16; ++i) { const int pr = 8 * (i >> 2) + 4 * hf + (i & 3);
                    Hn[pr * 136 + 32 * w4 + l32] = (bf16)(cvt_pk_bf16(hs0[i], 0.f) & 0xffffu); Hn[(32 + pr) * 136 + 32 * w4 + l32] = (bf16)(cvt_pk_bf16(hs1[i], 0.f) & 0xffffu); } }
        }
        if (more) {
#pragma unroll
            for (int k = 0; k < 5; ++k) *(LAS v4u*)(lds + (buf ^ 1) * SS_TILE + soff[k]) = stg[k]; }
        __syncthreads();
        if (tid < 64) { const LAS float* sq = (const LAS float*)(lds + SS_SQ) + buf * 256; SSQ[(size_t)(tokc + tid) * 32 + h] = (sq[tid] + sq[64 + tid]) + (sq[128 + tid] + sq[192 + tid]); }
    }
    if (!ywave) {
#pragma unroll
        for (int i = 0; i < 16; ++i) { const int pr = 8 * (i >> 2) + 4 * hf + (i & 3); sout[(size_t)pr * 128 + 32 * w4 + l32] = hs0[i]; sout[(size_t)(32 + pr) * 128 + 32 * w4 + l32] = hs1[i]; } }
    __syncthreads();
}

constexpr int SCW = 2116;
__device__ __forceinline__ unsigned sortable(float x) { x += 0.0f; const unsigned b = __float_as_uint(x); return (b & 0x80000000u) ? ~b : (b | 0x80000000u); }
__device__ __forceinline__ void topk_unit(LAS unsigned char* lds, int tid, int lane, int wave, bool isS, int b, int qb,
                                          const bf16* QI, const bf16* KIP, const bf16* KIS, const float* WI, unsigned* MASK) {
    const int tok0 = isS ? TP + b * DSEQ + qb * 16 : b * SEQ + qb * 16;
    const int pos0 = (isS ? PAST : 0) + qb * 16, limit = ((pos0 >> 6) + 1) << 6, nslots = limit >> 6, ntile = limit >> 4;
    const bf16* KI = isS ? KIS + (size_t)b * NKS * 64 : KIP + (size_t)b * NKP * 64;
    LAS float* sc = (LAS float*)lds;
    const int l16 = lane & 15, kg = lane >> 4;
    if (limit > 256) {
        bf16x8 qf[8][2]; float wq[8];
#pragma unroll
        for (int hd = 0; hd < 8; ++hd) {
#pragma unroll
            for (int ks = 0; ks < 2; ++ks) qf[hd][ks] = *(const bf16x8*)(QI + (size_t)(tok0 + l16) * 512 + hd * 64 + 32 * ks + 8 * kg);
            wq[hd] = WI[(size_t)(tok0 + l16) * 8 + hd]; }
        for (int kt = wave; kt < ntile; kt += 8) {
            const bf16x8 a0 = *(const bf16x8*)(KI + (size_t)(16 * kt + l16) * 64 + 8 * kg), a1 = *(const bf16x8*)(KI + (size_t)(16 * kt + l16) * 64 + 32 + 8 * kg);
            f32x4 s = (f32x4){0.f, 0.f, 0.f, 0.f};
#pragma unroll
            for (int hd = 0; hd < 8; ++hd) { f32x4 c = (f32x4){0.f, 0.f, 0.f, 0.f};
                c = __builtin_amdgcn_mfma_f32_16x16x32_bf16(a0, qf[hd][0], c, 0, 0, 0); c = __builtin_amdgcn_mfma_f32_16x16x32_bf16(a1, qf[hd][1], c, 0, 0, 0);
#pragma unroll
                for (int i = 0; i < 4; ++i) s[i] += wq[hd] * fmaxf(c[i], 0.f); }
            *(LAS f32x4*)(sc + l16 * SCW + 16 * kt + 4 * kg) = s;
        }
    }
    __syncthreads();
    for (int qq = 0; qq < 2; ++qq) {
        const int q = 2 * wave + qq; unsigned* mrow = MASK + (size_t)(tok0 + q) * MASKW;
        if (limit <= 256) {
            if (lane < 33) { const unsigned v = (lane < nslots) ? 0xffffffffu : 0u; mrow[2 * lane] = v; mrow[2 * lane + 1] = v; }
            continue;
        }
        unsigned u[33];
#pragma unroll
        for (int j = 0; j < 33; ++j) u[j] = (j < nslots) ? sortable(sc[q * SCW + 64 * j + lane]) : 0u;
        const int ng = (nslots + 10) / 11;
#define CNT_GE(dst, val) do { int _c = 0; \
            _Pragma("unroll") for (int j = 0; j < 11; ++j) _c += __popcll(__ballot(u[j] >= (val))); \
            if (ng > 1) { _Pragma("unroll") for (int j = 11; j < 22; ++j) _c += __popcll(__ballot(u[j] >= (val))); } \
            if (ng > 2) { _Pragma("unroll") for (int j = 22; j < 33; ++j) _c += __popcll(__ballot(u[j] >= (val))); } \
            dst = _c; } while (0)
        unsigned thr = 0u; bool exact = false;
        for (int bit = 31; bit >= 0; --bit) { const unsigned cand = thr | (1u << bit); int cnt; CNT_GE(cnt, cand);
            if (cnt >= 256) thr = cand;
            if (cnt == 256) { exact = true; break; } }
        int rem = 0;
        if (!exact) { int cgt; CNT_GE(cgt, thr + 1u); rem = 256 - cgt; }
#pragma unroll
        for (int j = 0; j < 33; ++j) {
            unsigned long long wv;
            if (exact) wv = __ballot(u[j] >= thr);
            else { const unsigned long long gt = __ballot(u[j] > thr); unsigned long long eq = __ballot(u[j] == thr), sel = 0ull;
                const int pe = __popcll(eq);
                if (pe <= rem) { sel = eq; rem -= pe; }
                else { while (rem > 0) { const unsigned long long low = eq & (0ull - eq); sel |= low; eq ^= low; --rem; } }
                wv = gt | sel; }
            if (lane == 0) { mrow[2 * j] = (unsigned)wv; mrow[2 * j + 1] = (unsigned)(wv >> 32); }
        }
#undef CNT_GE
    }
    __syncthreads();
}

constexpr int AT_K = 0, AT_V = 18432, AT_M = 59392, AT_VP = 160, AT_VSZ = 64 * AT_VP;
__device__ __forceinline__ void attn_unit(LAS unsigned char* lds, int tid, int lane, int wave, bool isS, int b, int c, int kvh,
                                          bf16* Q, const bf16* KP, const bf16* KSn, const bf16* VP, const bf16* VSn, const float* CK, const float* CV, const unsigned* MASK) {
    const int tok0 = isS ? TP + b * DSEQ : b * SEQ + 64 * c;
    const int limit = isS ? NKS : 64 * (c + 1), nt = limit >> 6;
    const bf16* Kb = isS ? KSn + (size_t)(b * 4 + kvh) * DSEQ * 64 : KP + (size_t)(b * 4 + kvh) * NKP * 64;
    const bf16* Vb = isS ? VSn + (size_t)(b * 4 + kvh) * DSEQ * 64 : VP + (size_t)(b * 4 + kvh) * NKP * 64;
    const float* Kc = CK + ((size_t)b * PAST * 4 + kvh) * 64; const float* Vc32 = CV + ((size_t)b * PAST * 4 + kvh) * 64;
    LAS bf16* Kt = (LAS bf16*)(lds + AT_K); LAS bf16* Vt = (LAS bf16*)(lds + AT_V); LAS unsigned* MK = (LAS unsigned*)(lds + AT_M);
    const int l32 = lane & 31, hf = lane >> 5, r = 32 * wave + l32, tl = r >> 2, gq = r & 3;
    bf16* qp = Q + (size_t)(tok0 + tl) * DM + (kvh * 4 + gq) * 64;
    bf16x8 qf[4];
#pragma unroll
    for (int ks = 0; ks < 4; ++ks) qf[ks] = *(const bf16x8*)(qp + hf * 32 + 8 * ks);
    for (int i = tid; i < 64 * MASKW; i += 512) MK[i] = MASK[(size_t)tok0 * MASKW + i];
    const int srow = tid >> 3, sseg = tid & 7;
    v4u kr0, kr1, vr0, vr1;
#define AT_LOAD(kt_) do { if (isS && (kt_) < 32) { const float* kp_ = Kc + (size_t)(64 * (kt_) + srow) * 256 + 8 * sseg; const float* vp_ = Vc32 + (size_t)(64 * (kt_) + srow) * 256 + 8 * sseg; \
            kr0 = *(const v4u*)kp_; kr1 = *(const v4u*)(kp_ + 4); vr0 = *(const v4u*)vp_; vr1 = *(const v4u*)(vp_ + 4); } \
        else { const int kk_ = isS ? srow : 64 * (kt_) + srow; kr0 = *(const v4u*)(Kb + (size_t)kk_ * 64 + 8 * sseg); vr0 = *(const v4u*)(Vb + (size_t)kk_ * 64 + 8 * sseg); } } while (0)
#define AT_STORE(kt_, buf_) do { v4u ko_ = kr0, vo_ = vr0; \
        if (isS && (kt_) < 32) { ko_.x = cvt_pk_bf16(__uint_as_float(kr0.x), __uint_as_float(kr0.y)); ko_.y = cvt_pk_bf16(__uint_as_float(kr0.z), __uint_as_float(kr0.w)); ko_.z = cvt_pk_bf16(__uint_as_float(kr1.x), __uint_as_float(kr1.y)); ko_.w = cvt_pk_bf16(__uint_as_float(kr1.z), __uint_as_float(kr1.w)); \
            vo_.x = cvt_pk_bf16(__uint_as_float(vr0.x), __uint_as_float(vr0.y)); vo_.y = cvt_pk_bf16(__uint_as_float(vr0.z), __uint_as_float(vr0.w)); vo_.z = cvt_pk_bf16(__uint_as_float(vr1.x), __uint_as_float(vr1.y)); vo_.w = cvt_pk_bf16(__uint_as_float(vr1.z), __uint_as_float(vr1.w)); } \
        *(LAS v4u*)(Kt + (buf_) * 4608 + srow * 72 + 8 * sseg) = ko_; *(LAS v4u*)(Vt + (buf_) * AT_VSZ + srow * AT_VP + 8 * sseg) = vo_; } while (0)
    AT_LOAD(0); AT_STORE(0, 0);
    __syncthreads();
    f32x16 o0, o1;
#pragma unroll
    for (int i = 0; i < 16; ++i) { o0[i] = 0.f; o1[i] = 0.f; }
    float lpart = 0.f;
    for (int kt = 0; kt < nt; ++kt) {
        const int buf = kt & 1;
        if (kt + 1 < nt) AT_LOAD(kt + 1);
        const LAS bf16* Kc2 = Kt + buf * 4608; const LAS bf16* Vc = Vt + buf * AT_VSZ;
        f32x16 s0, s1;
#pragma unroll
        for (int i = 0; i < 16; ++i) { s0[i] = 0.f; s1[i] = 0.f; }
#pragma unroll
        for (int ks = 0; ks < 4; ++ks) { const bf16x8 a0 = *(const LAS bf16x8*)(Kc2 + l32 * 72 + hf * 32 + 8 * ks), a1 = *(const LAS bf16x8*)(Kc2 + (32 + l32) * 72 + hf * 32 + 8 * ks);
            s0 = MFMA32(a0, qf[ks], s0); s1 = MFMA32(a1, qf[ks], s1); }
        const unsigned w0 = MK[tl * MASKW + 2 * kt] >> (4 * hf), w1 = MK[tl * MASKW + 2 * kt + 1] >> (4 * hf);
        float p0[16], p1[16], ls = 0.f;
#pragma unroll
        for (int i = 0; i < 16; ++i) { const int bp = 8 * (i >> 2) + (i & 3);
            p0[i] = ((w0 >> bp) & 1u) ? __builtin_amdgcn_exp2f(s0[i]) : 0.f; p1[i] = ((w1 >> bp) & 1u) ? __builtin_amdgcn_exp2f(s1[i]) : 0.f; ls += p0[i] + p1[i]; }
        lpart += ls;
#pragma unroll
        for (int sub = 0; sub < 2; ++sub)
#pragma unroll
            for (int jj = 0; jj < 2; ++jj) {
                const v4u pk = pack8((sub ? p1 : p0) + 8 * jj); bf16x8 bv; __builtin_memcpy(&bv, &pk, 16);
                const int ja = 32 * sub + 16 * jj + 4 * hf;
                const bf16x8 av0 = tr_frag(Vc, AT_VP, ja, ja + 8, l32, lane), av1 = tr_frag(Vc, AT_VP, ja, ja + 8, 32 + l32, lane);
                o0 = MFMA32(av0, bv, o0); o1 = MFMA32(av1, bv, o1);
            }
        if (kt + 1 < nt) AT_STORE(kt + 1, buf ^ 1);
        __syncthreads();
    }
#undef AT_LOAD
#undef AT_STORE
    const float lt = lpart + __shfl_xor(lpart, 32), inv = 1.f / lt;
#pragma unroll
    for (int q = 0; q < 4; ++q) {
        v2u a; a.x = cvt_pk_bf16(o0[4 * q] * inv, o0[4 * q + 1] * inv); a.y = cvt_pk_bf16(o0[4 * q + 2] * inv, o0[4 * q + 3] * inv); *(v2u*)(qp + 8 * q + 4 * hf) = a;
        v2u c2; c2.x = cvt_pk_bf16(o1[4 * q] * inv, o1[4 * q + 1] * inv); c2.y = cvt_pk_bf16(o1[4 * q + 2] * inv, o1[4 * q + 3] * inv); *(v2u*)(qp + 32 + 8 * q + 4 * hf) = c2;
    }
    __syncthreads();
}
constexpr int NPHASES = 12;

#ifdef NOSSD
#define SSDCALL(...) (void)0
#else
#define SSDCALL ssd_unit
#endif
#ifdef NOATT
#define ATTCALL(...) (void)0
#else
#define ATTCALL attn_unit
#endif
#define XB_TMO      128
#define XB_XCNT(j)  (256  + 64 * (j))
#define XB_XSUB(j)  (1280 + 64 * (j))
#define XB_XGEN(j)  (2304 + 64 * (j))
#define XB_TOP      3328
#define XB_TOPGEN   3392
#define XCD_BAR_WORDS 3456
#define XB_SPIN_CAP (1u << 18)

__device__ __forceinline__ unsigned xb_ld(unsigned* p)              { return __hip_atomic_load(p, __ATOMIC_RELAXED, __HIP_MEMORY_SCOPE_AGENT); }
__device__ __forceinline__ unsigned xb_add(unsigned* p, unsigned v) { return __hip_atomic_fetch_add(p, v, __ATOMIC_RELAXED, __HIP_MEMORY_SCOPE_AGENT); }
__device__ __forceinline__ unsigned xb_xcc_id() { return (unsigned)__builtin_amdgcn_s_getreg((3 << 11) | 20) & 0xFu; }
#define XB_SPIN(cond, bar) do { unsigned _sp = 0; while (cond) { __builtin_amdgcn_s_sleep(1); \
    if ((++_sp & 255u) == 0u) { if (xb_ld(&(bar)[XB_TMO])) break; if (_sp > XB_SPIN_CAP) { atomicAdd(&(bar)[XB_TMO], 1u); break; } } } } while (0)

struct XcdBarrier {
    unsigned* bar; unsigned x;
    volatile LAS unsigned* st;
};

__device__ __forceinline__ XcdBarrier xcd_barrier_post(unsigned* bar, volatile LAS unsigned* st) {
    XcdBarrier b; b.bar = bar; b.x = xb_xcc_id(); b.st = st;
    if (threadIdx.x == 0) (void)xb_add(&bar[XB_XCNT(b.x)], 1u);
    return b;
}
__device__ __forceinline__ void xcd_barrier_complete(unsigned* bar, unsigned x, unsigned& nloc, unsigned& nx) {
    const unsigned G = gridDim.x * gridDim.y * gridDim.z;
    unsigned sum, cnt, mine, sp = 0u;
    for (;;) {
        sum = 0u; cnt = 0u; mine = 0u;
#pragma unroll
        for (unsigned j = 0; j < 16; ++j) { const unsigned c = xb_ld(&bar[XB_XCNT(j)]); sum += c; cnt += (c > 0u) ? 1u : 0u; mine = (j == x) ? c : mine; }
        if (sum == G) break;
        __builtin_amdgcn_s_sleep(1);
        if ((++sp & 255u) == 0u) { if (xb_ld(&bar[XB_TMO])) break; if (sp > XB_SPIN_CAP) { atomicAdd(&bar[XB_TMO], 1u); break; } }
    }
    nloc = mine > 0u ? mine : 1u; nx = cnt > 0u ? cnt : 1u;
}

__device__ __forceinline__ void xcd_barrier(const XcdBarrier& b) {
    asm volatile("s_waitcnt vmcnt(0)" ::: "memory");
    __syncthreads();
    if (threadIdx.x == 0) {
        unsigned* bar = b.bar;
        __builtin_amdgcn_s_waitcnt(0);
        unsigned nloc = b.st[0], nx = b.st[1];
        if (nloc == 0u) { xcd_barrier_complete(bar, b.x, nloc, nx); b.st[0] = nloc; b.st[1] = nx; }
        const unsigned old = xb_add(&bar[XB_XSUB(b.x)], 1u);
        const unsigned gen = old / nloc;
        if (old + 1u == (gen + 1u) * nloc) {
            __builtin_amdgcn_fence(__ATOMIC_RELEASE, "agent");
            asm volatile("s_waitcnt vmcnt(0)" ::: "memory");
            const unsigned og = xb_add(&bar[XB_TOP], 1u);
            const unsigned tg = og / nx;
            if (og + 1u == (tg + 1u) * nx) xb_add(&bar[XB_TOPGEN], 1u);
            else XB_SPIN(xb_ld(&bar[XB_TOPGEN]) == tg, bar);
            __builtin_amdgcn_fence(__ATOMIC_ACQUIRE, "agent");
            xb_add(&bar[XB_XGEN(b.x)], 1u);
            asm volatile("s_waitcnt vmcnt(0)" ::: "memory");
        } else {
            XB_SPIN(xb_ld(&bar[XB_XGEN(b.x)]) == gen, bar);
            __builtin_amdgcn_fence(__ATOMIC_ACQUIRE, "agent");
            asm volatile("s_waitcnt vmcnt(0)" ::: "memory");
        }
    }
    __syncthreads();
}

__global__ void __launch_bounds__(512) mega(Params p) {
    extern __shared__ __attribute__((aligned(16))) unsigned char lds_raw[];
    LAS unsigned char* lds = (LAS unsigned char*)lds_raw;
    cg::grid_group grid = cg::this_grid();
    const int tid = threadIdx.x, lane = tid & 63, wave = __builtin_amdgcn_readfirstlane(tid >> 6);
    unsigned char* ws = p.ws;
#define IN(k) (p.ph_hi > (k))
#define SEAM(k) xcd_barrier(xbar)
    volatile LAS unsigned* xst = (volatile LAS unsigned*)(lds + LDS_BYTES - 16);
    if (tid < 4) xst[tid] = 0u;
    __syncthreads();
    if (p.ph_hi < 0) grid.sync();
    XcdBarrier xbar = xcd_barrier_post((unsigned*)(ws + WS_CTL), xst);
    bf16* Hb = (bf16*)(ws + WS_H);
    bf16* QIb = (bf16*)(p.out + O_SSMS); bf16* KIPb = QIb + (size_t)TT * 512; bf16* KISb = KIPb + (size_t)NBP * NKP * 64;
    bf16* Zb = (bf16*)(p.out + O_Y);

    if (IN(0)) phase0(p, lds, tid, lane, wave);
    SEAM(0);
    if (IN(1)) normmod_phase<true>(p, lds, tid, lane, wave, p.in[0], p.in[1], p.in[11], 0, 1024, Hb);
    SEAM(1);
    if (IN(2)) {
        pg8::Gemm g{Hb, (const bf16*)(ws + WS_WIN), TT, NIN, DM}; pg8::StaticOrder S; S.init(TT, NIN, gridDim.x, (int)blockIdx.x);
        EpiIn E{(bf16*)(ws + WS_Q), (bf16*)(ws + WS_KP), (bf16*)(ws + WS_KS), (bf16*)(ws + WS_VTP), (bf16*)(ws + WS_VTS), QIb, KIPb, KISb, Zb, (bf16*)(ws + WS_XBC),
                (float*)(ws + WS_WI), (float*)(ws + WS_DT), p.out, p.in[14], p.in[15], p.in[18], (const float*)(ws + WS_ROPE)};
        pg8::gemm_phase<EpiIn, pg8::StaticOrder, true, true>(lds, g, S, E);
    }
    SEAM(2);
    bf16* Qb = (bf16*)(ws + WS_Q); unsigned* MASKb = (unsigned*)(ws + WS_MASK); float* SSQb = (float*)(ws + WS_SSQ);
    bf16* GATESb = (bf16*)(ws + WS_GATES); bf16* P1b = (bf16*)(ws + WS_P1); bf16* MXb = (bf16*)(ws + WS_MIXED); bf16* ACTb = (bf16*)(ws + WS_ACT);
    const float* MODb = (const float*)(ws + WS_MOD);
    const int G = gridDim.x, bx = blockIdx.x;
    const int bxr = ((G & 7) == 0) ? ((G >> 3) - 1 - (bx >> 3)) * 8 + (bx & 7) : G - 1 - bx;
    if (IN(3)) {
        conv_phase(p, tid, (bf16*)(ws + WS_XBC));
        __syncthreads();
        for (int rd = 0; rd * G < 1152; ++rd) { const int u = rd * G + ((rd & 1) ? bxr : bx); if (u >= 1152) continue;
            bool us; int ub, uq;
            if (u < 128) { us = true; ub = u >> 2; uq = u & 3; } else { const int v = u - 128; us = false; ub = v & 7; uq = 127 - (v >> 3); }
            topk_unit(lds, tid, lane, wave, us, ub, uq, QIb, KIPb, KISb, (const float*)(ws + WS_WI), MASKb); }
    }
    SEAM(3);
    if (IN(4)) {
        for (int rd = 0; rd * G < 2432; ++rd) { const int u = rd * G + ((rd & 1) ? bxr : bx); if (u >= 2432) continue;
            int kind, ub, uc, uh; bool us;
            if (u < 256) { kind = 0; us = false; const int gi = ((u >> 5) << 3) + (u & 7); ub = gi >> 3; uh = ((gi & 7) << 2) + ((u >> 3) & 3); uc = 0; }
            else if (u < 384) { const int v = u - 256; kind = 1; us = true; ub = v >> 2; uh = v & 3; uc = 0; }
            else if (u < 1408) { const int v = u - 384, w = v & 31; kind = 1; us = false; ub = w >> 2; uh = w & 3; uc = 31 - (v >> 5); }
            else { const int v = u - 1408; kind = 0; us = true; const int gi = ((v >> 5) << 3) + (v & 7); ub = gi >> 3; uh = ((gi & 7) << 2) + ((v >> 3) & 3); uc = 0; }
            if (kind == 0) SSDCALL(p, lds, tid, lane, wave, us, ub, uh, (const bf16*)(ws + WS_XBC), (const float*)(ws + WS_DT), Zb, SSQb);
            else ATTCALL(lds, tid, lane, wave, us, ub, uc, uh, Qb, (const bf16*)(ws + WS_KP), (const bf16*)(ws + WS_KS), (const bf16*)(ws + WS_VTP), (const bf16*)(ws + WS_VTS), p.in[2], p.in[3], MASKb); }
    }
    SEAM(4);
    if (IN(5)) {
        ynorm_phase(p, lane, wave, Zb, SSQb);
        __syncthreads();
        { pg8::Gemm g{Hb, (const bf16*)(ws + WS_WG), TT, 2048, DM}; pg8::StaticOrder S; S.init(TT, 2048, G, bx);
          EpiGates E{GATESb};
          pg8::gemm_phase<EpiGates, pg8::StaticOrder, true, true>(lds, g, S, E); }
        { pg8::Gemm g{Qb, (const bf16*)(ws + WS_WBA), TT, DM, DM}; pg8::StaticOrder S; S.init(TT, DM, G, G - 1 - bx);
          EpiP1 E{GATESb, P1b};
          pg8::gemm_phase<EpiP1, pg8::StaticOrder, true, true>(lds, g, S, E); }
    }
    SEAM(5);
    if (IN(7)) {
        pg8::Gemm g{Zb, (const bf16*)(ws + WS_WBS), TT, DM, DINNER}; pg8::StaticOrder S; S.init(TT, DM, G, bx);
        EpiMixed E{GATESb, P1b, MXb};
        pg8::gemm_phase<EpiMixed, pg8::StaticOrder, true, true>(lds, g, S, E);
    }
    SEAM(7);
    if (IN(8)) {
        pg8::Gemm g{MXb, (const bf16*)(ws + WS_WOUT), TT, DM, DM}; pg8::StaticOrder S; S.init(TT, DM, G, bx);
        EpiRes E{p.in[0], p.in[1], MODb, 2048, p.out};
        pg8::gemm_phase<EpiRes, pg8::StaticOrder, true, true>(lds, g, S, E);
    }
    SEAM(8);
    if (IN(9)) normmod_phase<false>(p, lds, tid, lane, wave, p.out, p.out + (size_t)TP * DM, p.in[12], 3072, 4096, Hb);
    SEAM(9);
    if (IN(10)) {
        pg8::Gemm g{Hb, (const bf16*)(ws + WS_WGU), TT, 2 * DFF, DM}; pg8::StaticOrder S; S.init(TT, 2 * DFF, G, bx);
        EpiAct E{ACTb};
        pg8::gemm_phase<EpiAct, pg8::StaticOrder, true, true>(lds, g, S, E);
    }
    SEAM(10);
    if (IN(11)) {
        pg8::Gemm g{ACTb, (const bf16*)(ws + WS_WDN), TT, DM, DFF}; pg8::StaticOrder S; S.init(TT, DM, G, bx);
        EpiRes E{p.out, p.out + (size_t)TP * DM, MODb, 5120, p.out};
        pg8::gemm_phase<EpiRes, pg8::StaticOrder, true, true>(lds, g, S, E);
    }
#undef IN
#undef SEAM
}

extern "C" void kernel_launch(void* const* d_in, const int* in_sizes, int n_in, void* d_out, int out_size, void* d_ws, size_t ws_size, hipStream_t stream) {
    static int grid = 0;
    if (grid == 0) {
        if (n_in != 27 || ws_size < WS_END) { fprintf(stderr, "kernel_launch: unexpected n_in %d / ws %zu\n", n_in, ws_size); grid = -1; return; }
        int dev = 0, cus = 0, per_cu = 0;
        hipGetDevice(&dev); hipDeviceGetAttribute(&cus, hipDeviceAttributeMultiprocessorCount, dev);
        hipFuncSetAttribute((const void*)mega, hipFuncAttributeMaxDynamicSharedMemorySize, LDS_BYTES);
        hipOccupancyMaxActiveBlocksPerMultiprocessor(&per_cu, (const void*)mega, 512, LDS_BYTES);
        (void)hipGetLastError();
        if (per_cu < 1) per_cu = 1;
        grid = cus;
    }
    if (grid < 0) return;
    Params prm{};
    for (int i = 0; i < 27; ++i) prm.in[i] = (const float*)d_in[i];
    prm.out = (float*)d_out; prm.ws = (unsigned char*)d_ws; prm.ph_lo = 0; prm.ph_hi = NPHASES;
    (void)hipMemsetAsync((char*)d_ws + WS_CTL, 0, 16384, stream);
    void* args[] = {&prm};
    hipError_t e = hipLaunchCooperativeKernel((const void*)mega, dim3(grid), dim3(512), args, LDS_BYTES, stream);
    if (e != hipSuccess) fprintf(stderr, "cooperative launch failed: %s (grid %d)\n", hipGetErrorString(e), grid);
}
```

```cpp
#include <hip/hip_runtime.h>
#include <hip/hip_cooperative_groups.h>
#include <cstdio>
#include <cstdint>
namespace cg = cooperative_groups;

namespace pg8 {
#define PG8_LAS __attribute__((address_space(3)))
typedef unsigned short bf16_t;
typedef short bf16x8 __attribute__((ext_vector_type(8)));
typedef float f32x4 __attribute__((ext_vector_type(4)));
typedef unsigned u32x4 __attribute__((ext_vector_type(4)));
constexpr int BM = 256, BK = 64, HALF = 128, HTB = HALF * BK * 2  , STAGE_BYTES = 8 * HTB, NXCD = 8, WGM = 8;

__host__ __device__ __forceinline__ int lds_byte(int r, int c) { const int st = (r >> 4) * 2 + (c >> 5), rr = r & 15, cc = c & 31, ob = rr * 64 + cc * 2; return st * 1024 + (ob ^ (((ob >> 9) & 1) << 5)); }
__host__ __device__ __forceinline__ void stage_rc(int b, int& R, int& C) { const int st = b / 1024, sb = b % 1024, swz = sb ^ (((sb >> 9) & 1) << 5); R = (st >> 1) * 16 + swz / 64; C = (st & 1) * 32 + (swz % 64) / 2; }
__host__ __device__ __forceinline__ int perm32(int rho) { const int n = rho >> 4, i = rho & 15; return 8 * (i >> 2) + 4 * n + (i & 3); }

struct Unit { int pm, pn; };
struct Gemm { const bf16_t* A; const bf16_t* Bt; int M, N, K; int ld = 0; int ncol = 0; };

struct StaticOrder {
    int nM, nN, nwg, G, c;
    __host__ __device__ void init(int M, int N, int G_, int c_) { nM = M / BM; nN = N / BM; nwg = nM * nN; G = G_; c = c_; }
    __host__ __device__ bool next(int i, Unit& u) const {
        const long L = (long)i * G + c; if (L >= nwg) return false;
        int wgid = (int)L; { const int q = nwg / NXCD, r = nwg % NXCD, xcd = wgid % NXCD, off = wgid / NXCD; wgid = (xcd < r ? xcd * (q + 1) : r * (q + 1) + (xcd - r) * q) + off; }
        const int nig = WGM * nN, gid = wgid / nig, fm = gid * WGM, gsz = (nM - fm) < WGM ? (nM - fm) : WGM;
        u.pm = fm + ((wgid % nig) % gsz); u.pn = (wgid % nig) / gsz; return true;
    }
    __device__ __forceinline__ void a_ready(const Unit&) const {}
    __device__ __forceinline__ void done(const Unit&) const {}
};
typedef float f32x2_t __attribute__((ext_vector_type(2)));
typedef __bf16 bf16x2_t __attribute__((ext_vector_type(2)));
__device__ __forceinline__ unsigned cvt_pk_bf16(float lo, float hi) { const bf16x2_t r = __builtin_convertvector((f32x2_t){lo, hi}, bf16x2_t); unsigned u; __builtin_memcpy(&u, &r, 4); return u; }
template <class Epi, class Sched, bool ALIGN_EPI = false, bool SP2 = false>
__device__ __forceinline__ void gemm_phase(PG8_LAS unsigned char* lds, const Gemm g, const Sched& S, const Epi& E) {
    const int tid = threadIdx.x, wid = __builtin_amdgcn_readfirstlane(tid >> 6), lane = tid & 63, wr = wid >> 2, wc = wid & 3, fr = lane & 15, fq = lane >> 4;
    const int K = g.ld ? g.ld : g.K, nt = g.K / BK;
    const int ncol = g.ncol ? g.ncol : (1 << 30); const size_t ksplit = (size_t)g.K * 2;
    unsigned voffA[2], voffB[2];
#pragma unroll
    for (int i = 0; i < 2; ++i) { int R, C; stage_rc(tid * 16 + i * 8192, R, C); const int Rb = Epi::PERM ? ((R & ~31) + perm32(R & 31)) : R;
        voffA[i] = (unsigned)(R * K + C) * 2u; voffB[i] = (unsigned)(Rb * K + C) * 2u; }
    const size_t kstep = (size_t)(BK * 2);
    const size_t hstep = (size_t)HALF * K * 2;
    const size_t tstep = 2 * hstep;
    const unsigned ldsw = (unsigned)wid * 1024u;
    const int aoff = lds_byte(wr * 64 + fr, fq * 8), boff = lds_byte(wc * 32 + fr, fq * 8);
#define PG8_SA(b, h) (((b) * 2 + (h)) * HTB)
#define PG8_SB(b, h) ((4 + (b) * 2 + (h)) * HTB)
#define PG8_STAGE(bufoff, gbase, voff) do { _Pragma("unroll") for (int _i = 0; _i < 2; ++_i) \
        __builtin_amdgcn_global_load_lds((const unsigned*)((const char*)(gbase) + (voff)[_i]), (PG8_LAS unsigned*)(lds + (bufoff) + ldsw + _i * 8192), 16, 0, 0); } while (0)
#define PG8_LDA(dst, b, h) do { _Pragma("unroll") for (int m = 0; m < 4; ++m) _Pragma("unroll") for (int k = 0; k < 2; ++k) dst[m][k] = *(const PG8_LAS bf16x8*)(lds + PG8_SA(b, h) + aoff + m * 2048 + k * 1024); } while (0)
#define PG8_LDB(dst, b, h) do { _Pragma("unroll") for (int n = 0; n < 2; ++n) _Pragma("unroll") for (int k = 0; k < 2; ++k) dst[n][k] = *(const PG8_LAS bf16x8*)(lds + PG8_SB(b, h) + boff + n * 2048 + k * 1024); } while (0)
#define PG8_MMA(ai, bj, At, Bt) do { __builtin_amdgcn_s_setprio(1); _Pragma("unroll") for (int m = 0; m < 4; ++m) _Pragma("unroll") for (int n = 0; n < 2; ++n) _Pragma("unroll") for (int k = 0; k < 2; ++k) \
        acc[ai][bj][m][n] = __builtin_amdgcn_mfma_f32_16x16x32_bf16(Bt[n][k], At[m][k], acc[ai][bj][m][n], 0, 0, 0); __builtin_amdgcn_s_setprio(0); } while (0)
#define PG8_WAIT_V(n) asm volatile("s_waitcnt vmcnt(" #n ")" ::: "memory")
#define PG8_WAIT_L(n) asm volatile("s_waitcnt lgkmcnt(" #n ")" ::: "memory")
#define PG8_BAR __builtin_amdgcn_s_barrier()
#define PG8_SCHED __builtin_amdgcn_sched_barrier(0)
    Unit cur, nxt; int ui = 0;
    if (!S.next(0, cur)) return;
    f32x4 acc[2][2][4][2];
#pragma unroll
    for (int a = 0; a < 2; ++a)
#pragma unroll
        for (int b = 0; b < 2; ++b)
#pragma unroll
            for (int m = 0; m < 4; ++m)
#pragma unroll
                for (int n = 0; n < 2; ++n) acc[a][b][m][n] = (f32x4){0.f, 0.f, 0.f, 0.f};
    bf16x8 At[4][2], B0[2][2], B1[2][2];
    const char* cA = (const char*)g.A + (size_t)cur.pm * tstep + (size_t)(cur.pn / ncol) * ksplit; const char* cB = (const char*)g.Bt + (size_t)(cur.pn % ncol) * tstep + (size_t)(cur.pn / ncol) * ksplit;
    S.a_ready(cur);
    if constexpr (SP2) {
        PG8_STAGE(PG8_SB(0, 0), cB, voffB); PG8_STAGE(PG8_SB(0, 1), cB + hstep, voffB); PG8_STAGE(PG8_SA(0, 0), cA, voffA); PG8_STAGE(PG8_SA(0, 1), cA + hstep, voffA);
        if (wr == 1) PG8_BAR;
        PG8_WAIT_V(2); PG8_BAR;
        PG8_STAGE(PG8_SB(1, 0), cB + kstep, voffB); PG8_STAGE(PG8_SA(1, 0), cA + kstep, voffA); PG8_STAGE(PG8_SB(1, 1), cB + hstep + kstep, voffB);
        PG8_WAIT_V(6); PG8_BAR;
    } else {
        PG8_STAGE(PG8_SB(0, 0), cB, voffB); PG8_STAGE(PG8_SA(0, 0), cA, voffA); PG8_STAGE(PG8_SB(0, 1), cB + hstep, voffB); PG8_STAGE(PG8_SA(0, 1), cA + hstep, voffA);
        if (wr == 1) PG8_BAR;
        PG8_WAIT_V(4); PG8_BAR;
        PG8_STAGE(PG8_SB(1, 0), cB + kstep, voffB); PG8_STAGE(PG8_SA(1, 0), cA + kstep, voffA); PG8_STAGE(PG8_SB(1, 1), cB + hstep + kstep, voffB);
        PG8_WAIT_V(6); PG8_BAR;
    }
    for (;;) {
        const bool has_next = S.next(ui + 1, nxt);
        const char* nA = has_next ? (const char*)g.A + (size_t)nxt.pm * tstep + (size_t)(nxt.pn / ncol) * ksplit : cA; const char* nB = has_next ? (const char*)g.Bt + (size_t)(nxt.pn % ncol) * tstep + (size_t)(nxt.pn / ncol) * ksplit : cB;
        for (int t = 0; t < nt; t += 2) {
            const bool last = (t == nt - 2);
            const char* a1 = cA + (size_t)(t + 1) * kstep;
            const char* a2 = last ? nA : cA + (size_t)(t + 2) * kstep; const char* b2 = last ? nB : cB + (size_t)(t + 2) * kstep;
            const char* a3 = a2 + kstep; const char* b3 = b2 + kstep;
            if (last && has_next) S.a_ready(nxt);
            if constexpr (SP2) {
            PG8_LDB(B0, 0, 0); PG8_LDB(B1, 0, 1); PG8_SCHED; PG8_LDA(At, 0, 0); PG8_STAGE(PG8_SA(1, 1), a1 + hstep, voffA);
            PG8_WAIT_V(8); PG8_WAIT_L(0); PG8_BAR; PG8_MMA(0, 0, At, B0); PG8_MMA(0, 1, At, B1); PG8_BAR; PG8_SCHED;
            PG8_LDA(At, 0, 1); PG8_STAGE(PG8_SB(0, 0), b2, voffB); PG8_STAGE(PG8_SB(0, 1), b2 + hstep, voffB); PG8_STAGE(PG8_SA(0, 0), a2, voffA);
            PG8_WAIT_V(8); PG8_WAIT_L(0); PG8_BAR; PG8_MMA(1, 0, At, B0); PG8_MMA(1, 1, At, B1); PG8_BAR; PG8_SCHED;
            PG8_LDB(B0, 1, 0); PG8_LDB(B1, 1, 1); PG8_SCHED; PG8_LDA(At, 1, 0); PG8_STAGE(PG8_SA(0, 1), a2 + hstep, voffA);
            PG8_WAIT_V(8); PG8_WAIT_L(0); PG8_BAR; PG8_MMA(0, 0, At, B0); PG8_MMA(0, 1, At, B1); PG8_BAR; PG8_SCHED;
            PG8_LDA(At, 1, 1); PG8_STAGE(PG8_SB(1, 0), b3, voffB); PG8_STAGE(PG8_SB(1, 1), b3 + hstep, voffB); PG8_STAGE(PG8_SA(1, 0), a3, voffA);
            PG8_WAIT_V(8); PG8_WAIT_L(0); PG8_BAR; PG8_MMA(1, 0, At, B0); PG8_MMA(1, 1, At, B1); PG8_BAR; PG8_SCHED;
            } else {
            PG8_LDB(B0, 0, 0); PG8_SCHED; PG8_LDA(At, 0, 0); PG8_STAGE(PG8_SA(1, 1), a1 + hstep, voffA);
            PG8_WAIT_L(8); PG8_BAR; PG8_WAIT_L(0); PG8_MMA(0, 0, At, B0); PG8_BAR; PG8_SCHED;
            PG8_LDB(B1, 0, 1); PG8_STAGE(PG8_SB(0, 0), b2, voffB);
            PG8_BAR; PG8_WAIT_L(0); PG8_MMA(0, 1, At, B1); PG8_BAR;
            PG8_LDA(At, 0, 1); PG8_STAGE(PG8_SA(0, 0), a2, voffA);
            PG8_BAR; PG8_WAIT_L(0); PG8_MMA(1, 0, At, B0); PG8_BAR; PG8_SCHED;
            PG8_STAGE(PG8_SB(0, 1), b2 + hstep, voffB);
            PG8_WAIT_V(6); PG8_BAR; PG8_MMA(1, 1, At, B1); PG8_BAR;
            PG8_LDB(B0, 1, 0); PG8_SCHED; PG8_LDA(At, 1, 0); PG8_STAGE(PG8_SA(0, 1), a2 + hstep, voffA);
            PG8_WAIT_L(8); PG8_BAR; PG8_WAIT_L(0); PG8_MMA(0, 0, At, B0); PG8_BAR; PG8_SCHED;
            PG8_LDB(B1, 1, 1); PG8_STAGE(PG8_SB(1, 0), b3, voffB);
            PG8_BAR; PG8_WAIT_L(0); PG8_MMA(0, 1, At, B1); PG8_BAR;
            PG8_LDA(At, 1, 1); PG8_STAGE(PG8_SA(1, 0), a3, voffA);
            PG8_BAR; PG8_WAIT_L(0); PG8_MMA(1, 0, At, B0); PG8_BAR; PG8_SCHED;
            PG8_STAGE(PG8_SB(1, 1), b3 + hstep, voffB);
            PG8_WAIT_V(6); PG8_BAR; PG8_MMA(1, 1, At, B1); PG8_BAR;
            }
        }
        if constexpr (ALIGN_EPI) { if (wr == 0) PG8_BAR; }
        if constexpr (!Epi::AFTER_DRAIN) { E(acc, cur, wr, wc, fr, fq); S.done(cur); }
        if (!has_next) break;
#pragma unroll
        for (int a = 0; a < 2; ++a)
#pragma unroll
            for (int b = 0; b < 2; ++b)
#pragma unroll
                for (int m = 0; m < 4; ++m)
#pragma unroll
                    for (int n = 0; n < 2; ++n) acc[a][b][m][n] = (f32x4){0.f, 0.f, 0.f, 0.f};
        cur = nxt; cA = nA; cB = nB; ++ui;
        if constexpr (ALIGN_EPI) { if (wr == 1) PG8_BAR; }
    }
    PG8_WAIT_V(0);
    if constexpr (!ALIGN_EPI) { if (wr == 0) PG8_BAR; }
    PG8_BAR;
    if constexpr (Epi::AFTER_DRAIN) { E.fused(acc, cur, wr, wc, fr, fq, lds, wid, lane); S.done(cur); }
#undef PG8_SA
#undef PG8_SB
#undef PG8_STAGE
#undef PG8_LDA
#undef PG8_LDB
#undef PG8_MMA
#undef PG8_WAIT_V
#undef PG8_WAIT_L
#undef PG8_BAR
#undef PG8_SCHED
}
}

constexpr int DM = 1024, NBP = 8, SEQ = 2048, NBS = 32, DSEQ = 64, PAST = 2048;
constexpr int TP = NBP * SEQ, TS = NBS * DSEQ, TT = TP + TS;
constexpr int NKP = 2048, NKS = 2112;
constexpr int DFF = 2816, DINNER = 2048, CONVC = 4096;
constexpr int IN_DIM = 10344;
constexpr int CQ = 0, CK = 1024, CV = 1280, CQI = 1536, CKI = 2048, CWI = 2112, CZ = 2120, CXBC = 4168, CDT = 8264, CGATE = 8296;
constexpr int NIN = 33 * 256;
constexpr float EPS = 1e-6f;
constexpr int MASKW = 68;
constexpr size_t O_Y = 0, O_KP = 18874368, O_VP = 23068672, O_KIP = 27262976, O_CONVP = 28311552, O_SSMP = 28409856,
                 O_KS = 30507008, O_VS = 31031296, O_KIS = 31555584, O_CONVS = 31686656, O_SSMS = 32079872;
constexpr size_t MiB = 1u << 20;
constexpr size_t WS_CTL = 0, WS_MOD = 1 * MiB, WS_ROPE = 2 * MiB, WS_WI = 3 * MiB, WS_DT = 4 * MiB;
constexpr size_t WS_WBA = 8 * MiB, WS_WOUT = 10 * MiB, WS_WBS = 12 * MiB, WS_WGU = 16 * MiB, WS_WDN = 27 * MiB, WS_WG = 33 * MiB, WS_WIN = 37 * MiB;
constexpr size_t WS_MASK = 37 * MiB, WS_SSQ = 43 * MiB;
constexpr size_t WS_H = 54 * MiB, WS_Q = 90 * MiB, WS_KP = 126 * MiB, WS_KS = 134 * MiB, WS_VTP = 167 * MiB, WS_VTS = 175 * MiB, WS_XBC = 208 * MiB;
constexpr size_t WS_PART = WS_XBC;
constexpr size_t WS_GATES = 208 * MiB, WS_P1 = 280 * MiB, WS_MIXED = 316 * MiB, WS_ACT = 208 * MiB, WS_END = 352 * MiB;
constexpr int LDS_BYTES = 147456;

#define LAS __attribute__((address_space(3)))
typedef unsigned short bf16;
typedef unsigned v4u __attribute__((ext_vector_type(4)));
typedef unsigned v2u __attribute__((ext_vector_type(2)));
typedef float f32x4 __attribute__((ext_vector_type(4)));
typedef float f32x16 __attribute__((ext_vector_type(16)));
typedef short bf16x8 __attribute__((ext_vector_type(8)));
typedef short bf16x4 __attribute__((ext_vector_type(4)));
using pg8::cvt_pk_bf16;
#define LDS_WAIT() asm volatile("s_waitcnt lgkmcnt(0)" ::: "memory")
__device__ __forceinline__ float bf2f(unsigned h) { return __uint_as_float(h << 16); }
__device__ __forceinline__ float wave_sum(float v) {
#pragma unroll
    for (int o = 1; o < 64; o <<= 1) v += __shfl_xor(v, o);
    return v;
}
__device__ __forceinline__ float silu_f(float v) { return v * __builtin_amdgcn_rcpf(1.f + __expf(-v)); }
__device__ __forceinline__ float sigmoid_f(float v) { return __builtin_amdgcn_rcpf(1.f + __expf(-v)); }
__device__ __forceinline__ v4u pack8(const float* a) { v4u o; o.x = cvt_pk_bf16(a[0], a[1]); o.y = cvt_pk_bf16(a[2], a[3]); o.z = cvt_pk_bf16(a[4], a[5]); o.w = cvt_pk_bf16(a[6], a[7]); return o; }

struct Params { const float* in[27]; float* out; unsigned char* ws; int ph_lo, ph_hi; };

__device__ __forceinline__ void tr_item(const float* __restrict__ W, int ldw, int srccol, int nvalid, bf16* WT, size_t ldd, int dstrow, int k0, LAS float* scr, int lane) {
    { float t[32]; const int c = lane & 31;
#pragma unroll
      for (int i = 0; i < 32; ++i) t[i] = (c < nvalid) ? W[(size_t)(k0 + 2 * i + (lane >> 5)) * ldw + srccol + c] : 0.f;
#pragma unroll
      for (int i = 0; i < 32; ++i) scr[(2 * i + (lane >> 5)) * 33 + c] = t[i]; }
    LDS_WAIT();
    const int c = lane & 7;
#pragma unroll
    for (int j = 0; j < 4; ++j) { const int n = (lane >> 3) + 8 * j; const LAS float* s = scr + (8 * c) * 33 + n;
        v4u o; o.x = cvt_pk_bf16(s[0 * 33], s[1 * 33]); o.y = cvt_pk_bf16(s[2 * 33], s[3 * 33]); o.z = cvt_pk_bf16(s[4 * 33], s[5 * 33]); o.w = cvt_pk_bf16(s[6 * 33], s[7 * 33]);
        *(v4u*)(WT + (size_t)(dstrow + n) * ldd + k0 + 8 * c) = o; }
    LDS_WAIT();
}

__device__ __forceinline__ void phase0(const Params& p, LAS unsigned char* lds, int tid, int lane, int wave) {
    const int G = gridDim.x, bx = blockIdx.x;
    unsigned char* ws = p.ws;
    {
        LAS float* sc = (LAS float*)lds;
        const float* w_ada = p.in[9];
        float* part = (float*)(ws + WS_PART);
        for (int it = bx; it < 192; it += G) {
            const int ks = it / 24, cb = it % 24;
            __syncthreads();
            for (int i = tid; i < 40 * 128; i += 512) { const int r = i >> 7, k = i & 127; const float c = (r < 8) ? p.in[7][r * DM + ks * 128 + k] : p.in[8][(r - 8) * DM + ks * 128 + k]; sc[i] = silu_f(c); }
            __syncthreads();
            const int col = cb * 256 + (tid & 255), rh = tid >> 8;
            float a[20];
#pragma unroll
            for (int r = 0; r < 20; ++r) a[r] = 0.f;
            const float* wp = w_ada + (size_t)(ks * 128) * 6144 + col;
            for (int k0 = 0; k0 < 128; k0 += 8) {
                float w8[8];
#pragma unroll
                for (int i = 0; i < 8; ++i) w8[i] = wp[(size_t)(k0 + i) * 6144];
#pragma unroll
                for (int r = 0; r < 20; ++r) { const f32x4 s0 = *(const LAS f32x4*)(sc + (rh * 20 + r) * 128 + k0), s1 = *(const LAS f32x4*)(sc + (rh * 20 + r) * 128 + k0 + 4);
                    a[r] += (s0[0] * w8[0] + s0[1] * w8[1]) + (s0[2] * w8[2] + s0[3] * w8[3]) + (s1[0] * w8[4] + s1[1] * w8[5]) + (s1[2] * w8[6] + s1[3] * w8[7]); }
            }
#pragma unroll
            for (int r = 0; r < 20; ++r) part[((size_t)ks * 40 + rh * 20 + r) * 6144 + col] = a[r];
        }
        __syncthreads();
    }
    {
        LAS float* scr = (LAS float*)(lds + wave * 8704);
        const int gw = bx * 8 + wave, NGW = G * 8;
        constexpr int I_IN = 16 * 264, I_G = 16 * 64, I_BA = 16 * 32, I_OUT = 16 * 32, I_BS = 32 * 32, I_GU = 16 * 176, I_DN = 44 * 32;
        constexpr int NIT = I_IN + I_G + I_BA + I_OUT + I_BS + I_GU + I_DN;
        for (int it = gw; it < NIT; it += NGW) {
            int r = it;
            if (r < I_IN) { const int kb = r / 264, rg = r % 264, pn = rg >> 3, w8 = rg & 7, bj = w8 >> 2, wc = w8 & 3; int src, nv = 32;
                if (pn < 8) src = 256 * pn + 64 * wc + 32 * bj;
                else if (pn == 8) { if (wc == 0) src = CKI + 32 * bj; else if (wc == 1) { if (bj == 0) { src = CWI; nv = 8; } else src = CDT; } else { src = 0; nv = 0; } }
                else if (pn < 17) src = CZ + (rg - 72) * 32; else src = CXBC + (rg - 136) * 32;
                tr_item(p.in[13], IN_DIM, src, nv, (bf16*)(ws + WS_WIN), 1024, rg * 32, kb * 64, scr, lane); continue; } r -= I_IN;
            if (r < I_G) { const int kb = r / 64, rg = r % 64; tr_item(p.in[13], IN_DIM, CGATE + rg * 32, 32, (bf16*)(ws + WS_WG), 1024, rg * 32, kb * 64, scr, lane); continue; } r -= I_G;
            if (r < I_BA) { const int kb = r / 32, rg = r % 32; tr_item(p.in[22], 1024, rg * 32, 32, (bf16*)(ws + WS_WBA), 1024, rg * 32, kb * 64, scr, lane); continue; } r -= I_BA;
            if (r < I_OUT) { const int kb = r / 32, rg = r % 32; tr_item(p.in[24], 1024, rg * 32, 32, (bf16*)(ws + WS_WOUT), 1024, rg * 32, kb * 64, scr, lane); continue; } r -= I_OUT;
            if (r < I_BS) { const int kb = r / 32, rg = r % 32; tr_item(p.in[23], 1024, rg * 32, 32, (bf16*)(ws + WS_WBS), 2048, rg * 32, kb * 64, scr, lane); continue; } r -= I_BS;
            if (r < I_GU) { const int kb = r / 176, rg = r % 176, pt = rg >> 3, w8 = rg & 7, half = w8 >> 2, r4 = w8 & 3;
                tr_item(p.in[25], 2 * DFF, half * DFF + 128 * pt + 32 * r4, 32, (bf16*)(ws + WS_WGU), 1024, rg * 32, kb * 64, scr, lane); continue; } r -= I_GU;
            { const int kb = r / 32, rg = r % 32; tr_item(p.in[26], 1024, rg * 32, 32, (bf16*)(ws + WS_WDN), DFF, rg * 32, kb * 64, scr, lane); }
        }
    }
    {
        const int gt = bx * 512 + tid, NGT = G * 512;
        const float* cki = p.in[4]; bf16* KIS = (bf16*)(p.out + O_SSMS) + (size_t)TT * 512 + (size_t)NBP * NKP * 64;
        for (int i = gt; i < 524288; i += NGT) { const size_t e = (size_t)i * 8; const int d = (int)(e & 63), s = (int)((e >> 6) & 2047), b = (int)(e >> 17);
            const f32x4 x0 = *(const f32x4*)(cki + e), x1 = *(const f32x4*)(cki + e + 4);
            v4u o; o.x = cvt_pk_bf16(x0[0], x0[1]); o.y = cvt_pk_bf16(x0[2], x0[3]); o.z = cvt_pk_bf16(x1[0], x1[1]); o.w = cvt_pk_bf16(x1[2], x1[3]);
            *(v4u*)(KIS + ((size_t)b * NKS + s) * 64 + d) = o; }
        float* rope = (float*)(ws + WS_ROPE);
        for (int i = gt; i < NKS * 32; i += NGT) { const int pos = i >> 5, j = i & 31;
            double invd = 1.0; for (int k = 0; k < j; ++k) invd *= 0.74989420933245582;
            const float inv = (float)invd; const float ang = (float)pos * inv;
            const double x = (double)ang; const double q = __builtin_rint(x * 0.63661977236758134); const double r = x - q * 1.5707963267948966; const double r2 = r * r;
            const double sn = r * (1.0 + r2 * (-1.0 / 6 + r2 * (1.0 / 120 + r2 * (-1.0 / 5040 + r2 * (1.0 / 362880 + r2 * (-1.0 / 39916800))))));
            const double cs = 1.0 + r2 * (-0.5 + r2 * (1.0 / 24 + r2 * (-1.0 / 720 + r2 * (1.0 / 40320 + r2 * (-1.0 / 3628800 + r2 * (1.0 / 479001600))))));
            const int iq = ((int)q) & 3; double so, co;
            if (iq == 0) { so = sn; co = cs; } else if (iq == 1) { so = cs; co = -sn; } else if (iq == 2) { so = -sn; co = -cs; } else { so = -cs; co = sn; }
            rope[i] = (float)co; rope[NKS * 32 + i] = (float)so; }
    }
}

template <bool FROM_PART>
__device__ __forceinline__ void normmod_phase(const Params& p, LAS unsigned char* lds, int tid, int lane, int wave, const float* xp, const float* xs, const float* g, int off_sh, int off_sc, bf16* H) {
    const int bx = blockIdx.x, G = gridDim.x;
    unsigned char* ws = p.ws;
    const float* part = (const float*)(ws + WS_PART); const float* b_ada = p.in[10]; float* MOD = (float*)(ws + WS_MOD);
    LAS float* lsh = (LAS float*)lds; LAS float* lsc = lsh + 1024;
    if (FROM_PART) {
        for (int it = bx; it < 240; it += G) { const int row = it / 6, seg = it % 6;
            for (int c = tid; c < 1024; c += 512) { float v = b_ada[seg * 1024 + c];
#pragma unroll
                for (int ks = 0; ks < 8; ++ks) v += part[((size_t)ks * 40 + row) * 6144 + seg * 1024 + c];
                MOD[row * 6144 + seg * 1024 + c] = v; } }
    }
    const int rows_per = (TT + G - 1) / G;
    const int r_lo = bx * rows_per, r_hi = (r_lo + rows_per < TT) ? r_lo + rows_per : TT;
    int r = r_lo;
    while (r < r_hi) {
        const int mrow = (r < TP) ? (r >> 11) : 8 + ((r - TP) >> 6);
        const int gend = (r < TP) ? ((r >> 11) + 1) << 11 : TP + ((((r - TP) >> 6) + 1) << 6);
        const int e = gend < r_hi ? gend : r_hi;
        __syncthreads();
        for (int c = tid; c < 1024; c += 512) {
            float vsh, vsc;
            if (FROM_PART) { vsh = b_ada[off_sh + c]; vsc = b_ada[off_sc + c];
#pragma unroll
                for (int ks = 0; ks < 8; ++ks) { vsh += part[((size_t)ks * 40 + mrow) * 6144 + off_sh + c]; vsc += part[((size_t)ks * 40 + mrow) * 6144 + off_sc + c]; } }
            else { vsh = MOD[mrow * 6144 + off_sh + c]; vsc = MOD[mrow * 6144 + off_sc + c]; }
            lsh[c] = vsh; lsc[c] = (1.f + vsc) * g[c];
        }
        __syncthreads();
        f32x4 vn[4];
        if (r + wave < e) { const int row0 = r + wave; const float* xr = (row0 < TP) ? xp + (size_t)row0 * DM : xs + (size_t)(row0 - TP) * DM;
#pragma unroll
            for (int j = 0; j < 4; ++j) vn[j] = *(const f32x4*)(xr + 4 * lane + 256 * j); }
        for (int row = r + wave; row < e; row += 8) {
            f32x4 v[4]; float s = 0.f;
#pragma unroll
            for (int j = 0; j < 4; ++j) { v[j] = vn[j]; s += (v[j][0] * v[j][0] + v[j][1] * v[j][1]) + (v[j][2] * v[j][2] + v[j][3] * v[j][3]); }
            if (row + 8 < e) { const int rn = row + 8; const float* xr = (rn < TP) ? xp + (size_t)rn * DM : xs + (size_t)(rn - TP) * DM;
#pragma unroll
                for (int j = 0; j < 4; ++j) vn[j] = *(const f32x4*)(xr + 4 * lane + 256 * j); }
            const float rstd = rsqrtf(wave_sum(s) * (1.f / DM) + EPS);
#pragma unroll
            for (int j = 0; j < 4; ++j) { const int c = 4 * lane + 256 * j; const f32x4 a = *(const LAS f32x4*)(lsc + c), b = *(const LAS f32x4*)(lsh + c);
                v2u o; o.x = cvt_pk_bf16(v[j][0] * rstd * a[0] + b[0], v[j][1] * rstd * a[1] + b[1]); o.y = cvt_pk_bf16(v[j][2] * rstd * a[2] + b[2], v[j][3] * rstd * a[3] + b[3]);
                *(v2u*)(H + (size_t)row * DM + c) = o; }
        }
        r = e;
    }
    __syncthreads();
}

#define EPI_ROWS_BEGIN \
    _Pragma("unroll") for (int ai = 0; ai < 2; ++ai) _Pragma("unroll") for (int m = 0; m < 4; ++m) { \
        const int row = u.pm * 256 + ai * 128 + wr * 64 + m * 16 + fr; float a[8], b[8]; \
        _Pragma("unroll") for (int e = 0; e < 4; ++e) { a[e] = acc[ai][0][m][0][e]; a[4 + e] = acc[ai][0][m][1][e]; b[e] = acc[ai][1][m][0][e]; b[4 + e] = acc[ai][1][m][1][e]; }
#define EPI_ROWS_END }

#define EPI_LOADROW(AI, M) { _Pragma("unroll") for (int e = 0; e < 4; ++e) { a[e] = acc[AI][0][M][0][e]; a[4 + e] = acc[AI][0][M][1][e]; b[e] = acc[AI][1][M][0][e]; b[4 + e] = acc[AI][1][M][1][e]; } }
#define EPI_ROWS_LOOP_BEGIN \
    _Pragma("unroll 1") for (int rr = 0; rr < 8; ++rr) { \
        const int row = u.pm * 256 + (rr >> 2) * 128 + wr * 64 + (rr & 3) * 16 + fr; float a[8], b[8]; \
        switch (rr) { case 0: EPI_LOADROW(0, 0) break; case 1: EPI_LOADROW(0, 1) break; case 2: EPI_LOADROW(0, 2) break; case 3: EPI_LOADROW(0, 3) break; \
                      case 4: EPI_LOADROW(1, 0) break; case 5: EPI_LOADROW(1, 1) break; case 6: EPI_LOADROW(1, 2) break; default: EPI_LOADROW(1, 3) break; }

struct EpiIn {
    static constexpr bool PERM = true, AFTER_DRAIN = false;
    bf16 *Q, *KP, *KS, *VTP, *VTS, *QI, *KIP, *KIS, *Z, *XBC; float *WI, *DT, *out; const float *gq, *gk, *dtb, *rope;
    __device__ __forceinline__ void operator()(const f32x4 (&acc)[2][2][4][2], const pg8::Unit& u, int wr, int wc, int fr, int fq) const {
        const int pn = u.pn;
        if (pn == 8 && wc >= 2) return;
        EPI_ROWS_LOOP_BEGIN
            const bool isS = row >= TP; int sb, t, pos;
            if (!isS) { sb = row >> 11; t = row & 2047; pos = t; } else { const int s = row - TP; sb = s >> 6; t = s & 63; pos = PAST + t; }
            if (pn >= 17) {
                const int col = 256 * (pn - 17) + 32 * wc + 8 * fq;
                *(v4u*)(XBC + (size_t)row * CONVC + col) = pack8(a); *(v4u*)(XBC + (size_t)row * CONVC + col + 128) = pack8(b);
                const int L = isS ? DSEQ : SEQ;
                if (t >= L - 3) { float* o = out + (isS ? O_CONVS : O_CONVP) + (size_t)(sb * 3 + (t - (L - 3))) * CONVC + col;
                    *(f32x4*)(o) = (f32x4){a[0], a[1], a[2], a[3]}; *(f32x4*)(o + 4) = (f32x4){a[4], a[5], a[6], a[7]};
                    *(f32x4*)(o + 128) = (f32x4){b[0], b[1], b[2], b[3]}; *(f32x4*)(o + 132) = (f32x4){b[4], b[5], b[6], b[7]}; }
            } else if (pn >= 9) {
                const int col = 256 * (pn - 9) + 32 * wc + 8 * fq;
#pragma unroll
                for (int e = 0; e < 8; ++e) { a[e] = silu_f(a[e]); b[e] = silu_f(b[e]); }
                *(v4u*)(Z + (size_t)row * DINNER + col) = pack8(a); *(v4u*)(Z + (size_t)row * DINNER + col + 128) = pack8(b);
            } else if (pn == 8 && wc == 1) {
                if (fq == 0) { float* w = WI + (size_t)row * 8; const float sc = 0.35355339059327373f * 0.125f;
                    *(f32x4*)w = (f32x4){a[0] * sc, a[1] * sc, a[2] * sc, a[3] * sc}; *(f32x4*)(w + 4) = (f32x4){a[4] * sc, a[5] * sc, a[6] * sc, a[7] * sc}; }
                float d[8];
#pragma unroll
                for (int e = 0; e < 8; ++e) { const float x = b[e] + dtb[8 * fq + e]; d[e] = x > 20.f ? x : log1pf(__expf(x)); }
                float* o = DT + (size_t)row * 32 + 8 * fq; *(f32x4*)o = (f32x4){d[0], d[1], d[2], d[3]}; *(f32x4*)(o + 4) = (f32x4){d[4], d[5], d[6], d[7]};
            } else if (pn == 5) {
                float* o = out + (isS ? O_VS + ((size_t)(row - TP) * 4 + wc) * 64 : O_VP + ((size_t)row * 4 + wc) * 64) + 8 * fq;
                *(f32x4*)(o) = (f32x4){a[0], a[1], a[2], a[3]}; *(f32x4*)(o + 4) = (f32x4){a[4], a[5], a[6], a[7]};
                *(f32x4*)(o + 32) = (f32x4){b[0], b[1], b[2], b[3]}; *(f32x4*)(o + 36) = (f32x4){b[4], b[5], b[6], b[7]};
                bf16* vb = (isS ? VTS + ((size_t)(sb * 4 + wc) * DSEQ + t) * 64 : VTP + ((size_t)(sb * 4 + wc) * NKP + t) * 64) + 8 * fq;
                *(v4u*)vb = pack8(a); *(v4u*)(vb + 32) = pack8(b);
            } else {
                if (pn <= 4) { float ss = 0.f;
#pragma unroll
                    for (int e = 0; e < 8; ++e) ss += a[e] * a[e] + b[e] * b[e];
                    ss += __shfl_xor(ss, 16); ss += __shfl_xor(ss, 32);
                    const float rstd = rsqrtf(ss * (1.f / 64.f) + EPS); const float* g = (pn < 4) ? gq : gk;
#pragma unroll
                    for (int e = 0; e < 8; ++e) { a[e] *= rstd * g[8 * fq + e]; b[e] *= rstd * g[32 + 8 * fq + e]; } }
                { const float* cp = rope + (size_t)pos * 32 + 8 * fq; const float* sp = cp + NKS * 32;
#pragma unroll
                  for (int e = 0; e < 8; ++e) { const float c = cp[e], s = sp[e], x1 = a[e], x2 = b[e]; a[e] = x1 * c - x2 * s; b[e] = x2 * c + x1 * s; } }
                if (pn < 4) { const float qs = 0.125f * 1.4426950408889634f;
#pragma unroll
                    for (int e = 0; e < 8; ++e) { a[e] *= qs; b[e] *= qs; }
                    bf16* q = Q + (size_t)row * DM + (4 * pn + wc) * 64 + 8 * fq; *(v4u*)q = pack8(a); *(v4u*)(q + 32) = pack8(b); }
                else if (pn == 4) {
                    float* o = out + (isS ? O_KS + ((size_t)(row - TP) * 4 + wc) * 64 : O_KP + ((size_t)row * 4 + wc) * 64) + 8 * fq;
                    *(f32x4*)(o) = (f32x4){a[0], a[1], a[2], a[3]}; *(f32x4*)(o + 4) = (f32x4){a[4], a[5], a[6], a[7]};
                    *(f32x4*)(o + 32) = (f32x4){b[0], b[1], b[2], b[3]}; *(f32x4*)(o + 36) = (f32x4){b[4], b[5], b[6], b[7]};
                    bf16* kb = (isS ? KS + ((size_t)(sb * 4 + wc) * DSEQ + t) * 64 : KP + ((size_t)(sb * 4 + wc) * NKP + t) * 64) + 8 * fq;
                    *(v4u*)kb = pack8(a); *(v4u*)(kb + 32) = pack8(b);
                } else if (pn < 8) { bf16* q = QI + (size_t)row * 512 + (4 * (pn - 6) + wc) * 64 + 8 * fq; *(v4u*)q = pack8(a); *(v4u*)(q + 32) = pack8(b); }
                else {
                    float* o = out + (isS ? O_KIS + (size_t)(row - TP) * 64 : O_KIP + (size_t)row * 64) + 8 * fq;
                    *(f32x4*)(o) = (f32x4){a[0], a[1], a[2], a[3]}; *(f32x4*)(o + 4) = (f32x4){a[4], a[5], a[6], a[7]};
                    *(f32x4*)(o + 32) = (f32x4){b[0], b[1], b[2], b[3]}; *(f32x4*)(o + 36) = (f32x4){b[4], b[5], b[6], b[7]};
                    bf16* kb = (isS ? KIS + ((size_t)sb * NKS + pos) * 64 : KIP + (size_t)row * 64) + 8 * fq;
                    *(v4u*)kb = pack8(a); *(v4u*)(kb + 32) = pack8(b);
                }
            }
        EPI_ROWS_END
    }
};

__device__ __forceinline__ void unpack8(const v4u w, float* f) {
    f[0] = __uint_as_float(w.x << 16); f[1] = __uint_as_float(w.x & 0xffff0000u); f[2] = __uint_as_float(w.y << 16); f[3] = __uint_as_float(w.y & 0xffff0000u);
    f[4] = __uint_as_float(w.z << 16); f[5] = __uint_as_float(w.z & 0xffff0000u); f[6] = __uint_as_float(w.w << 16); f[7] = __uint_as_float(w.w & 0xffff0000u);
}
__device__ __forceinline__ int mod_row(int row) { return (row < TP) ? (row >> 11) : 8 + ((row - TP) >> 6); }

struct EpiGates {
    static constexpr bool PERM = true, AFTER_DRAIN = false; bf16* G;
    __device__ __forceinline__ void operator()(const f32x4 (&acc)[2][2][4][2], const pg8::Unit& u, int wr, int wc, int fr, int fq) const {
        EPI_ROWS_BEGIN
            const int col = 256 * u.pn + 32 * wc + 8 * fq;
#pragma unroll
            for (int e = 0; e < 8; ++e) { a[e] = sigmoid_f(a[e]); b[e] = sigmoid_f(b[e]); }
            *(v4u*)(G + (size_t)row * 2048 + col) = pack8(a); *(v4u*)(G + (size_t)row * 2048 + col + 128) = pack8(b);
        EPI_ROWS_END
    }
};
struct EpiP1 {
    static constexpr bool PERM = true, AFTER_DRAIN = false; const bf16* G; bf16* P1;
    __device__ __forceinline__ void operator()(const f32x4 (&acc)[2][2][4][2], const pg8::Unit& u, int wr, int wc, int fr, int fq) const {
        EPI_ROWS_BEGIN
            const int col = 256 * u.pn + 32 * wc + 8 * fq;
            *(v4u*)(P1 + (size_t)row * DM + col) = pack8(a); *(v4u*)(P1 + (size_t)row * DM + col + 128) = pack8(b);
        EPI_ROWS_END
    }
};
struct EpiMixed {
    static constexpr bool PERM = true, AFTER_DRAIN = false; const bf16* G; const bf16* P1; bf16* MX;
    __device__ __forceinline__ void operator()(const f32x4 (&acc)[2][2][4][2], const pg8::Unit& u, int wr, int wc, int fr, int fq) const {
        EPI_ROWS_BEGIN
            const int col = 256 * u.pn + 32 * wc + 8 * fq; float g0[8], g1[8], p0[8], p1[8], h0[8], h1[8];
            unpack8(*(const v4u*)(G + (size_t)row * 2048 + 1024 + col), g0); unpack8(*(const v4u*)(G + (size_t)row * 2048 + 1024 + col + 128), g1);
            unpack8(*(const v4u*)(G + (size_t)row * 2048 + col), h0); unpack8(*(const v4u*)(G + (size_t)row * 2048 + col + 128), h1);
            unpack8(*(const v4u*)(P1 + (size_t)row * DM + col), p0); unpack8(*(const v4u*)(P1 + (size_t)row * DM + col + 128), p1);
#pragma unroll
            for (int e = 0; e < 8; ++e) { a[e] = p0[e] * h0[e] + a[e] * g0[e]; b[e] = p1[e] * h1[e] + b[e] * g1[e]; }
            *(v4u*)(MX + (size_t)row * DM + col) = pack8(a); *(v4u*)(MX + (size_t)row * DM + col + 128) = pack8(b);
        EPI_ROWS_END
    }
};
struct EpiRes {
    static constexpr bool PERM = true, AFTER_DRAIN = false; const float* xp; const float* xs; const float* MOD; int moff; float* out;
    __device__ __forceinline__ void operator()(const f32x4 (&acc)[2][2][4][2], const pg8::Unit& u, int wr, int wc, int fr, int fq) const {
        EPI_ROWS_BEGIN
            const int col = 256 * u.pn + 32 * wc + 8 * fq;
            const float* xr = ((row < TP) ? xp + (size_t)row * DM : xs + (size_t)(row - TP) * DM) + col;
            const float* mr = MOD + (size_t)mod_row(row) * 6144 + moff + col; float* o = out + (size_t)row * DM + col;
#pragma unroll
            for (int hh = 0; hh < 2; ++hh) { const float* v = hh ? b : a;
#pragma unroll
                for (int q = 0; q < 2; ++q) { const f32x4 x = *(const f32x4*)(xr + 128 * hh + 4 * q), g = *(const f32x4*)(mr + 128 * hh + 4 * q);
                    *(f32x4*)(o + 128 * hh + 4 * q) = (f32x4){x[0] + g[0] * v[4 * q], x[1] + g[1] * v[4 * q + 1], x[2] + g[2] * v[4 * q + 2], x[3] + g[3] * v[4 * q + 3]}; } }
        EPI_ROWS_END
    }
};
struct EpiResAdd {
    static constexpr bool PERM = true, AFTER_DRAIN = false; const float* MOD; int moff; float* out;
    __device__ __forceinline__ void operator()(const f32x4 (&acc)[2][2][4][2], const pg8::Unit& u, int wr, int wc, int fr, int fq) const {
        EPI_ROWS_BEGIN
            const int col = 256 * (u.pn & 3) + 32 * wc + 8 * fq;
            const float* mr = MOD + (size_t)mod_row(row) * 6144 + moff + col; float* o = out + (size_t)row * DM + col;
#pragma unroll
            for (int e = 0; e < 8; ++e) { unsafeAtomicAdd(o + e, mr[e] * a[e]); unsafeAtomicAdd(o + 128 + e, mr[128 + e] * b[e]); }
        EPI_ROWS_END
    }
};
struct EpiAct {
    static constexpr bool PERM = true, AFTER_DRAIN = false; bf16* ACT;
    __device__ __forceinline__ void operator()(const f32x4 (&acc)[2][2][4][2], const pg8::Unit& u, int wr, int wc, int fr, int fq) const {
        EPI_ROWS_BEGIN
            const int col = 128 * u.pn + 32 * wc + 8 * fq;
#pragma unroll
            for (int e = 0; e < 8; ++e) a[e] = silu_f(a[e]) * b[e];
            *(v4u*)(ACT + (size_t)row * DFF + col) = pack8(a);
        EPI_ROWS_END
    }
};

__device__ __forceinline__ void ynorm_phase(const Params& p, int lane, int wave, bf16* Y, const float* SSQ) {
    const float* gn = p.in[21];
    const int gw = blockIdx.x * 8 + wave, NGW = gridDim.x * 8;
    v4u yn[4]; f32x4 sn[4];
    if (gw < TT) {
#pragma unroll
        for (int j = 0; j < 4; ++j) { const int c = 8 * lane + 512 * j; yn[j] = *(const v4u*)(Y + (size_t)gw * DINNER + c); sn[j] = *(const f32x4*)(SSQ + (size_t)gw * 32 + 4 * (c >> 8)); } }
    for (int row = gw; row < TT; row += NGW) {
        v4u yc[4]; f32x4 sc4[4];
#pragma unroll
        for (int j = 0; j < 4; ++j) { yc[j] = yn[j]; sc4[j] = sn[j]; }
        if (row + NGW < TT) { const int rn = row + NGW;
#pragma unroll
            for (int j = 0; j < 4; ++j) { const int c = 8 * lane + 512 * j; yn[j] = *(const v4u*)(Y + (size_t)rn * DINNER + c); sn[j] = *(const f32x4*)(SSQ + (size_t)rn * 32 + 4 * (c >> 8)); } }
#pragma unroll
        for (int j = 0; j < 4; ++j) { const int c = 8 * lane + 512 * j;
            const f32x4 sq = sc4[j];
            const float rstd = rsqrtf(((sq[0] + sq[1]) + (sq[2] + sq[3])) * (1.f / 256.f) + EPS);
            float y[8]; unpack8(yc[j], y);
            const f32x4 g0 = *(const f32x4*)(gn + c), g1 = *(const f32x4*)(gn + c + 4);
            y[0] *= rstd * g0[0]; y[1] *= rstd * g0[1]; y[2] *= rstd * g0[2]; y[3] *= rstd * g0[3]; y[4] *= rstd * g1[0]; y[5] *= rstd * g1[1]; y[6] *= rstd * g1[2]; y[7] *= rstd * g1[3];
            *(v4u*)(Y + (size_t)row * DINNER + c) = pack8(y); }
    }
}

__device__ __forceinline__ void conv_stream(bf16* base, float (&h0)[8], float (&h1)[8], float (&h2)[8], const float* wconv, const float* bconv, int col) {
    float w[4][8], bias[8];
#pragma unroll
    for (int j = 0; j < 4; ++j) { const f32x4 w0 = *(const f32x4*)(wconv + j * CONVC + col), w1 = *(const f32x4*)(wconv + j * CONVC + col + 4);
        w[j][0] = w0[0]; w[j][1] = w0[1]; w[j][2] = w0[2]; w[j][3] = w0[3]; w[j][4] = w1[0]; w[j][5] = w1[1]; w[j][6] = w1[2]; w[j][7] = w1[3]; }
    { const f32x4 b0 = *(const f32x4*)(bconv + col), b1 = *(const f32x4*)(bconv + col + 4);
      bias[0] = b0[0]; bias[1] = b0[1]; bias[2] = b0[2]; bias[3] = b0[3]; bias[4] = b1[0]; bias[5] = b1[1]; bias[6] = b1[2]; bias[7] = b1[3]; }
    for (int r0 = 0; r0 < 64; r0 += 16) {
        v4u raw[16];
#pragma unroll
        for (int k = 0; k < 16; ++k) raw[k] = *(const v4u*)(base + (size_t)(r0 + k) * CONVC);
#pragma unroll
        for (int k = 0; k < 16; ++k) { float x[8], o[8]; unpack8(raw[k], x);
#pragma unroll
            for (int e = 0; e < 8; ++e) { o[e] = silu_f(bias[e] + w[0][e] * h0[e] + w[1][e] * h1[e] + w[2][e] * h2[e] + w[3][e] * x[e]); h0[e] = h1[e]; h1[e] = h2[e]; h2[e] = x[e]; }
            *(v4u*)(base + (size_t)(r0 + k) * CONVC) = pack8(o); }
    }
}
__device__ __forceinline__ void conv_phase(const Params& p, int tid, bf16* XBC) {
    const float* wconv = p.in[16]; const float* bconv = p.in[17];
    const int G = gridDim.x, bx = blockIdx.x;
    for (int it = bx; it < 256; it += G) {
        const int b = it >> 5, cb = it & 31, cg = tid & 15, run = tid >> 4, col = cb * 128 + cg * 8;
        bf16* base = XBC + (size_t)(b * SEQ + run * 64) * CONVC + col;
        float h0[8], h1[8], h2[8];
        if (run > 0) { unpack8(*(const v4u*)(base - 3 * CONVC), h0); unpack8(*(const v4u*)(base - 2 * CONVC), h1); unpack8(*(const v4u*)(base - CONVC), h2); }
        else {
#pragma unroll
            for (int e = 0; e < 8; ++e) { h0[e] = 0.f; h1[e] = 0.f; h2[e] = 0.f; } }
        __syncthreads();
        conv_stream(base, h0, h1, h2, wconv, bconv, col);
        __syncthreads();
    }
    for (int i = bx * 512 + tid; i < NBS * 512; i += G * 512) {
        const int b = i >> 9, col = (i & 511) * 8;
        bf16* base = XBC + (size_t)(TP + b * DSEQ) * CONVC + col;
        const float* sp = p.in[5] + (size_t)b * 3 * CONVC + col;
        float h0[8], h1[8], h2[8];
#pragma unroll
        for (int e = 0; e < 8; ++e) { h0[e] = sp[e]; h1[e] = sp[CONVC + e]; h2[e] = sp[2 * CONVC + e]; }
        conv_stream(base, h0, h1, h2, wconv, bconv, col);
    }
}

#define MFMA32(a, b, c) __builtin_amdgcn_mfma_f32_32x32x16_bf16((a), (b), (c), 0, 0, 0)
typedef short s16x4 __attribute__((ext_vector_type(4)));
#ifndef TR_SLOW
#define TR_SLOW 0
#endif
__device__ __forceinline__ bf16x8 tr_frag(const LAS bf16* tile, int pitch, int ra, int rb, int col, int lane) {
#if TR_SLOW
    bf16x8 r;
#pragma unroll
    for (int e = 0; e < 4; ++e) { r[e] = (short)tile[(ra + e) * pitch + col]; r[4 + e] = (short)tile[(rb + e) * pitch + col]; }
    return r;
#else
    const int tq = (lane & 15) >> 2, tp = lane & 3, cb = (col & ~15) + 4 * tp;
    const s16x4 lo = __builtin_amdgcn_ds_read_tr16_b64_v4i16((LAS s16x4*)(tile + (ra + tq) * pitch + cb)), hi = __builtin_amdgcn_ds_read_tr16_b64_v4i16((LAS s16x4*)(tile + (rb + tq) * pitch + cb));
    return (bf16x8){lo[0], lo[1], lo[2], lo[3], hi[0], hi[1], hi[2], hi[3]};
#endif
}
constexpr int SS_TILE = 44032, SS_XN = 0, SS_BN = 9216, SS_CN = 26624, SS_HS = 88064, SS_HSZ = 17408, SS_ACS = 122880, SS_SQ = 126976;
__device__ __forceinline__ void ssd_unit(const Params& p, LAS unsigned char* lds, int tid, int lane, int wave, bool isS, int b, int h,
                                         const bf16* XBC, const float* DT, bf16* Y, float* SSQ) {
    const int g = h >> 2, nch = isS ? 1 : 32, tok0 = isS ? TP + b * DSEQ : b * SEQ;
    const float a_h = -__expf(p.in[19][h]), d_h = p.in[20][h];
    LAS float* acs = (LAS float*)(lds + SS_ACS + wave * 512); LAS float* dtv = acs + 64;
    const int l32 = lane & 31, hf = lane >> 5, blk = (lane >> 4) & 1, tq = (lane & 15) >> 2, tp = lane & 3;
    const bool ywave = wave < 4; const int w4 = wave & 3;
    f32x16 hs0, hs1;
    float* sout = p.out + (isS ? O_SSMS : O_SSMP) + ((size_t)(b * 32 + h) * 64) * 128;
#pragma unroll
    for (int i = 0; i < 16; ++i) { hs0[i] = 0.f; hs1[i] = 0.f; }
    if (isS && !ywave) { const float* s0 = p.in[6] + ((size_t)(b * 32 + h) * 64) * 128;
#pragma unroll
        for (int i = 0; i < 16; ++i) { const int pr = 8 * (i >> 2) + 4 * hf + (i & 3); hs0[i] = s0[(size_t)pr * 128 + 32 * w4 + l32]; hs1[i] = s0[(size_t)(32 + pr) * 128 + 32 * w4 + l32]; } }
    int soff[5]; int goff[5];
#pragma unroll
    for (int k = 0; k < 5; ++k) { const int pc = tid + 512 * k;
        if (pc < 512) { const int r = pc >> 3, s8 = pc & 7; soff[k] = SS_XN + (r * 72 + 8 * s8) * 2; goff[k] = r * CONVC + h * 64 + 8 * s8; }
        else if (pc < 1536) { const int q = pc - 512, r = q >> 4, s8 = q & 15; soff[k] = SS_BN + (r * 136 + 8 * s8) * 2; goff[k] = r * CONVC + 2048 + g * 128 + 8 * s8; }
        else { const int q = pc - 1536, r = q >> 4, s8 = q & 15; soff[k] = SS_CN + (r * 136 + 8 * s8) * 2; goff[k] = r * CONVC + 3072 + g * 128 + 8 * s8; } }
    v4u stg[5]; float dtn; v2u zn[4];
    const int pt = wave >> 1, it = wave & 1, irow = 32 * it + l32;
#pragma unroll
    for (int k = 0; k < 5; ++k) stg[k] = *(const v4u*)(XBC + (size_t)tok0 * CONVC + goff[k]);
    dtn = DT[(size_t)(tok0 + lane) * 32 + h];
    if (ywave) {
#pragma unroll
        for (int q = 0; q < 4; ++q) zn[q] = *(const v2u*)(Y + (size_t)(tok0 + irow) * DINNER + h * 64 + 32 * pt + 8 * q + 4 * hf); }
#pragma unroll
    for (int k = 0; k < 5; ++k) *(LAS v4u*)(lds + soff[k]) = stg[k];
    if (!ywave) { LAS bf16* Hs = (LAS bf16*)(lds + SS_HS);
#pragma unroll
        for (int i = 0; i < 16; ++i) { const int pr = 8 * (i >> 2) + 4 * hf + (i & 3);
            Hs[pr * 136 + 32 * w4 + l32] = (bf16)(cvt_pk_bf16(hs0[i], 0.f) & 0xffffu); Hs[(32 + pr) * 136 + 32 * w4 + l32] = (bf16)(cvt_pk_bf16(hs1[i], 0.f) & 0xffffu); } }
    __syncthreads();
    for (int c = 0; c < nch; ++c) {
        const int tokc = tok0 + 64 * c, buf = c & 1;
        LAS unsigned char* tb = lds + buf * SS_TILE;
        const LAS bf16* Xn = (const LAS bf16*)(tb + SS_XN); const LAS bf16* Bn = (const LAS bf16*)(tb + SS_BN); const LAS bf16* Cn = (const LAS bf16*)(tb + SS_CN);
        const LAS bf16* Hs = (const LAS bf16*)(lds + SS_HS + buf * SS_HSZ);
        const float dtc = dtn; float av = dtc * a_h;
#pragma unroll
        for (int o = 1; o < 64; o <<= 1) { const float t = __shfl_up(av, o); if (lane >= o) av += t; }
        acs[lane] = av; dtv[lane] = dtc;
        const v2u zc0 = zn[0], zc1 = zn[1], zc2 = zn[2], zc3 = zn[3];
        const bool more = (c + 1 < nch);
        if (more) {
#pragma unroll
            for (int k = 0; k < 5; ++k) stg[k] = *(const v4u*)(XBC + (size_t)(tokc + 64) * CONVC + goff[k]);
            dtn = DT[(size_t)(tokc + 64 + lane) * 32 + h];
            if (ywave) {
#pragma unroll
                for (int q = 0; q < 4; ++q) zn[q] = *(const v2u*)(Y + (size_t)(tokc + 64 + irow) * DINNER + h * 64 + 32 * pt + 8 * q + 4 * hf); }
        }
        if (ywave) {
            const int prow = 32 * pt + l32;
            f32x16 yo;
#pragma unroll
            for (int i = 0; i < 16; ++i) yo[i] = 0.f;
#pragma unroll
            for (int ks = 0; ks < 8; ++ks) { const bf16x8 av8 = *(const LAS bf16x8*)(Hs + prow * 136 + 16 * ks + 8 * hf), bv8 = *(const LAS bf16x8*)(Cn + irow * 136 + 16 * ks + 8 * hf); yo = MFMA32(av8, bv8, yo); }
            const float ai = acs[irow]; const float ei = __expf(ai);
#pragma unroll
            for (int i = 0; i < 16; ++i) yo[i] *= ei;
            for (int jt = 0; jt <= it; ++jt) {
                f32x16 s;
#pragma unroll
                for (int i = 0; i < 16; ++i) s[i] = 0.f;
#pragma unroll
                for (int ks = 0; ks < 8; ++ks) { const bf16x8 av8 = *(const LAS bf16x8*)(Bn + (32 * jt + l32) * 136 + 16 * ks + 8 * hf), bv8 = *(const LAS bf16x8*)(Cn + irow * 136 + 16 * ks + 8 * hf); s = MFMA32(av8, bv8, s); }
                float mv[16];
#pragma unroll
                for (int i = 0; i < 16; ++i) { const int j = 32 * jt + 8 * (i >> 2) + 4 * hf + (i & 3); mv[i] = (j <= irow) ? s[i] * __expf(ai - acs[j]) * dtv[j] : 0.f; }
#pragma unroll
                for (int jj = 0; jj < 2; ++jj) {
                    const v4u pk = pack8(mv + 8 * jj); bf16x8 bv8; __builtin_memcpy(&bv8, &pk, 16);
                    const int ja = 32 * jt + 16 * jj + 4 * hf;
                    const bf16x8 av8 = tr_frag(Xn, 72, ja, ja + 8, 32 * pt + l32, lane);
                    yo = MFMA32(av8, bv8, yo);
                }
            }
            float sq = 0.f; bf16* zp = Y + (size_t)(tokc + irow) * DINNER + h * 64 + 32 * pt + 4 * hf;
#pragma unroll
            for (int q = 0; q < 4; ++q) { const int p4 = 32 * pt + 8 * q + 4 * hf;
                const v2u xr = *(const LAS v2u*)(Xn + irow * 72 + p4); const v2u zr = (q == 0) ? zc0 : (q == 1) ? zc1 : (q == 2) ? zc2 : zc3;
                const float x0 = bf2f(xr.x & 0xffffu), x1 = __uint_as_float(xr.x & 0xffff0000u), x2 = bf2f(xr.y & 0xffffu), x3 = __uint_as_float(xr.y & 0xffff0000u);
                const float z0 = bf2f(zr.x & 0xffffu), z1 = __uint_as_float(zr.x & 0xffff0000u), z2 = bf2f(zr.y & 0xffffu), z3 = __uint_as_float(zr.y & 0xffff0000u);
                const float y0 = (yo[4 * q] + d_h * x0) * z0, y1 = (yo[4 * q + 1] + d_h * x1) * z1, y2 = (yo[4 * q + 2] + d_h * x2) * z2, y3 = (yo[4 * q + 3] + d_h * x3) * z3;
                sq += (y0 * y0 + y1 * y1) + (y2 * y2 + y3 * y3);
                v2u o; o.x = cvt_pk_bf16(y0, y1); o.y = cvt_pk_bf16(y2, y3); *(v2u*)(zp + 8 * q) = o; }
            ((LAS float*)(lds + SS_SQ))[buf * 256 + (pt * 2 + hf) * 64 + irow] = sq;
        } else {
            const float a63 = acs[63]; const float dec = __expf(a63);
#pragma unroll
            for (int i = 0; i < 16; ++i) { hs0[i] *= dec; hs1[i] *= dec; }
#pragma unroll
            for (int ks = 0; ks < 4; ++ks) {
                const int j0 = 16 * ks + 8 * hf;
                const bf16x8 bv8 = tr_frag(Bn, 136, j0, j0 + 4, 32 * w4 + l32, lane);
                float wj[8];
#pragma unroll
                for (int e = 0; e < 8; ++e) wj[e] = __expf(a63 - acs[j0 + e]) * dtv[j0 + e];
#pragma unroll
                for (int ptt = 0; ptt < 2; ++ptt) {
                    const bf16x8 xr = tr_frag(Xn, 72, j0, j0 + 4, 32 * ptt + l32, lane);
                    v4u xu; __builtin_memcpy(&xu, &xr, 16); float xf[8]; unpack8(xu, xf);
#pragma unroll
                    for (int e = 0; e < 8; ++e) xf[e] *= wj[e];
                    const v4u xp = pack8(xf); bf16x8 av8; __builtin_memcpy(&av8, &xp, 16);
                    if (ptt == 0) hs0 = MFMA32(av8, bv8, hs0); else hs1 = MFMA32(av8, bv8, hs1);
                }
            }
            if (more) { LAS bf16* Hn = (LAS bf16*)(lds + SS_HS + (buf ^ 1) * SS_HSZ);
#pragma unroll
                for (int i = 0; i < 16; ++i) { const int pr = 8 * (i >> 2) + 4 * hf + (i & 3);
                    Hn[pr * 136 + 32 * w4 + l32] = (bf16)(cvt_pk_bf16(hs0[i], 0.f) & 0xffffu); Hn[(32 + pr) * 136 + 32 * w4 + l32] = (bf16)(cvt_pk_bf16(hs1[i], 0.f) & 0xffffu); } }
        }
        if (more) {
#pragma unroll
            for (int k = 0; k < 5; ++k) *(LAS v4u*)(lds + (buf ^ 1) * SS_TILE + soff[k]) = stg[k]; }
        __syncthreads();
        if (tid < 64) { const LAS float* sq = (const LAS float*)(lds + SS_SQ) + buf * 256; SSQ[(size_t)(tokc + tid) * 32 + h] = (sq[tid] + sq[64 + tid]) + (sq[128 + tid] + sq[192 + tid]); }
    }
    if (!ywave) {
#pragma unroll
        for (int i = 0; i < 16; ++i) { const int pr = 8 * (i >> 2) + 4 * hf + (i & 3); sout[(size_t)pr * 128 + 32 * w4 + l32] = hs0[i]; sout[(size_t)(32 + pr) * 128 + 32 * w4 + l32] = hs1[i]; } }
    __syncthreads();
}

constexpr int SCW = 2116;
__device__ __forceinline__ unsigned sortable(float x) { x += 0.0f; const unsigned b = __float_as_uint(x); return (b & 0x80000000u) ? ~b : (b | 0x80000000u); }
__device__ __forceinline__ void topk_unit(LAS unsigned char* lds, int tid, int lane, int wave, bool isS, int b, int qb,
                                          const bf16* QI, const bf16* KIP, const bf16* KIS, const float* WI, unsigned* MASK) {
    const int tok0 = isS ? TP + b * DSEQ + qb * 16 : b * SEQ + qb * 16;
    const int pos0 = (isS ? PAST : 0) + qb * 16, limit = ((pos0 >> 6) + 1) << 6, nslots = limit >> 6, ntile = limit >> 4;
    const bf16* KI = isS ? KIS + (size_t)b * NKS * 64 : KIP + (size_t)b * NKP * 64;
    LAS float* sc = (LAS float*)lds;
    const int l16 = lane & 15, kg = lane >> 4;
    if (limit > 256) {
        bf16x8 qf[8][2]; float wq[8];
#pragma unroll
        for (int hd = 0; hd < 8; ++hd) {
#pragma unroll
            for (int ks = 0; ks < 2; ++ks) qf[hd][ks] = *(const bf16x8*)(QI + (size_t)(tok0 + l16) * 512 + hd * 64 + 32 * ks + 8 * kg);
            wq[hd] = WI[(size_t)(tok0 + l16) * 8 + hd]; }
        for (int kt = wave; kt < ntile; kt += 8) {
            const bf16x8 a0 = *(const bf16x8*)(KI + (size_t)(16 * kt + l16) * 64 + 8 * kg), a1 = *(const bf16x8*)(KI + (size_t)(16 * kt + l16) * 64 + 32 + 8 * kg);
            f32x4 s = (f32x4){0.f, 0.f, 0.f, 0.f};
#pragma unroll
            for (int hd = 0; hd < 8; ++hd) { f32x4 c = (f32x4){0.f, 0.f, 0.f, 0.f};
                c = __builtin_amdgcn_mfma_f32_16x16x32_bf16(a0, qf[hd][0], c, 0, 0, 0); c = __builtin_amdgcn_mfma_f32_16x16x32_bf16(a1, qf[hd][1], c, 0, 0, 0);
#pragma unroll
                for (int i = 0; i < 4; ++i) s[i] += wq[hd] * fmaxf(c[i], 0.f); }
            *(LAS f32x4*)(sc + l16 * SCW + 16 * kt + 4 * kg) = s;
        }
    }
    __syncthreads();
    for (int qq = 0; qq < 2; ++qq) {
        const int q = 2 * wave + qq; unsigned* mrow = MASK + (size_t)(tok0 + q) * MASKW;
        if (limit <= 256) {
            if (lane < 33) { const unsigned v = (lane < nslots) ? 0xffffffffu : 0u; mrow[2 * lane] = v; mrow[2 * lane + 1] = v; }
            continue;
        }
        unsigned u[33];
#pragma unroll
        for (int j = 0; j < 33; ++j) u[j] = (j < nslots) ? sortable(sc[q * SCW + 64 * j + lane]) : 0u;
        const int ng = (nslots + 10) / 11;
#define CNT_GE(dst, val) do { int _c = 0; \
            _Pragma("unroll") for (int j = 0; j < 11; ++j) _c += __popcll(__ballot(u[j] >= (val))); \
            if (ng > 1) { _Pragma("unroll") for (int j = 11; j < 22; ++j) _c += __popcll(__ballot(u[j] >= (val))); } \
            if (ng > 2) { _Pragma("unroll") for (int j = 22; j < 33; ++j) _c += __popcll(__ballot(u[j] >= (val))); } \
            dst = _c; } while (0)
        unsigned thr = 0u; bool exact = false;
        for (int bit = 31; bit >= 0; --bit) { const unsigned cand = thr | (1u << bit); int cnt; CNT_GE(cnt, cand);
            if (cnt >= 256) thr = cand;
            if (cnt == 256) { exact = true; break; } }
        int rem = 0;
        if (!exact) { int cgt; CNT_GE(cgt, thr + 1u); rem = 256 - cgt; }
#pragma unroll
        for (int j = 0; j < 33; ++j) {
            unsigned long long wv;
            if (exact) wv = __ballot(u[j] >= thr);
            else { const unsigned long long gt = __ballot(u[j] > thr); unsigned long long eq = __ballot(u[j] == thr), sel = 0ull;
                const int pe = __popcll(eq);
                if (pe <= rem) { sel = eq; rem -= pe; }
                else { while (rem > 0) { const unsigned long long low = eq & (0ull - eq); sel |= low; eq ^= low; --rem; } }
                wv = gt | sel; }
            if (lane == 0) { mrow[2 * j] = (unsigned)wv; mrow[2 * j + 1] = (unsigned)(wv >> 32); }
        }
#undef CNT_GE
    }
    __syncthreads();
}

constexpr int AT_K = 0, AT_V = 18432, AT_M = 59392, AT_VP = 160, AT_VSZ = 64 * AT_VP;
__device__ __forceinline__ void attn_unit(LAS unsigned char* lds, int tid, int lane, int wave, bool isS, int b, int c, int kvh,
                                          bf16* Q, const bf16* KP, const bf16* KSn, const bf16* VP, const bf16* VSn, const float* CK, const float* CV, const unsigned* MASK) {
    const int tok0 = isS ? TP + b * DSEQ : b * SEQ + 64 * c;
    const int limit = isS ? NKS : 64 * (c + 1), nt = limit >> 6;
    const bf16* Kb = isS ? KSn + (size_t)(b * 4 + kvh) * DSEQ * 64 : KP + (size_t)(b * 4 + kvh) * NKP * 64;
    const bf16* Vb = isS ? VSn + (size_t)(b * 4 + kvh) * DSEQ * 64 : VP + (size_t)(b * 4 + kvh) * NKP * 64;
    const float* Kc = CK + ((size_t)b * PAST * 4 + kvh) * 64; const float* Vc32 = CV + ((size_t)b * PAST * 4 + kvh) * 64;
    LAS bf16* Kt = (LAS bf16*)(lds + AT_K); LAS bf16* Vt = (LAS bf16*)(lds + AT_V); LAS unsigned* MK = (LAS unsigned*)(lds + AT_M);
    const int l32 = lane & 31, hf = lane >> 5, r = 32 * wave + l32, tl = r >> 2, gq = r & 3;
    bf16* qp = Q + (size_t)(tok0 + tl) * DM + (kvh * 4 + gq) * 64;
    bf16x8 qf[4];
#pragma unroll
    for (int ks = 0; ks < 4; ++ks) qf[ks] = *(const bf16x8*)(qp + hf * 32 + 8 * ks);
    const int srow = tid >> 3, sseg = tid & 7;
    v4u kr0, kr1, vr0, vr1;
#define AT_LOAD(kt_) do { if (isS && (kt_) < 32) { const float* kp_ = Kc + (size_t)(64 * (kt_) + srow) * 256 + 8 * sseg; const float* vp_ = Vc32 + (size_t)(64 * (kt_) + srow) * 256 + 8 * sseg; \
            kr0 = *(const v4u*)kp_; kr1 = *(const v4u*)(kp_ + 4); vr0 = *(const v4u*)vp_; vr1 = *(const v4u*)(vp_ + 4); } \
        else { const int kk_ = isS ? srow : 64 * (kt_) + srow; kr0 = *(const v4u*)(Kb + (size_t)kk_ * 64 + 8 * sseg); vr0 = *(const v4u*)(Vb + (size_t)kk_ * 64 + 8 * sseg); } } while (0)
#define AT_STORE(kt_, buf_) do { v4u ko_ = kr0, vo_ = vr0; \
        if (isS && (kt_) < 32) { ko_.x = cvt_pk_bf16(__uint_as_float(kr0.x), __uint_as_float(kr0.y)); ko_.y = cvt_pk_bf16(__uint_as_float(kr0.z), __uint_as_float(kr0.w)); ko_.z = cvt_pk_bf16(__uint_as_float(kr1.x), __uint_as_float(kr1.y)); ko_.w = cvt_pk_bf16(__uint_as_float(kr1.z), __uint_as_float(kr1.w)); \
            vo_.x = cvt_pk_bf16(__uint_as_float(vr0.x), __uint_as_float(vr0.y)); vo_.y = cvt_pk_bf16(__uint_as_float(vr0.z), __uint_as_float(vr0.w)); vo_.z = cvt_pk_bf16(__uint_as_float(vr1.x), __uint_as_float(vr1.y)); vo_.w = cvt_pk_bf16(__uint_as_float(vr1.z), __uint_as_float(vr1.w)); } \
        *(LAS v4u*)(Kt + (buf_) * 4608 + srow * 72 + 8 * sseg) = ko_; *(LAS v4u*)(Vt + (buf_) * AT_VSZ + srow * AT_VP + 8 * sseg) = vo_; } while (0)
    AT_LOAD(0);
    for (int i = tid; i < 64 * MASKW; i += 512) MK[i] = MASK[(size_t)tok0 * MASKW + i];
    AT_STORE(0, 0);
    __syncthreads();
    f32x16 o0, o1;
#pragma unroll
    for (int i = 0; i < 16; ++i) { o0[i] = 0.f; o1[i] = 0.f; }
    float lpart = 0.f;
    for (int kt = 0; kt < nt; ++kt) {
        const int buf = kt & 1;
        if (kt + 1 < nt) AT_LOAD(kt + 1);
        const LAS bf16* Kc2 = Kt + buf * 4608; const LAS bf16* Vc = Vt + buf * AT_VSZ;
        f32x16 s0, s1;
#pragma unroll
        for (int i = 0; i < 16; ++i) { s0[i] = 0.f; s1[i] = 0.f; }
#pragma unroll
        for (int ks = 0; ks < 4; ++ks) { const bf16x8 a0 = *(const LAS bf16x8*)(Kc2 + l32 * 72 + hf * 32 + 8 * ks), a1 = *(const LAS bf16x8*)(Kc2 + (32 + l32) * 72 + hf * 32 + 8 * ks);
            s0 = MFMA32(a0, qf[ks], s0); s1 = MFMA32(a1, qf[ks], s1); }
        const unsigned w0 = MK[tl * MASKW + 2 * kt] >> (4 * hf), w1 = MK[tl * MASKW + 2 * kt + 1] >> (4 * hf);
        float p0[16], p1[16], ls = 0.f;
#pragma unroll
        for (int i = 0; i < 16; ++i) { const int bp = 8 * (i >> 2) + (i & 3);
            p0[i] = ((w0 >> bp) & 1u) ? __builtin_amdgcn_exp2f(s0[i]) : 0.f; p1[i] = ((w1 >> bp) & 1u) ? __builtin_amdgcn_exp2f(s1[i]) : 0.f; ls += p0[i] + p1[i]; }
        lpart += ls;
#pragma unroll
        for (int sub = 0; sub < 2; ++sub)
#pragma unroll
            for (int jj = 0; jj < 2; ++jj) {
                const v4u pk = pack8((sub ? p1 : p0) + 8 * jj); bf16x8 bv; __builtin_memcpy(&bv, &pk, 16);
                const int ja = 32 * sub + 16 * jj + 4 * hf;
                const bf16x8 av0 = tr_frag(Vc, AT_VP, ja, ja + 8, l32, lane), av1 = tr_frag(Vc, AT_VP, ja, ja + 8, 32 + l32, lane);
                o0 = MFMA32(av0, bv, o0); o1 = MFMA32(av1, bv, o1);
            }
        if (kt + 1 < nt) AT_STORE(kt + 1, buf ^ 1);
        __syncthreads();
    }
#undef AT_LOAD
#undef AT_STORE
    const float lt = lpart + __shfl_xor(lpart, 32), inv = 1.f / lt;
#pragma unroll
    for (int q = 0; q < 4; ++q) {
        v2u a; a.x = cvt_pk_bf16(o0[4 * q] * inv, o0[4 * q + 1] * inv); a.y = cvt_pk_bf16(o0[4 * q + 2] * inv, o0[4 * q + 3] * inv); *(v2u*)(qp + 8 * q + 4 * hf) = a;
        v2u c2; c2.x = cvt_pk_bf16(o1[4 * q] * inv, o1[4 * q + 1] * inv); c2.y = cvt_pk_bf16(o1[4 * q + 2] * inv, o1[4 * q + 3] * inv); *(v2u*)(qp + 32 + 8 * q + 4 * hf) = c2;
    }
    __syncthreads();
}
constexpr int NPHASES = 12;

#ifdef NOSSD
#define SSDCALL(...) (void)0
#else
#define SSDCALL ssd_unit
#endif
#ifdef NOATT
#define ATTCALL(...) (void)0
#else
#define ATTCALL attn_unit
#endif
#define XB_TMO      128
#define XB_XCNT(j)  (256  + 64 * (j))
#define XB_XSUB(j)  (1280 + 64 * (j))
#define XB_XGEN(j)  (2304 + 64 * (j))
#define XB_TOP      3328
#define XB_TOPGEN   3392
#define XCD_BAR_WORDS 3456
#define XB_SPIN_CAP (1u << 18)

__device__ __forceinline__ unsigned xb_ld(unsigned* p)              { return __hip_atomic_load(p, __ATOMIC_RELAXED, __HIP_MEMORY_SCOPE_AGENT); }
__device__ __forceinline__ unsigned xb_add(unsigned* p, unsigned v) { return __hip_atomic_fetch_add(p, v, __ATOMIC_RELAXED, __HIP_MEMORY_SCOPE_AGENT); }
__device__ __forceinline__ unsigned xb_xcc_id() { return (unsigned)__builtin_amdgcn_s_getreg((3 << 11) | 20) & 0xFu; }
#define XB_SPIN(cond, bar) do { unsigned _sp = 0; while (cond) { __builtin_amdgcn_s_sleep(1); \
    if ((++_sp & 255u) == 0u) { if (xb_ld(&(bar)[XB_TMO])) break; if (_sp > XB_SPIN_CAP) { atomicAdd(&(bar)[XB_TMO], 1u); break; } } } } while (0)

struct XcdBarrier {
    unsigned* bar; unsigned x;
    volatile LAS unsigned* st;
};

__device__ __forceinline__ XcdBarrier xcd_barrier_post(unsigned* bar, volatile LAS unsigned* st) {
    XcdBarrier b; b.bar = bar; b.x = xb_xcc_id(); b.st = st;
    if (threadIdx.x == 0) (void)xb_add(&bar[XB_XCNT(b.x)], 1u);
    return b;
}
__device__ __forceinline__ void xcd_barrier_complete(unsigned* bar, unsigned x, unsigned& nloc, unsigned& nx) {
    const unsigned G = gridDim.x * gridDim.y * gridDim.z;
    unsigned sum, cnt, mine, sp = 0u;
    for (;;) {
        sum = 0u; cnt = 0u; mine = 0u;
#pragma unroll
        for (unsigned j = 0; j < 16; ++j) { const unsigned c = xb_ld(&bar[XB_XCNT(j)]); sum += c; cnt += (c > 0u) ? 1u : 0u; mine = (j == x) ? c : mine; }
        if (sum == G) break;
        __builtin_amdgcn_s_sleep(1);
        if ((++sp & 255u) == 0u) { if (xb_ld(&bar[XB_TMO])) break; if (sp > XB_SPIN_CAP) { atomicAdd(&bar[XB_TMO], 1u); break; } }
    }
    nloc = mine > 0u ? mine : 1u; nx = cnt > 0u ? cnt : 1u;
}

__device__ __forceinline__ void xcd_barrier(const XcdBarrier& b) {
    asm volatile("s_waitcnt vmcnt(0)" ::: "memory");
    __syncthreads();
    if (threadIdx.x == 0) {
        unsigned* bar = b.bar;
        __builtin_amdgcn_s_waitcnt(0);
        unsigned nloc = b.st[0], nx = b.st[1];
        if (nloc == 0u) { xcd_barrier_complete(bar, b.x, nloc, nx); b.st[0] = nloc; b.st[1] = nx; }
        const unsigned old = xb_add(&bar[XB_XSUB(b.x)], 1u);
        const unsigned gen = old / nloc;
        if (old + 1u == (gen + 1u) * nloc) {
            __builtin_amdgcn_fence(__ATOMIC_RELEASE, "agent");
            asm volatile("s_waitcnt vmcnt(0)" ::: "memory");
            const unsigned og = xb_add(&bar[XB_TOP], 1u);
            const unsigned tg = og / nx;
            if (og + 1u == (tg + 1u) * nx) xb_add(&bar[XB_TOPGEN], 1u);
            else XB_SPIN(xb_ld(&bar[XB_TOPGEN]) == tg, bar);
            __builtin_amdgcn_fence(__ATOMIC_ACQUIRE, "agent");
            xb_add(&bar[XB_XGEN(b.x)], 1u);
            asm volatile("s_waitcnt vmcnt(0)" ::: "memory");
        } else {
            XB_SPIN(xb_ld(&bar[XB_XGEN(b.x)]) == gen, bar);
            __builtin_amdgcn_fence(__ATOMIC_ACQUIRE, "agent");
            asm volatile("s_waitcnt vmcnt(0)" ::: "memory");
        }
    }
    __syncthreads();
}

__global__ void __launch_bounds__(512) mega(Params p) {
    extern __shared__ __attribute__((aligned(16))) unsigned char lds_raw[];
    LAS unsigned char* lds = (LAS unsigned char*)lds_raw;
    cg::grid_group grid = cg::this_grid();
    const int tid = threadIdx.x, lane = tid & 63, wave = __builtin_amdgcn_readfirstlane(tid >> 6);
    unsigned char* ws = p.ws;
#define IN(k) (p.ph_hi > (k))
#define SEAM(k) xcd_barrier(xbar)
    volatile LAS unsigned* xst = (volatile LAS unsigned*)(lds + LDS_BYTES - 16);
    if (tid < 4) xst[tid] = 0u;
    __syncthreads();
    if (p.ph_hi < 0) grid.sync();
    XcdBarrier xbar = xcd_barrier_post((unsigned*)(ws + WS_CTL), xst);
    bf16* Hb = (bf16*)(ws + WS_H);
    bf16* QIb = (bf16*)(p.out + O_SSMS); bf16* KIPb = QIb + (size_t)TT * 512; bf16* KISb = KIPb + (size_t)NBP * NKP * 64;
    bf16* Zb = (bf16*)(p.out + O_Y);

    if (IN(0)) phase0(p, lds, tid, lane, wave);
    SEAM(0);
    if (IN(1)) normmod_phase<true>(p, lds, tid, lane, wave, p.in[0], p.in[1], p.in[11], 0, 1024, Hb);
    SEAM(1);
    if (IN(2)) {
        pg8::Gemm g{Hb, (const bf16*)(ws + WS_WIN), TT, NIN, DM}; pg8::StaticOrder S; S.init(TT, NIN, gridDim.x, (int)blockIdx.x);
        EpiIn E{(bf16*)(ws + WS_Q), (bf16*)(ws + WS_KP), (bf16*)(ws + WS_KS), (bf16*)(ws + WS_VTP), (bf16*)(ws + WS_VTS), QIb, KIPb, KISb, Zb, (bf16*)(ws + WS_XBC),
                (float*)(ws + WS_WI), (float*)(ws + WS_DT), p.out, p.in[14], p.in[15], p.in[18], (const float*)(ws + WS_ROPE)};
        pg8::gemm_phase<EpiIn, pg8::StaticOrder, true, true>(lds, g, S, E);
    }
    SEAM(2);
    bf16* Qb = (bf16*)(ws + WS_Q); unsigned* MASKb = (unsigned*)(ws + WS_MASK); float* SSQb = (float*)(ws + WS_SSQ);
    bf16* GATESb = (bf16*)(ws + WS_GATES); bf16* P1b = (bf16*)(ws + WS_P1); bf16* MXb = (bf16*)(ws + WS_MIXED); bf16* ACTb = (bf16*)(ws + WS_ACT);
    const float* MODb = (const float*)(ws + WS_MOD);
    const int G = gridDim.x, bx = blockIdx.x;
    const int bxr = ((G & 7) == 0) ? ((G >> 3) - 1 - (bx >> 3)) * 8 + (bx & 7) : G - 1 - bx;
    if (IN(3)) {
        conv_phase(p, tid, (bf16*)(ws + WS_XBC));
        __syncthreads();
        for (int rd = 0; rd * G < 1152; ++rd) { const int u = rd * G + ((rd & 1) ? bxr : bx); if (u >= 1152) continue;
            bool us; int ub, uq;
            if (u < 128) { us = true; ub = u >> 2; uq = u & 3; } else { const int v = u - 128; us = false; ub = v & 7; uq = 127 - (v >> 3); }
            topk_unit(lds, tid, lane, wave, us, ub, uq, QIb, KIPb, KISb, (const float*)(ws + WS_WI), MASKb); }
    }
    SEAM(3);
    if (IN(4)) {
        for (int rd = 0; rd * G < 2432; ++rd) { const int u = rd * G + ((rd & 1) ? bxr : bx); if (u >= 2432) continue;
            int kind, ub, uc, uh; bool us;
            if (u < 256) { kind = 0; us = false; const int gi = ((u >> 5) << 3) + (u & 7); ub = gi >> 3; uh = ((gi & 7) << 2) + ((u >> 3) & 3); uc = 0; }
            else if (u < 384) { const int v = u - 256; kind = 1; us = true; ub = v >> 2; uh = v & 3; uc = 0; }
            else if (u < 1408) { const int v = u - 384, w = v & 31; kind = 1; us = false; ub = w >> 2; uh = w & 3; uc = 31 - (v >> 5); }
            else { const int v = u - 1408; kind = 0; us = true; const int gi = ((v >> 5) << 3) + (v & 7); ub = gi >> 3; uh = ((gi & 7) << 2) + ((v >> 3) & 3); uc = 0; }
            if (kind == 0) SSDCALL(p, lds, tid, lane, wave, us, ub, uh, (const bf16*)(ws + WS_XBC), (const float*)(ws + WS_DT), Zb, SSQb);
            else ATTCALL(lds, tid, lane, wave, us, ub, uc, uh, Qb, (const bf16*)(ws + WS_KP), (const bf16*)(ws + WS_KS), (const bf16*)(ws + WS_VTP), (const bf16*)(ws + WS_VTS), p.in[2], p.in[3], MASKb); }
    }
    SEAM(4);
    if (IN(5)) {
        ynorm_phase(p, lane, wave, Zb, SSQb);
        __syncthreads();
        { pg8::Gemm g{Hb, (const bf16*)(ws + WS_WG), TT, 2048, DM}; pg8::StaticOrder S; S.init(TT, 2048, G, bx);
          EpiGates E{GATESb};
          pg8::gemm_phase<EpiGates, pg8::StaticOrder, true, true>(lds, g, S, E); }
        { pg8::Gemm g{Qb, (const bf16*)(ws + WS_WBA), TT, DM, DM}; pg8::StaticOrder S; S.init(TT, DM, G, G - 1 - bx);
          EpiP1 E{GATESb, P1b};
          pg8::gemm_phase<EpiP1, pg8::StaticOrder, true, true>(lds, g, S, E); }
    }
    SEAM(5);
    if (IN(7)) {
        pg8::Gemm g{Zb, (const bf16*)(ws + WS_WBS), TT, DM, DINNER}; pg8::StaticOrder S; S.init(TT, DM, G, bx);
        EpiMixed E{GATESb, P1b, MXb};
        pg8::gemm_phase<EpiMixed, pg8::StaticOrder, true, true>(lds, g, S, E);
    }
    SEAM(7);
    if (IN(8)) {
        pg8::Gemm g{MXb, (const bf16*)(ws + WS_WOUT), TT, DM, DM}; pg8::StaticOrder S; S.init(TT, DM, G, bx);
        EpiRes E{p.in[0], p.in[1], MODb, 2048, p.out};
        pg8::gemm_phase<EpiRes, pg8::StaticOrder, true, true>(lds, g, S, E);
    }
    SEAM(8);
    if (IN(9)) normmod_phase<false>(p, lds, tid, lane, wave, p.out, p.out + (size_t)TP * DM, p.in[12], 3072, 4096, Hb);
    SEAM(9);
    if (IN(10)) {
        pg8::Gemm g{Hb, (const bf16*)(ws + WS_WGU), TT, 2 * DFF, DM}; pg8::StaticOrder S; S.init(TT, 2 * DFF, G, bx);
        EpiAct E{ACTb};
        pg8::gemm_phase<EpiAct, pg8::StaticOrder, true, true>(lds, g, S, E);
    }
    SEAM(10);
    if (IN(11)) {
        pg8::Gemm g{ACTb, (const bf16*)(ws + WS_WDN), TT, DM, DFF}; pg8::StaticOrder S; S.init(TT, DM, G, bx);
        EpiRes E{p.out, p.out + (size_t)TP * DM, MODb, 5120, p.out};
        pg8::gemm_phase<EpiRes, pg8::StaticOrder, true, true>(lds, g, S, E);
    }
#undef IN
#undef SEAM
}

extern "C" void kernel_launch(void* const* d_in, const int* in_sizes, int n_in, void* d_out, int out_size, void* d_ws, size_t ws_size, hipStream_t stream) {
    static int grid = 0;
    if (grid == 0) {
        if (n_in != 27 || ws_size < WS_END) { fprintf(stderr, "kernel_launch: unexpected n_in %d / ws %zu\n", n_in, ws_size); grid = -1; return; }
        int dev = 0, cus = 0, per_cu = 0;
        hipGetDevice(&dev); hipDeviceGetAttribute(&cus, hipDeviceAttributeMultiprocessorCount, dev);
        hipFuncSetAttribute((const void*)mega, hipFuncAttributeMaxDynamicSharedMemorySize, LDS_BYTES);
        hipOccupancyMaxActiveBlocksPerMultiprocessor(&per_cu, (const void*)mega, 512, LDS_BYTES);
        (void)hipGetLastError();
        if (per_cu < 1) per_cu = 1;
        grid = cus;
    }
    if (grid < 0) return;
    Params prm{};
    for (int i = 0; i < 27; ++i) prm.in[i] = (const float*)d_in[i];
    prm.out = (float*)d_out; prm.ws = (unsigned char*)d_ws; prm.ph_lo = 0; prm.ph_hi = NPHASES;
    (void)hipMemsetAsync((char*)d_ws + WS_CTL, 0, 16384, stream);
    void* args[] = {&prm};
    hipError_t e = hipLaunchCooperativeKernel((const void*)mega, dim3(grid), dim3(512), args, LDS_BYTES, stream);
    if (e != hipSuccess) fprintf(stderr, "cooperative launch failed: %s (grid %d)\n", hipGetErrorString(e), grid);
}
```

```cpp
#include <hip/hip_runtime.h>
#include <hip/hip_cooperative_groups.h>
#include <cstdio>
#include <cstdint>
namespace cg = cooperative_groups;

namespace pg8 {
#define PG8_LAS __attribute__((address_space(3)))
typedef unsigned short bf16_t;
typedef short bf16x8 __attribute__((ext_vector_type(8)));
typedef float f32x4 __attribute__((ext_vector_type(4)));
typedef unsigned u32x4 __attribute__((ext_vector_type(4)));
constexpr int BM = 256, BK = 64, HALF = 128, HTB = HALF * BK * 2  , STAGE_BYTES = 8 * HTB, NXCD = 8, WGM = 9;

__host__ __device__ __forceinline__ int lds_byte(int r, int c) { const int st = (r >> 4) * 2 + (c >> 5), rr = r & 15, cc = c & 31, ob = rr * 64 + cc * 2; return st * 1024 + (ob ^ (((ob >> 9) & 1) << 5)); }
__host__ __device__ __forceinline__ void stage_rc(int b, int& R, int& C) { const int st = b / 1024, sb = b % 1024, swz = sb ^ (((sb >> 9) & 1) << 5); R = (st >> 1) * 16 + swz / 64; C = (st & 1) * 32 + (swz % 64) / 2; }
__host__ __device__ __forceinline__ int perm32(int rho) { const int n = rho >> 4, i = rho & 15; return 8 * (i >> 2) + 4 * n + (i & 3); }

struct Unit { int pm, pn; };
struct Gemm { const bf16_t* A; const bf16_t* Bt; int M, N, K; int ld = 0; int ncol = 0; };

struct StaticOrder {
    int nM, nN, nwg, G, c;
    __host__ __device__ void init(int M, int N, int G_, int c_) { nM = M / BM; nN = N / BM; nwg = nM * nN; G = G_; c = c_; }
    __host__ __device__ bool next(int i, Unit& u) const {
        const long L = (long)i * G + c; if (L >= nwg) return false;
        int wgid = (int)L; { const int q = nwg / NXCD, r = nwg % NXCD, xcd = wgid % NXCD, off = wgid / NXCD; wgid = (xcd < r ? xcd * (q + 1) : r * (q + 1) + (xcd - r) * q) + off; }
        const int nig = WGM * nN, gid = wgid / nig, fm = gid * WGM, gsz = (nM - fm) < WGM ? (nM - fm) : WGM;
        u.pm = fm + ((wgid % nig) % gsz); u.pn = (wgid % nig) / gsz; return true;
    }
    __device__ __forceinline__ void a_ready(const Unit&) const {}
    __device__ __forceinline__ void done(const Unit&) const {}
};
typedef float f32x2_t __attribute__((ext_vector_type(2)));
typedef __bf16 bf16x2_t __attribute__((ext_vector_type(2)));
__device__ __forceinline__ unsigned cvt_pk_bf16(float lo, float hi) { const bf16x2_t r = __builtin_convertvector((f32x2_t){lo, hi}, bf16x2_t); unsigned u; __builtin_memcpy(&u, &r, 4); return u; }
template <class Epi, class Sched, bool ALIGN_EPI = false, bool SP2 = false>
__device__ __forceinline__ void gemm_phase(PG8_LAS unsigned char* lds, const Gemm g, const Sched& S, const Epi& E) {
    const int tid = threadIdx.x, wid = __builtin_amdgcn_readfirstlane(tid >> 6), lane = tid & 63, wr = wid >> 2, wc = wid & 3, fr = lane & 15, fq = lane >> 4;
    const int K = g.ld ? g.ld : g.K, nt = g.K / BK;
    const int ncol = g.ncol ? g.ncol : (1 << 30); const size_t ksplit = (size_t)g.K * 2;
    unsigned voffA[2], voffB[2];
#pragma unroll
    for (int i = 0; i < 2; ++i) { int R, C; stage_rc(tid * 16 + i * 8192, R, C); const int Rb = Epi::PERM ? ((R & ~31) + perm32(R & 31)) : R;
        voffA[i] = (unsigned)(R * K + C) * 2u; voffB[i] = (unsigned)(Rb * K + C) * 2u; }
    const size_t kstep = (size_t)(BK * 2);
    const size_t hstep = (size_t)HALF * K * 2;
    const size_t tstep = 2 * hstep;
    const unsigned ldsw = (unsigned)wid * 1024u;
    const int aoff = lds_byte(wr * 64 + fr, fq * 8), boff = lds_byte(wc * 32 + fr, fq * 8);
#define PG8_SA(b, h) (((b) * 2 + (h)) * HTB)
#define PG8_SB(b, h) ((4 + (b) * 2 + (h)) * HTB)
#define PG8_STAGE(bufoff, gbase, voff) do { _Pragma("unroll") for (int _i = 0; _i < 2; ++_i) \
        __builtin_amdgcn_global_load_lds((const unsigned*)((const char*)(gbase) + (voff)[_i]), (PG8_LAS unsigned*)(lds + (bufoff) + ldsw + _i * 8192), 16, 0, 0); } while (0)
#define PG8_LDA(dst, b, h) do { _Pragma("unroll") for (int m = 0; m < 4; ++m) _Pragma("unroll") for (int k = 0; k < 2; ++k) dst[m][k] = *(const PG8_LAS bf16x8*)(lds + PG8_SA(b, h) + aoff + m * 2048 + k * 1024); } while (0)
#define PG8_LDB(dst, b, h) do { _Pragma("unroll") for (int n = 0; n < 2; ++n) _Pragma("unroll") for (int k = 0; k < 2; ++k) dst[n][k] = *(const PG8_LAS bf16x8*)(lds + PG8_SB(b, h) + boff + n * 2048 + k * 1024); } while (0)
#define PG8_MMA(ai, bj, At, Bt) do { __builtin_amdgcn_s_setprio(1); _Pragma("unroll") for (int m = 0; m < 4; ++m) _Pragma("unroll") for (int n = 0; n < 2; ++n) _Pragma("unroll") for (int k = 0; k < 2; ++k) \
        acc[ai][bj][m][n] = __builtin_amdgcn_mfma_f32_16x16x32_bf16(Bt[n][k], At[m][k], acc[ai][bj][m][n], 0, 0, 0); __builtin_amdgcn_s_setprio(0); } while (0)
#define PG8_WAIT_V(n) asm volatile("s_waitcnt vmcnt(" #n ")" ::: "memory")
#define PG8_WAIT_L(n) asm volatile("s_waitcnt lgkmcnt(" #n ")" ::: "memory")
#define PG8_BAR __builtin_amdgcn_s_barrier()
#define PG8_SCHED __builtin_amdgcn_sched_barrier(0)
    Unit cur, nxt; int ui = 0;
    if (!S.next(0, cur)) return;
    f32x4 acc[2][2][4][2];
#pragma unroll
    for (int a = 0; a < 2; ++a)
#pragma unroll
        for (int b = 0; b < 2; ++b)
#pragma unroll
            for (int m = 0; m < 4; ++m)
#pragma unroll
                for (int n = 0; n < 2; ++n) acc[a][b][m][n] = (f32x4){0.f, 0.f, 0.f, 0.f};
    bf16x8 At[4][2], B0[2][2], B1[2][2];
    const char* cA = (const char*)g.A + (size_t)cur.pm * tstep + (size_t)(cur.pn / ncol) * ksplit; const char* cB = (const char*)g.Bt + (size_t)(cur.pn % ncol) * tstep + (size_t)(cur.pn / ncol) * ksplit;
    S.a_ready(cur);
    if constexpr (SP2) {
        PG8_STAGE(PG8_SB(0, 0), cB, voffB); PG8_STAGE(PG8_SB(0, 1), cB + hstep, voffB); PG8_STAGE(PG8_SA(0, 0), cA, voffA); PG8_STAGE(PG8_SA(0, 1), cA + hstep, voffA);
        if (wr == 1) PG8_BAR;
        PG8_WAIT_V(2); PG8_BAR;
        PG8_STAGE(PG8_SB(1, 0), cB + kstep, voffB); PG8_STAGE(PG8_SA(1, 0), cA + kstep, voffA); PG8_STAGE(PG8_SB(1, 1), cB + hstep + kstep, voffB);
        PG8_WAIT_V(6); PG8_BAR;
    } else {
        PG8_STAGE(PG8_SB(0, 0), cB, voffB); PG8_STAGE(PG8_SA(0, 0), cA, voffA); PG8_STAGE(PG8_SB(0, 1), cB + hstep, voffB); PG8_STAGE(PG8_SA(0, 1), cA + hstep, voffA);
        if (wr == 1) PG8_BAR;
        PG8_WAIT_V(4); PG8_BAR;
        PG8_STAGE(PG8_SB(1, 0), cB + kstep, voffB); PG8_STAGE(PG8_SA(1, 0), cA + kstep, voffA); PG8_STAGE(PG8_SB(1, 1), cB + hstep + kstep, voffB);
        PG8_WAIT_V(6); PG8_BAR;
    }
    for (;;) {
        const bool has_next = S.next(ui + 1, nxt);
        const char* nA = has_next ? (const char*)g.A + (size_t)nxt.pm * tstep + (size_t)(nxt.pn / ncol) * ksplit : cA; const char* nB = has_next ? (const char*)g.Bt + (size_t)(nxt.pn % ncol) * tstep + (size_t)(nxt.pn / ncol) * ksplit : cB;
        for (int t = 0; t < nt; t += 2) {
            const bool last = (t == nt - 2);
            const char* a1 = cA + (size_t)(t + 1) * kstep;
            const char* a2 = last ? nA : cA + (size_t)(t + 2) * kstep; const char* b2 = last ? nB : cB + (size_t)(t + 2) * kstep;
            const char* a3 = a2 + kstep; const char* b3 = b2 + kstep;
            if (last && has_next) S.a_ready(nxt);
            if constexpr (SP2) {
            PG8_LDB(B0, 0, 0); PG8_LDB(B1, 0, 1); PG8_SCHED; PG8_LDA(At, 0, 0); PG8_STAGE(PG8_SA(1, 1), a1 + hstep, voffA);
            PG8_WAIT_V(8); PG8_WAIT_L(0); PG8_BAR; PG8_MMA(0, 0, At, B0); PG8_MMA(0, 1, At, B1); PG8_BAR; PG8_SCHED;
            PG8_LDA(At, 0, 1); PG8_STAGE(PG8_SB(0, 0), b2, voffB); PG8_STAGE(PG8_SB(0, 1), b2 + hstep, voffB); PG8_STAGE(PG8_SA(0, 0), a2, voffA);
            PG8_WAIT_V(8); PG8_WAIT_L(0); PG8_BAR; PG8_MMA(1, 0, At, B0); PG8_MMA(1, 1, At, B1); PG8_BAR; PG8_SCHED;
            PG8_LDB(B0, 1, 0); PG8_LDB(B1, 1, 1); PG8_SCHED; PG8_LDA(At, 1, 0); PG8_STAGE(PG8_SA(0, 1), a2 + hstep, voffA);
            PG8_WAIT_V(8); PG8_WAIT_L(0); PG8_BAR; PG8_MMA(0, 0, At, B0); PG8_MMA(0, 1, At, B1); PG8_BAR; PG8_SCHED;
            PG8_LDA(At, 1, 1); PG8_STAGE(PG8_SB(1, 0), b3, voffB); PG8_STAGE(PG8_SB(1, 1), b3 + hstep, voffB); PG8_STAGE(PG8_SA(1, 0), a3, voffA);
            PG8_WAIT_V(8); PG8_WAIT_L(0); PG8_BAR; PG8_MMA(1, 0, At, B0); PG8_MMA(1, 1, At, B1); PG8_BAR; PG8_SCHED;
            } else {
            PG8_LDB(B0, 0, 0); PG8_SCHED; PG8_LDA(At, 0, 0); PG8_STAGE(PG8_SA(1, 1), a1 + hstep, voffA);
            PG8_WAIT_L(8); PG8_BAR; PG8_WAIT_L(0); PG8_MMA(0, 0, At, B0); PG8_BAR; PG8_SCHED;
            PG8_LDB(B1, 0, 1); PG8_STAGE(PG8_SB(0, 0), b2, voffB);
            PG8_BAR; PG8_WAIT_L(0); PG8_MMA(0, 1, At, B1); PG8_BAR;
            PG8_LDA(At, 0, 1); PG8_STAGE(PG8_SA(0, 0), a2, voffA);
            PG8_BAR; PG8_WAIT_L(0); PG8_MMA(1, 0, At, B0); PG8_BAR; PG8_SCHED;
            PG8_STAGE(PG8_SB(0, 1), b2 + hstep, voffB);
            PG8_WAIT_V(6); PG8_BAR; PG8_MMA(1, 1, At, B1); PG8_BAR;
            PG8_LDB(B0, 1, 0); PG8_SCHED; PG8_LDA(At, 1, 0); PG8_STAGE(PG8_SA(0, 1), a2 + hstep, voffA);
            PG8_WAIT_L(8); PG8_BAR; PG8_WAIT_L(0); PG8_MMA(0, 0, At, B0); PG8_BAR; PG8_SCHED;
            PG8_LDB(B1, 1, 1); PG8_STAGE(PG8_SB(1, 0), b3, voffB);
            PG8_BAR; PG8_WAIT_L(0); PG8_MMA(0, 1, At, B1); PG8_BAR;
            PG8_LDA(At, 1, 1); PG8_STAGE(PG8_SA(1, 0), a3, voffA);
            PG8_BAR; PG8_WAIT_L(0); PG8_MMA(1, 0, At, B0); PG8_BAR; PG8_SCHED;
            PG8_STAGE(PG8_SB(1, 1), b3 + hstep, voffB);
            PG8_WAIT_V(6); PG8_BAR; PG8_MMA(1, 1, At, B1); PG8_BAR;
            }
        }
        if constexpr (ALIGN_EPI) { if (wr == 0) PG8_BAR; }
        if constexpr (!Epi::AFTER_DRAIN) { E(acc, cur, wr, wc, fr, fq); S.done(cur); }
        if (!has_next) break;
#pragma unroll
        for (int a = 0; a < 2; ++a)
#pragma unroll
            for (int b = 0; b < 2; ++b)
#pragma unroll
                for (int m = 0; m < 4; ++m)
#pragma unroll
                    for (int n = 0; n < 2; ++n) acc[a][b][m][n] = (f32x4){0.f, 0.f, 0.f, 0.f};
        cur = nxt; cA = nA; cB = nB; ++ui;
        if constexpr (ALIGN_EPI) { if (wr == 1) PG8_BAR; }
    }
    PG8_WAIT_V(0);
    if constexpr (!ALIGN_EPI) { if (wr == 0) PG8_BAR; }
    PG8_BAR;
    if constexpr (Epi::AFTER_DRAIN) { E.fused(acc, cur, wr, wc, fr, fq, lds, wid, lane); S.done(cur); }
#undef PG8_SA
#undef PG8_SB
#undef PG8_STAGE
#undef PG8_LDA
#undef PG8_LDB
#undef PG8_MMA
#undef PG8_WAIT_V
#undef PG8_WAIT_L
#undef PG8_BAR
#undef PG8_SCHED
}
}

constexpr int DM = 1024, NBP = 8, SEQ = 2048, NBS = 32, DSEQ = 64, PAST = 2048;
constexpr int TP = NBP * SEQ, TS = NBS * DSEQ, TT = TP + TS;
constexpr int NKP = 2048, NKS = 2112;
constexpr int DFF = 2816, DINNER = 2048, CONVC = 4096;
constexpr int IN_DIM = 10344;
constexpr int CQ = 0, CK = 1024, CV = 1280, CQI = 1536, CKI = 2048, CWI = 2112, CZ = 2120, CXBC = 4168, CDT = 8264, CGATE = 8296;
constexpr int NIN = 33 * 256;
constexpr float EPS = 1e-6f;
constexpr int MASKW = 68;
constexpr size_t O_Y = 0, O_KP = 18874368, O_VP = 23068672, O_KIP = 27262976, O_CONVP = 28311552, O_SSMP = 28409856,
                 O_KS = 30507008, O_VS = 31031296, O_KIS = 31555584, O_CONVS = 31686656, O_SSMS = 32079872;
constexpr size_t MiB = 1u << 20;
constexpr size_t WS_CTL = 0, WS_MOD = 1 * MiB, WS_ROPE = 2 * MiB, WS_WI = 3 * MiB, WS_DT = 4 * MiB;
constexpr size_t WS_WBA = 8 * MiB, WS_WOUT = 10 * MiB, WS_WBS = 12 * MiB, WS_WGU = 16 * MiB, WS_WDN = 27 * MiB, WS_WG = 33 * MiB, WS_WIN = 37 * MiB;
constexpr size_t WS_MASK = 37 * MiB, WS_SSQ = 43 * MiB;
constexpr size_t WS_H = 54 * MiB, WS_Q = 90 * MiB, WS_KP = 126 * MiB, WS_KS = 134 * MiB, WS_VTP = 167 * MiB, WS_VTS = 175 * MiB, WS_XBC = 208 * MiB;
constexpr size_t WS_PART = WS_XBC;
constexpr size_t WS_GATES = 208 * MiB, WS_P1 = 280 * MiB, WS_MIXED = 316 * MiB, WS_ACT = 208 * MiB, WS_END = 352 * MiB;
constexpr int LDS_BYTES = 147456;

#define LAS __attribute__((address_space(3)))
typedef unsigned short bf16;
typedef unsigned v4u __attribute__((ext_vector_type(4)));
typedef unsigned v2u __attribute__((ext_vector_type(2)));
typedef float f32x4 __attribute__((ext_vector_type(4)));
typedef float f32x16 __attribute__((ext_vector_type(16)));
typedef short bf16x8 __attribute__((ext_vector_type(8)));
typedef short bf16x4 __attribute__((ext_vector_type(4)));
using pg8::cvt_pk_bf16;
#define LDS_WAIT() asm volatile("s_waitcnt lgkmcnt(0)" ::: "memory")
__device__ __forceinline__ float bf2f(unsigned h) { return __uint_as_float(h << 16); }
__device__ __forceinline__ float wave_sum(float v) {
#pragma unroll
    for (int o = 1; o < 64; o <<= 1) v += __shfl_xor(v, o);
    return v;
}
__device__ __forceinline__ float silu_f(float v) { return v * __builtin_amdgcn_rcpf(1.f + __expf(-v)); }
__device__ __forceinline__ float sigmoid_f(float v) { return __builtin_amdgcn_rcpf(1.f + __expf(-v)); }
__device__ __forceinline__ v4u pack8(const float* a) { v4u o; o.x = cvt_pk_bf16(a[0], a[1]); o.y = cvt_pk_bf16(a[2], a[3]); o.z = cvt_pk_bf16(a[4], a[5]); o.w = cvt_pk_bf16(a[6], a[7]); return o; }

struct Params { const float* in[27]; float* out; unsigned char* ws; int ph_lo, ph_hi; };

__device__ __forceinline__ void tr_item(const float* __restrict__ W, int ldw, int srccol, int nvalid, bf16* WT, size_t ldd, int dstrow, int k0, LAS float* scr, int lane) {
    { float t[32]; const int c = lane & 31;
#pragma unroll
      for (int i = 0; i < 32; ++i) t[i] = (c < nvalid) ? W[(size_t)(k0 + 2 * i + (lane >> 5)) * ldw + srccol + c] : 0.f;
#pragma unroll
      for (int i = 0; i < 32; ++i) scr[(2 * i + (lane >> 5)) * 33 + c] = t[i]; }
    LDS_WAIT();
    const int c = lane & 7;
#pragma unroll
    for (int j = 0; j < 4; ++j) { const int n = (lane >> 3) + 8 * j; const LAS float* s = scr + (8 * c) * 33 + n;
        v4u o; o.x = cvt_pk_bf16(s[0 * 33], s[1 * 33]); o.y = cvt_pk_bf16(s[2 * 33], s[3 * 33]); o.z = cvt_pk_bf16(s[4 * 33], s[5 * 33]); o.w = cvt_pk_bf16(s[6 * 33], s[7 * 33]);
        *(v4u*)(WT + (size_t)(dstrow + n) * ldd + k0 + 8 * c) = o; }
    LDS_WAIT();
}

__device__ __forceinline__ void phase0(const Params& p, LAS unsigned char* lds, int tid, int lane, int wave) {
    const int G = gridDim.x, bx = blockIdx.x;
    unsigned char* ws = p.ws;
    {
        LAS float* sc = (LAS float*)lds;
        const float* w_ada = p.in[9];
        float* part = (float*)(ws + WS_PART);
        for (int it = bx; it < 192; it += G) {
            const int ks = it / 24, cb = it % 24;
            __syncthreads();
            for (int i = tid; i < 40 * 128; i += 512) { const int r = i >> 7, k = i & 127; const float c = (r < 8) ? p.in[7][r * DM + ks * 128 + k] : p.in[8][(r - 8) * DM + ks * 128 + k]; sc[i] = silu_f(c); }
            __syncthreads();
            const int col = cb * 256 + (tid & 255), rh = tid >> 8;
            float a[20];
#pragma unroll
            for (int r = 0; r < 20; ++r) a[r] = 0.f;
            const float* wp = w_ada + (size_t)(ks * 128) * 6144 + col;
            for (int k0 = 0; k0 < 128; k0 += 16) {
                float w8[16];
#pragma unroll
                for (int i = 0; i < 16; ++i) w8[i] = wp[(size_t)(k0 + i) * 6144];
#pragma unroll
                for (int r = 0; r < 20; ++r) {
#pragma unroll
                    for (int q4 = 0; q4 < 4; ++q4) { const f32x4 s0 = *(const LAS f32x4*)(sc + (rh * 20 + r) * 128 + k0 + 4 * q4);
                        a[r] += (s0[0] * w8[4 * q4] + s0[1] * w8[4 * q4 + 1]) + (s0[2] * w8[4 * q4 + 2] + s0[3] * w8[4 * q4 + 3]); } }
            }
#pragma unroll
            for (int r = 0; r < 20; ++r) part[((size_t)ks * 40 + rh * 20 + r) * 6144 + col] = a[r];
        }
        __syncthreads();
    }
    {
        LAS float* scr = (LAS float*)(lds + wave * 8704);
        const int gw = bx * 8 + wave, NGW = G * 8;
        constexpr int I_IN = 16 * 264, I_G = 16 * 64, I_BA = 16 * 32, I_OUT = 16 * 32, I_BS = 32 * 32, I_GU = 16 * 176, I_DN = 44 * 32;
        constexpr int NIT = I_IN + I_G + I_BA + I_OUT + I_BS + I_GU + I_DN;
        for (int it = gw; it < NIT; it += NGW) {
            int r = it;
            if (r < I_IN) { const int kb = r / 264, rg = r % 264, pn = rg >> 3, w8 = rg & 7, bj = w8 >> 2, wc = w8 & 3; int src, nv = 32;
                if (pn < 8) src = 256 * pn + 64 * wc + 32 * bj;
                else if (pn == 8) { if (wc == 0) src = CKI + 32 * bj; else if (wc == 1) { if (bj == 0) { src = CWI; nv = 8; } else src = CDT; } else { src = 0; nv = 0; } }
                else if (pn < 17) src = CZ + (rg - 72) * 32; else src = CXBC + (rg - 136) * 32;
                tr_item(p.in[13], IN_DIM, src, nv, (bf16*)(ws + WS_WIN), 1024, rg * 32, kb * 64, scr, lane); continue; } r -= I_IN;
            if (r < I_G) { const int kb = r / 64, rg = r % 64; tr_item(p.in[13], IN_DIM, CGATE + rg * 32, 32, (bf16*)(ws + WS_WG), 1024, rg * 32, kb * 64, scr, lane); continue; } r -= I_G;
            if (r < I_BA) { const int kb = r / 32, rg = r % 32; tr_item(p.in[22], 1024, rg * 32, 32, (bf16*)(ws + WS_WBA), 1024, rg * 32, kb * 64, scr, lane); continue; } r -= I_BA;
            if (r < I_OUT) { const int kb = r / 32, rg = r % 32; tr_item(p.in[24], 1024, rg * 32, 32, (bf16*)(ws + WS_WOUT), 1024, rg * 32, kb * 64, scr, lane); continue; } r -= I_OUT;
            if (r < I_BS) { const int kb = r / 32, rg = r % 32; tr_item(p.in[23], 1024, rg * 32, 32, (bf16*)(ws + WS_WBS), 2048, rg * 32, kb * 64, scr, lane); continue; } r -= I_BS;
            if (r < I_GU) { const int kb = r / 176, rg = r % 176, pt = rg >> 3, w8 = rg & 7, half = w8 >> 2, r4 = w8 & 3;
                tr_item(p.in[25], 2 * DFF, half * DFF + 128 * pt + 32 * r4, 32, (bf16*)(ws + WS_WGU), 1024, rg * 32, kb * 64, scr, lane); continue; } r -= I_GU;
            { const int kb = r / 32, rg = r % 32; tr_item(p.in[26], 1024, rg * 32, 32, (bf16*)(ws + WS_WDN), DFF, rg * 32, kb * 64, scr, lane); }
        }
    }
    {
        const int gt = bx * 512 + tid, NGT = G * 512;
        const float* cki = p.in[4]; bf16* KIS = (bf16*)(p.out + O_SSMS) + (size_t)TT * 512 + (size_t)NBP * NKP * 64;
        for (int i = gt; i < 524288; i += NGT) { const size_t e = (size_t)i * 8; const int d = (int)(e & 63), s = (int)((e >> 6) & 2047), b = (int)(e >> 17);
            const f32x4 x0 = *(const f32x4*)(cki + e), x1 = *(const f32x4*)(cki + e + 4);
            v4u o; o.x = cvt_pk_bf16(x0[0], x0[1]); o.y = cvt_pk_bf16(x0[2], x0[3]); o.z = cvt_pk_bf16(x1[0], x1[1]); o.w = cvt_pk_bf16(x1[2], x1[3]);
            *(v4u*)(KIS + ((size_t)b * NKS + s) * 64 + d) = o; }
        float* rope = (float*)(ws + WS_ROPE);
        for (int i = gt; i < NKS * 32; i += NGT) { const int pos = i >> 5, j = i & 31;
            double invd = 1.0; for (int k = 0; k < j; ++k) invd *= 0.74989420933245582;
            const float inv = (float)invd; const float ang = (float)pos * inv;
            const double x = (double)ang; const double q = __builtin_rint(x * 0.63661977236758134); const double r = x - q * 1.5707963267948966; const double r2 = r * r;
            const double sn = r * (1.0 + r2 * (-1.0 / 6 + r2 * (1.0 / 120 + r2 * (-1.0 / 5040 + r2 * (1.0 / 362880 + r2 * (-1.0 / 39916800))))));
            const double cs = 1.0 + r2 * (-0.5 + r2 * (1.0 / 24 + r2 * (-1.0 / 720 + r2 * (1.0 / 40320 + r2 * (-1.0 / 3628800 + r2 * (1.0 / 479001600))))));
            const int iq = ((int)q) & 3; double so, co;
            if (iq == 0) { so = sn; co = cs; } else if (iq == 1) { so = cs; co = -sn; } else if (iq == 2) { so = -sn; co = -cs; } else { so = -cs; co = sn; }
            rope[i] = (float)co; rope[NKS * 32 + i] = (float)so; }
    }
}

template <bool FROM_PART>
__device__ __forceinline__ void normmod_phase(const Params& p, LAS unsigned char* lds, int tid, int lane, int wave, const float* xp, const float* xs, const float* g, int off_sh, int off_sc, bf16* H) {
    const int bx = blockIdx.x, G = gridDim.x;
    unsigned char* ws = p.ws;
    const float* part = (const float*)(ws + WS_PART); const float* b_ada = p.in[10]; float* MOD = (float*)(ws + WS_MOD);
    LAS float* lsh = (LAS float*)lds; LAS float* lsc = lsh + 1024;
    if (FROM_PART) {
        for (int it = bx; it < 240; it += G) { const int row = it / 6, seg = it % 6;
            for (int c = tid; c < 1024; c += 512) { float v = b_ada[seg * 1024 + c];
#pragma unroll
                for (int ks = 0; ks < 8; ++ks) v += part[((size_t)ks * 40 + row) * 6144 + seg * 1024 + c];
                MOD[row * 6144 + seg * 1024 + c] = v; } }
    }
    const int rows_per = (TT + G - 1) / G;
    const int r_lo = bx * rows_per, r_hi = (r_lo + rows_per < TT) ? r_lo + rows_per : TT;
    int r = r_lo;
    while (r < r_hi) {
        const int mrow = (r < TP) ? (r >> 11) : 8 + ((r - TP) >> 6);
        const int gend = (r < TP) ? ((r >> 11) + 1) << 11 : TP + ((((r - TP) >> 6) + 1) << 6);
        const int e = gend < r_hi ? gend : r_hi;
        __syncthreads();
        for (int c = tid; c < 1024; c += 512) {
            float vsh, vsc;
            if (FROM_PART) { vsh = b_ada[off_sh + c]; vsc = b_ada[off_sc + c];
#pragma unroll
                for (int ks = 0; ks < 8; ++ks) { vsh += part[((size_t)ks * 40 + mrow) * 6144 + off_sh + c]; vsc += part[((size_t)ks * 40 + mrow) * 6144 + off_sc + c]; } }
            else { vsh = MOD[mrow * 6144 + off_sh + c]; vsc = MOD[mrow * 6144 + off_sc + c]; }
            lsh[c] = vsh; lsc[c] = (1.f + vsc) * g[c];
        }
        __syncthreads();
        f32x4 vn[4];
        if (r + wave < e) { const int row0 = r + wave; const float* xr = (row0 < TP) ? xp + (size_t)row0 * DM : xs + (size_t)(row0 - TP) * DM;
#pragma unroll
            for (int j = 0; j < 4; ++j) vn[j] = *(const f32x4*)(xr + 4 * lane + 256 * j); }
        for (int row = r + wave; row < e; row += 8) {
            f32x4 v[4]; float s = 0.f;
#pragma unroll
            for (int j = 0; j < 4; ++j) { v[j] = vn[j]; s += (v[j][0] * v[j][0] + v[j][1] * v[j][1]) + (v[j][2] * v[j][2] + v[j][3] * v[j][3]); }
            if (row + 8 < e) { const int rn = row + 8; const float* xr = (rn < TP) ? xp + (size_t)rn * DM : xs + (size_t)(rn - TP) * DM;
#pragma unroll
                for (int j = 0; j < 4; ++j) vn[j] = *(const f32x4*)(xr + 4 * lane + 256 * j); }
            const float rstd = rsqrtf(wave_sum(s) * (1.f / DM) + EPS);
#pragma unroll
            for (int j = 0; j < 4; ++j) { const int c = 4 * lane + 256 * j; const f32x4 a = *(const LAS f32x4*)(lsc + c), b = *(const LAS f32x4*)(lsh + c);
                v2u o; o.x = cvt_pk_bf16(v[j][0] * rstd * a[0] + b[0], v[j][1] * rstd * a[1] + b[1]); o.y = cvt_pk_bf16(v[j][2] * rstd * a[2] + b[2], v[j][3] * rstd * a[3] + b[3]);
                *(v2u*)(H + (size_t)row * DM + c) = o; }
        }
        r = e;
    }
    __syncthreads();
}

#define EPI_ROWS_BEGIN \
    _Pragma("unroll") for (int ai = 0; ai < 2; ++ai) _Pragma("unroll") for (int m = 0; m < 4; ++m) { \
        const int row = u.pm * 256 + ai * 128 + wr * 64 + m * 16 + fr; float a[8], b[8]; \
        _Pragma("unroll") for (int e = 0; e < 4; ++e) { a[e] = acc[ai][0][m][0][e]; a[4 + e] = acc[ai][0][m][1][e]; b[e] = acc[ai][1][m][0][e]; b[4 + e] = acc[ai][1][m][1][e]; }
#define EPI_ROWS_END }

#define EPI_LOADROW(AI, M) { _Pragma("unroll") for (int e = 0; e < 4; ++e) { a[e] = acc[AI][0][M][0][e]; a[4 + e] = acc[AI][0][M][1][e]; b[e] = acc[AI][1][M][0][e]; b[4 + e] = acc[AI][1][M][1][e]; } }
#define EPI_ROWS_LOOP_BEGIN \
    _Pragma("unroll 1") for (int rr = 0; rr < 8; ++rr) { \
        const int row = u.pm * 256 + (rr >> 2) * 128 + wr * 64 + (rr & 3) * 16 + fr; float a[8], b[8]; \
        switch (rr) { case 0: EPI_LOADROW(0, 0) break; case 1: EPI_LOADROW(0, 1) break; case 2: EPI_LOADROW(0, 2) break; case 3: EPI_LOADROW(0, 3) break; \
                      case 4: EPI_LOADROW(1, 0) break; case 5: EPI_LOADROW(1, 1) break; case 6: EPI_LOADROW(1, 2) break; default: EPI_LOADROW(1, 3) break; }

struct EpiIn {
    static constexpr bool PERM = true, AFTER_DRAIN = false;
    bf16 *Q, *KP, *KS, *VTP, *VTS, *QI, *KIP, *KIS, *Z, *XBC; float *WI, *DT, *out; const float *gq, *gk, *dtb, *rope;
    __device__ __forceinline__ void operator()(const f32x4 (&acc)[2][2][4][2], const pg8::Unit& u, int wr, int wc, int fr, int fq) const {
        const int pn = u.pn;
        if (pn == 8 && wc >= 2) return;
        EPI_ROWS_LOOP_BEGIN
            const bool isS = row >= TP; int sb, t, pos;
            if (!isS) { sb = row >> 11; t = row & 2047; pos = t; } else { const int s = row - TP; sb = s >> 6; t = s & 63; pos = PAST + t; }
            if (pn >= 17) {
                const int col = 256 * (pn - 17) + 32 * wc + 8 * fq;
                *(v4u*)(XBC + (size_t)row * CONVC + col) = pack8(a); *(v4u*)(XBC + (size_t)row * CONVC + col + 128) = pack8(b);
                const int L = isS ? DSEQ : SEQ;
                if (t >= L - 3) { float* o = out + (isS ? O_CONVS : O_CONVP) + (size_t)(sb * 3 + (t - (L - 3))) * CONVC + col;
                    *(f32x4*)(o) = (f32x4){a[0], a[1], a[2], a[3]}; *(f32x4*)(o + 4) = (f32x4){a[4], a[5], a[6], a[7]};
                    *(f32x4*)(o + 128) = (f32x4){b[0], b[1], b[2], b[3]}; *(f32x4*)(o + 132) = (f32x4){b[4], b[5], b[6], b[7]}; }
            } else if (pn >= 9) {
                const int col = 256 * (pn - 9) + 32 * wc + 8 * fq;
#pragma unroll
                for (int e = 0; e < 8; ++e) { a[e] = silu_f(a[e]); b[e] = silu_f(b[e]); }
                *(v4u*)(Z + (size_t)row * DINNER + col) = pack8(a); *(v4u*)(Z + (size_t)row * DINNER + col + 128) = pack8(b);
            } else if (pn == 8 && wc == 1) {
                if (fq == 0) { float* w = WI + (size_t)row * 8; const float sc = 0.35355339059327373f * 0.125f;
                    *(f32x4*)w = (f32x4){a[0] * sc, a[1] * sc, a[2] * sc, a[3] * sc}; *(f32x4*)(w + 4) = (f32x4){a[4] * sc, a[5] * sc, a[6] * sc, a[7] * sc}; }
                float d[8];
#pragma unroll
                for (int e = 0; e < 8; ++e) { const float x = b[e] + dtb[8 * fq + e]; d[e] = x > 20.f ? x : log1pf(__expf(x)); }
                float* o = DT + (size_t)row * 32 + 8 * fq; *(f32x4*)o = (f32x4){d[0], d[1], d[2], d[3]}; *(f32x4*)(o + 4) = (f32x4){d[4], d[5], d[6], d[7]};
            } else if (pn == 5) {
                float* o = out + (isS ? O_VS + ((size_t)(row - TP) * 4 + wc) * 64 : O_VP + ((size_t)row * 4 + wc) * 64) + 8 * fq;
                *(f32x4*)(o) = (f32x4){a[0], a[1], a[2], a[3]}; *(f32x4*)(o + 4) = (f32x4){a[4], a[5], a[6], a[7]};
                *(f32x4*)(o + 32) = (f32x4){b[0], b[1], b[2], b[3]}; *(f32x4*)(o + 36) = (f32x4){b[4], b[5], b[6], b[7]};
                bf16* vb = (isS ? VTS + ((size_t)(sb * 4 + wc) * DSEQ + t) * 64 : VTP + ((size_t)(sb * 4 + wc) * NKP + t) * 64) + 8 * fq;
                *(v4u*)vb = pack8(a); *(v4u*)(vb + 32) = pack8(b);
            } else {
                if (pn <= 4) { float ss = 0.f;
#pragma unroll
                    for (int e = 0; e < 8; ++e) ss += a[e] * a[e] + b[e] * b[e];
                    ss += __shfl_xor(ss, 16); ss += __shfl_xor(ss, 32);
                    const float rstd = rsqrtf(ss * (1.f / 64.f) + EPS); const float* g = (pn < 4) ? gq : gk;
#pragma unroll
                    for (int e = 0; e < 8; ++e) { a[e] *= rstd * g[8 * fq + e]; b[e] *= rstd * g[32 + 8 * fq + e]; } }
                { const float* cp = rope + (size_t)pos * 32 + 8 * fq; const float* sp = cp + NKS * 32;
#pragma unroll
                  for (int e = 0; e < 8; ++e) { const float c = cp[e], s = sp[e], x1 = a[e], x2 = b[e]; a[e] = x1 * c - x2 * s; b[e] = x2 * c + x1 * s; } }
                if (pn < 4) { const float qs = 0.125f * 1.4426950408889634f;
#pragma unroll
                    for (int e = 0; e < 8; ++e) { a[e] *= qs; b[e] *= qs; }
                    bf16* q = Q + (size_t)row * DM + (4 * pn + wc) * 64 + 8 * fq; *(v4u*)q = pack8(a); *(v4u*)(q + 32) = pack8(b); }
                else if (pn == 4) {
                    float* o = out + (isS ? O_KS + ((size_t)(row - TP) * 4 + wc) * 64 : O_KP + ((size_t)row * 4 + wc) * 64) + 8 * fq;
                    *(f32x4*)(o) = (f32x4){a[0], a[1], a[2], a[3]}; *(f32x4*)(o + 4) = (f32x4){a[4], a[5], a[6], a[7]};
                    *(f32x4*)(o + 32) = (f32x4){b[0], b[1], b[2], b[3]}; *(f32x4*)(o + 36) = (f32x4){b[4], b[5], b[6], b[7]};
                    bf16* kb = (isS ? KS + ((size_t)(sb * 4 + wc) * DSEQ + t) * 64 : KP + ((size_t)(sb * 4 + wc) * NKP + t) * 64) + 8 * fq;
                    *(v4u*)kb = pack8(a); *(v4u*)(kb + 32) = pack8(b);
                } else if (pn < 8) { bf16* q = QI + (size_t)row * 512 + (4 * (pn - 6) + wc) * 64 + 8 * fq; *(v4u*)q = pack8(a); *(v4u*)(q + 32) = pack8(b); }
                else {
                    float* o = out + (isS ? O_KIS + (size_t)(row - TP) * 64 : O_KIP + (size_t)row * 64) + 8 * fq;
                    *(f32x4*)(o) = (f32x4){a[0], a[1], a[2], a[3]}; *(f32x4*)(o + 4) = (f32x4){a[4], a[5], a[6], a[7]};
                    *(f32x4*)(o + 32) = (f32x4){b[0], b[1], b[2], b[3]}; *(f32x4*)(o + 36) = (f32x4){b[4], b[5], b[6], b[7]};
                    bf16* kb = (isS ? KIS + ((size_t)sb * NKS + pos) * 64 : KIP + (size_t)row * 64) + 8 * fq;
                    *(v4u*)kb = pack8(a); *(v4u*)(kb + 32) = pack8(b);
                }
            }
        EPI_ROWS_END
    }
};

__device__ __forceinline__ void unpack8(const v4u w, float* f) {
    f[0] = __uint_as_float(w.x << 16); f[1] = __uint_as_float(w.x & 0xffff0000u); f[2] = __uint_as_float(w.y << 16); f[3] = __uint_as_float(w.y & 0xffff0000u);
    f[4] = __uint_as_float(w.z << 16); f[5] = __uint_as_float(w.z & 0xffff0000u); f[6] = __uint_as_float(w.w << 16); f[7] = __uint_as_float(w.w & 0xffff0000u);
}
__device__ __forceinline__ int mod_row(int row) { return (row < TP) ? (row >> 11) : 8 + ((row - TP) >> 6); }

struct EpiGates {
    static constexpr bool PERM = true, AFTER_DRAIN = false; bf16* G;
    __device__ __forceinline__ void operator()(const f32x4 (&acc)[2][2][4][2], const pg8::Unit& u, int wr, int wc, int fr, int fq) const {
        EPI_ROWS_BEGIN
            const int col = 256 * u.pn + 32 * wc + 8 * fq;
#pragma unroll
            for (int e = 0; e < 8; ++e) { a[e] = sigmoid_f(a[e]); b[e] = sigmoid_f(b[e]); }
            *(v4u*)(G + (size_t)row * 2048 + col) = pack8(a); *(v4u*)(G + (size_t)row * 2048 + col + 128) = pack8(b);
        EPI_ROWS_END
    }
};
struct EpiP1 {
    static constexpr bool PERM = true, AFTER_DRAIN = false; const bf16* G; bf16* P1;
    __device__ __forceinline__ void operator()(const f32x4 (&acc)[2][2][4][2], const pg8::Unit& u, int wr, int wc, int fr, int fq) const {
        EPI_ROWS_BEGIN
            const int col = 256 * u.pn + 32 * wc + 8 * fq;
            *(v4u*)(P1 + (size_t)row * DM + col) = pack8(a); *(v4u*)(P1 + (size_t)row * DM + col + 128) = pack8(b);
        EPI_ROWS_END
    }
};
struct EpiMixed {
    static constexpr bool PERM = true, AFTER_DRAIN = false; const bf16* G; const bf16* P1; bf16* MX;
    __device__ __forceinline__ void operator()(const f32x4 (&acc)[2][2][4][2], const pg8::Unit& u, int wr, int wc, int fr, int fq) const {
        EPI_ROWS_BEGIN
            const int col = 256 * u.pn + 32 * wc + 8 * fq; float g0[8], g1[8], p0[8], p1[8], h0[8], h1[8];
            unpack8(*(const v4u*)(G + (size_t)row * 2048 + 1024 + col), g0); unpack8(*(const v4u*)(G + (size_t)row * 2048 + 1024 + col + 128), g1);
            unpack8(*(const v4u*)(G + (size_t)row * 2048 + col), h0); unpack8(*(const v4u*)(G + (size_t)row * 2048 + col + 128), h1);
            unpack8(*(const v4u*)(P1 + (size_t)row * DM + col), p0); unpack8(*(const v4u*)(P1 + (size_t)row * DM + col + 128), p1);
#pragma unroll
            for (int e = 0; e < 8; ++e) { a[e] = p0[e] * h0[e] + a[e] * g0[e]; b[e] = p1[e] * h1[e] + b[e] * g1[e]; }
            *(v4u*)(MX + (size_t)row * DM + col) = pack8(a); *(v4u*)(MX + (size_t)row * DM + col + 128) = pack8(b);
        EPI_ROWS_END
    }
};
struct EpiRes {
    static constexpr bool PERM = true, AFTER_DRAIN = false; const float* xp; const float* xs; const float* MOD; int moff; float* out;
    __device__ __forceinline__ void operator()(const f32x4 (&acc)[2][2][4][2], const pg8::Unit& u, int wr, int wc, int fr, int fq) const {
        EPI_ROWS_BEGIN
            const int col = 256 * u.pn + 32 * wc + 8 * fq;
            const float* xr = ((row < TP) ? xp + (size_t)row * DM : xs + (size_t)(row - TP) * DM) + col;
            const float* mr = MOD + (size_t)mod_row(row) * 6144 + moff + col; float* o = out + (size_t)row * DM + col;
#pragma unroll
            for (int hh = 0; hh < 2; ++hh) { const float* v = hh ? b : a;
#pragma unroll
                for (int q = 0; q < 2; ++q) { const f32x4 x = *(const f32x4*)(xr + 128 * hh + 4 * q), g = *(const f32x4*)(mr + 128 * hh + 4 * q);
                    *(f32x4*)(o + 128 * hh + 4 * q) = (f32x4){x[0] + g[0] * v[4 * q], x[1] + g[1] * v[4 * q + 1], x[2] + g[2] * v[4 * q + 2], x[3] + g[3] * v[4 * q + 3]}; } }
        EPI_ROWS_END
    }
};
struct EpiResAdd {
    static constexpr bool PERM = true, AFTER_DRAIN = false; const float* MOD; int moff; float* out;
    __device__ __forceinline__ void operator()(const f32x4 (&acc)[2][2][4][2], const pg8::Unit& u, int wr, int wc, int fr, int fq) const {
        EPI_ROWS_BEGIN
            const int col = 256 * (u.pn & 3) + 32 * wc + 8 * fq;
            const float* mr = MOD + (size_t)mod_row(row) * 6144 + moff + col; float* o = out + (size_t)row * DM + col;
#pragma unroll
            for (int e = 0; e < 8; ++e) { unsafeAtomicAdd(o + e, mr[e] * a[e]); unsafeAtomicAdd(o + 128 + e, mr[128 + e] * b[e]); }
        EPI_ROWS_END
    }
};
struct EpiAct {
    static constexpr bool PERM = true, AFTER_DRAIN = false; bf16* ACT;
    __device__ __forceinline__ void operator()(const f32x4 (&acc)[2][2][4][2], const pg8::Unit& u, int wr, int wc, int fr, int fq) const {
        EPI_ROWS_BEGIN
            const int col = 128 * u.pn + 32 * wc + 8 * fq;
#pragma unroll
            for (int e = 0; e < 8; ++e) a[e] = silu_f(a[e]) * b[e];
            *(v4u*)(ACT + (size_t)row * DFF + col) = pack8(a);
        EPI_ROWS_END
    }
};

__device__ __forceinline__ void ynorm_phase(const Params& p, int lane, int wave, bf16* Y, const float* SSQ) {
    const float* gn = p.in[21];
    const int gw = blockIdx.x * 8 + wave, NGW = gridDim.x * 8;
    v4u yn[4]; f32x4 sn[4];
    if (gw < TT) {
#pragma unroll
        for (int j = 0; j < 4; ++j) { const int c = 8 * lane + 512 * j; yn[j] = *(const v4u*)(Y + (size_t)gw * DINNER + c); sn[j] = *(const f32x4*)(SSQ + (size_t)gw * 32 + 4 * (c >> 8)); } }
    for (int row = gw; row < TT; row += NGW) {
        v4u yc[4]; f32x4 sc4[4];
#pragma unroll
        for (int j = 0; j < 4; ++j) { yc[j] = yn[j]; sc4[j] = sn[j]; }
        if (row + NGW < TT) { const int rn = row + NGW;
#pragma unroll
            for (int j = 0; j < 4; ++j) { const int c = 8 * lane + 512 * j; yn[j] = *(const v4u*)(Y + (size_t)rn * DINNER + c); sn[j] = *(const f32x4*)(SSQ + (size_t)rn * 32 + 4 * (c >> 8)); } }
#pragma unroll
        for (int j = 0; j < 4; ++j) { const int c = 8 * lane + 512 * j;
            const f32x4 sq = sc4[j];
            const float rstd = rsqrtf(((sq[0] + sq[1]) + (sq[2] + sq[3])) * (1.f / 256.f) + EPS);
            float y[8]; unpack8(yc[j], y);
            const f32x4 g0 = *(const f32x4*)(gn + c), g1 = *(const f32x4*)(gn + c + 4);
            y[0] *= rstd * g0[0]; y[1] *= rstd * g0[1]; y[2] *= rstd * g0[2]; y[3] *= rstd * g0[3]; y[4] *= rstd * g1[0]; y[5] *= rstd * g1[1]; y[6] *= rstd * g1[2]; y[7] *= rstd * g1[3];
            *(v4u*)(Y + (size_t)row * DINNER + c) = pack8(y); }
    }
}

__device__ __forceinline__ void conv_stream(bf16* base, float (&h0)[8], float (&h1)[8], float (&h2)[8], const float* wconv, const float* bconv, int col) {
    float w[4][8], bias[8];
#pragma unroll
    for (int j = 0; j < 4; ++j) { const f32x4 w0 = *(const f32x4*)(wconv + j * CONVC + col), w1 = *(const f32x4*)(wconv + j * CONVC + col + 4);
        w[j][0] = w0[0]; w[j][1] = w0[1]; w[j][2] = w0[2]; w[j][3] = w0[3]; w[j][4] = w1[0]; w[j][5] = w1[1]; w[j][6] = w1[2]; w[j][7] = w1[3]; }
    { const f32x4 b0 = *(const f32x4*)(bconv + col), b1 = *(const f32x4*)(bconv + col + 4);
      bias[0] = b0[0]; bias[1] = b0[1]; bias[2] = b0[2]; bias[3] = b0[3]; bias[4] = b1[0]; bias[5] = b1[1]; bias[6] = b1[2]; bias[7] = b1[3]; }
    for (int r0 = 0; r0 < 64; r0 += 16) {
        v4u raw[16];
#pragma unroll
        for (int k = 0; k < 16; ++k) raw[k] = *(const v4u*)(base + (size_t)(r0 + k) * CONVC);
#pragma unroll
        for (int k = 0; k < 16; ++k) { float x[8], o[8]; unpack8(raw[k], x);
#pragma unroll
            for (int e = 0; e < 8; ++e) { o[e] = silu_f(bias[e] + w[0][e] * h0[e] + w[1][e] * h1[e] + w[2][e] * h2[e] + w[3][e] * x[e]); h0[e] = h1[e]; h1[e] = h2[e]; h2[e] = x[e]; }
            *(v4u*)(base + (size_t)(r0 + k) * CONVC) = pack8(o); }
    }
}
__device__ __forceinline__ void conv_phase(const Params& p, int tid, bf16* XBC) {
    const float* wconv = p.in[16]; const float* bconv = p.in[17];
    const int G = gridDim.x, bx = blockIdx.x;
    for (int it = bx; it < 256; it += G) {
        const int b = it >> 5, cb = it & 31, cg = tid & 15, run = tid >> 4, col = cb * 128 + cg * 8;
        bf16* base = XBC + (size_t)(b * SEQ + run * 64) * CONVC + col;
        float h0[8], h1[8], h2[8];
        if (run > 0) { unpack8(*(const v4u*)(base - 3 * CONVC), h0); unpack8(*(const v4u*)(base - 2 * CONVC), h1); unpack8(*(const v4u*)(base - CONVC), h2); }
        else {
#pragma unroll
            for (int e = 0; e < 8; ++e) { h0[e] = 0.f; h1[e] = 0.f; h2[e] = 0.f; } }
        __syncthreads();
        conv_stream(base, h0, h1, h2, wconv, bconv, col);
        __syncthreads();
    }
    for (int i = bx * 512 + tid; i < NBS * 512; i += G * 512) {
        const int b = i >> 9, col = (i & 511) * 8;
        bf16* base = XBC + (size_t)(TP + b * DSEQ) * CONVC + col;
        const float* sp = p.in[5] + (size_t)b * 3 * CONVC + col;
        float h0[8], h1[8], h2[8];
#pragma unroll
        for (int e = 0; e < 8; ++e) { h0[e] = sp[e]; h1[e] = sp[CONVC + e]; h2[e] = sp[2 * CONVC + e]; }
        conv_stream(base, h0, h1, h2, wconv, bconv, col);
    }
}

#define MFMA32(a, b, c) __builtin_amdgcn_mfma_f32_32x32x16_bf16((a), (b), (c), 0, 0, 0)
typedef short s16x4 __attribute__((ext_vector_type(4)));
#ifndef TR_SLOW
#define TR_SLOW 0
#endif
__device__ __forceinline__ bf16x8 tr_frag(const LAS bf16* tile, int pitch, int ra, int rb, int col, int lane) {
#if TR_SLOW
    bf16x8 r;
#pragma unroll
    for (int e = 0; e < 4; ++e) { r[e] = (short)tile[(ra + e) * pitch + col]; r[4 + e] = (short)tile[(rb + e) * pitch + col]; }
    return r;
#else
    const int tq = (lane & 15) >> 2, tp = lane & 3, cb = (col & ~15) + 4 * tp;
    const s16x4 lo = __builtin_amdgcn_ds_read_tr16_b64_v4i16((LAS s16x4*)(tile + (ra + tq) * pitch + cb)), hi = __builtin_amdgcn_ds_read_tr16_b64_v4i16((LAS s16x4*)(tile + (rb + tq) * pitch + cb));
    return (bf16x8){lo[0], lo[1], lo[2], lo[3], hi[0], hi[1], hi[2], hi[3]};
#endif
}
constexpr int SS_TILE = 44032, SS_XN = 0, SS_BN = 9216, SS_CN = 26624, SS_HS = 88064, SS_HSZ = 17408, SS_ACS = 122880, SS_SQ = 126976;
__device__ __forceinline__ void ssd_unit(const Params& p, LAS unsigned char* lds, int tid, int lane, int wave, bool isS, int b, int h,
                                         const bf16* XBC, const float* DT, bf16* Y, float* SSQ) {
    const int g = h >> 2, nch = isS ? 1 : 32, tok0 = isS ? TP + b * DSEQ : b * SEQ;
    const float a_h = -__expf(p.in[19][h]), d_h = p.in[20][h];
    LAS float* acs = (LAS float*)(lds + SS_ACS + wave * 512); LAS float* dtv = acs + 64;
    const int l32 = lane & 31, hf = lane >> 5, blk = (lane >> 4) & 1, tq = (lane & 15) >> 2, tp = lane & 3;
    const bool ywave = wave < 4; const int w4 = wave & 3;
    f32x16 hs0, hs1;
    float* sout = p.out + (isS ? O_SSMS : O_SSMP) + ((size_t)(b * 32 + h) * 64) * 128;
#pragma unroll
    for (int i = 0; i < 16; ++i) { hs0[i] = 0.f; hs1[i] = 0.f; }
    if (isS && !ywave) { const float* s0 = p.in[6] + ((size_t)(b * 32 + h) * 64) * 128;
#pragma unroll
        for (int i = 0; i < 16; ++i) { const int pr = 8 * (i >> 2) + 4 * hf + (i & 3); hs0[i] = s0[(size_t)pr * 128 + 32 * w4 + l32]; hs1[i] = s0[(size_t)(32 + pr) * 128 + 32 * w4 + l32]; } }
    int soff[5]; int goff[5];
#pragma unroll
    for (int k = 0; k < 5; ++k) { const int pc = tid + 512 * k;
        if (pc < 512) { const int r = pc >> 3, s8 = pc & 7; soff[k] = SS_XN + (r * 72 + 8 * s8) * 2; goff[k] = r * CONVC + h * 64 + 8 * s8; }
        else if (pc < 1536) { const int q = pc - 512, r = q >> 4, s8 = q & 15; soff[k] = SS_BN + (r * 136 + 8 * s8) * 2; goff[k] = r * CONVC + 2048 + g * 128 + 8 * s8; }
        else { const int q = pc - 1536, r = q >> 4, s8 = q & 15; soff[k] = SS_CN + (r * 136 + 8 * s8) * 2; goff[k] = r * CONVC + 3072 + g * 128 + 8 * s8; } }
    v4u stg[5]; float dtn; v2u zn[4];
    const int pt = wave >> 1, it = wave & 1, irow = 32 * it + l32;
#pragma unroll
    for (int k = 0; k < 5; ++k) stg[k] = *(const v4u*)(XBC + (size_t)tok0 * CONVC + goff[k]);
    dtn = DT[(size_t)(tok0 + lane) * 32 + h];
    if (ywave) {
#pragma unroll
        for (int q = 0; q < 4; ++q) zn[q] = *(const v2u*)(Y + (size_t)(tok0 + irow) * DINNER + h * 64 + 32 * pt + 8 * q + 4 * hf); }
#pragma unroll
    for (int k = 0; k < 5; ++k) *(LAS v4u*)(lds + soff[k]) = stg[k];
    if (!ywave) { LAS bf16* Hs = (LAS bf16*)(lds + SS_HS);
#pragma unroll
        for (int i = 0; i < 16; ++i) { const int pr = 8 * (i >> 2) + 4 * hf + (i & 3);
            Hs[pr * 136 + 32 * w4 + l32] = (bf16)(cvt_pk_bf16(hs0[i], 0.f) & 0xffffu); Hs[(32 + pr) * 136 + 32 * w4 + l32] = (bf16)(cvt_pk_bf16(hs1[i], 0.f) & 0xffffu); } }
    __syncthreads();
    for (int c = 0; c < nch; ++c) {
        const int tokc = tok0 + 64 * c, buf = c & 1;
        LAS unsigned char* tb = lds + buf * SS_TILE;
        const LAS bf16* Xn = (const LAS bf16*)(tb + SS_XN); const LAS bf16* Bn = (const LAS bf16*)(tb + SS_BN); const LAS bf16* Cn = (const LAS bf16*)(tb + SS_CN);
        const LAS bf16* Hs = (const LAS bf16*)(lds + SS_HS + buf * SS_HSZ);
        const float dtc = dtn; float av = dtc * a_h;
#pragma unroll
        for (int o = 1; o < 64; o <<= 1) { const float t = __shfl_up(av, o); if (lane >= o) av += t; }
        acs[lane] = av; dtv[lane] = dtc;
        const v2u zc0 = zn[0], zc1 = zn[1], zc2 = zn[2], zc3 = zn[3];
        const bool more = (c + 1 < nch);
        if (more) {
#pragma unroll
            for (int k = 0; k < 5; ++k) stg[k] = *(const v4u*)(XBC + (size_t)(tokc + 64) * CONVC + goff[k]);
            dtn = DT[(size_t)(tokc + 64 + lane) * 32 + h];
            if (ywave) {
#pragma unroll
                for (int q = 0; q < 4; ++q) zn[q] = *(const v2u*)(Y + (size_t)(tokc + 64 + irow) * DINNER + h * 64 + 32 * pt + 8 * q + 4 * hf); }
        }
        if (ywave) {
            const int prow = 32 * pt + l32;
            f32x16 yo;
#pragma unroll
            for (int i = 0; i < 16; ++i) yo[i] = 0.f;
#pragma unroll
            for (int ks = 0; ks < 8; ++ks) { const bf16x8 av8 = *(const LAS bf16x8*)(Hs + prow * 136 + 16 * ks + 8 * hf), bv8 = *(const LAS bf16x8*)(Cn + irow * 136 + 16 * ks + 8 * hf); yo = MFMA32(av8, bv8, yo); }
            const float ai = acs[irow]; const float ei = __expf(ai);
#pragma unroll
            for (int i = 0; i < 16; ++i) yo[i] *= ei;
            for (int jt = 0; jt <= it; ++jt) {
                f32x16 s;
#pragma unroll
                for (int i = 0; i < 16; ++i) s[i] = 0.f;
#pragma unroll
                for (int ks = 0; ks < 8; ++ks) { const bf16x8 av8 = *(const LAS bf16x8*)(Bn + (32 * jt + l32) * 136 + 16 * ks + 8 * hf), bv8 = *(const LAS bf16x8*)(Cn + irow * 136 + 16 * ks + 8 * hf); s = MFMA32(av8, bv8, s); }
                float mv[16];
#pragma unroll
                for (int i = 0; i < 16; ++i) { const int j = 32 * jt + 8 * (i >> 2) + 4 * hf + (i & 3); mv[i] = (j <= irow) ? s[i] * __expf(ai - acs[j]) * dtv[j] : 0.f; }
#pragma unroll
                for (int jj = 0; jj < 2; ++jj) {
                    const v4u pk = pack8(mv + 8 * jj); bf16x8 bv8; __builtin_memcpy(&bv8, &pk, 16);
                    const int ja = 32 * jt + 16 * jj + 4 * hf;
                    const bf16x8 av8 = tr_frag(Xn, 72, ja, ja + 8, 32 * pt + l32, lane);
                    yo = MFMA32(av8, bv8, yo);
                }
            }
            float sq = 0.f; bf16* zp = Y + (size_t)(tokc + irow) * DINNER + h * 64 + 32 * pt + 4 * hf;
#pragma unroll
            for (int q = 0; q < 4; ++q) { const int p4 = 32 * pt + 8 * q + 4 * hf;
                const v2u xr = *(const LAS v2u*)(Xn + irow * 72 + p4); const v2u zr = (q == 0) ? zc0 : (q == 1) ? zc1 : (q == 2) ? zc2 : zc3;
                const float x0 = bf2f(xr.x & 0xffffu), x1 = __uint_as_float(xr.x & 0xffff0000u), x2 = bf2f(xr.y & 0xffffu), x3 = __uint_as_float(xr.y & 0xffff0000u);
                const float z0 = bf2f(zr.x & 0xffffu), z1 = __uint_as_float(zr.x & 0xffff0000u), z2 = bf2f(zr.y & 0xffffu), z3 = __uint_as_float(zr.y & 0xffff0000u);
                const float y0 = (yo[4 * q] + d_h * x0) * z0, y1 = (yo[4 * q + 1] + d_h * x1) * z1, y2 = (yo[4 * q + 2] + d_h * x2) * z2, y3 = (yo[4 * q + 3] + d_h * x3) * z3;
                sq += (y0 * y0 + y1 * y1) + (y2 * y2 + y3 * y3);
                v2u o; o.x = cvt_pk_bf16(y0, y1); o.y = cvt_pk_bf16(y2, y3); *(v2u*)(zp + 8 * q) = o; }
            ((LAS float*)(lds + SS_SQ))[buf * 256 + (pt * 2 + hf) * 64 + irow] = sq;
        } else {
            const float a63 = acs[63]; const float dec = __expf(a63);
#pragma unroll
            for (int i = 0; i < 16; ++i) { hs0[i] *= dec; hs1[i] *= dec; }
#pragma unroll
            for (int ks = 0; ks < 4; ++ks) {
                const int j0 = 16 * ks + 8 * hf;
                const bf16x8 bv8 = tr_frag(Bn, 136, j0, j0 + 4, 32 * w4 + l32, lane);
                float wj[8];
#pragma unroll
                for (int e = 0; e < 8; ++e) wj[e] = __expf(a63 - acs[j0 + e]) * dtv[j0 + e];
#pragma unroll
                for (int ptt = 0; ptt < 2; ++ptt) {
                    const bf16x8 xr = tr_frag(Xn, 72, j0, j0 + 4, 32 * ptt + l32, lane);
                    v4u xu; __builtin_memcpy(&xu, &xr, 16); float xf[8]; unpack8(xu, xf);
#pragma unroll
                    for (int e = 0; e < 8; ++e) xf[e] *= wj[e];
                    const v4u xp = pack8(xf); bf16x8 av8; __builtin_memcpy(&av8, &xp, 16);
                    if (ptt == 0) hs0 = MFMA32(av8, bv8, hs0); else hs1 = MFMA32(av8, bv8, hs1);
                }
            }
            if (more) { LAS bf16* Hn = (LAS bf16*)(lds + SS_HS + (buf ^ 1) * SS_HSZ);
#pragma unroll
                for (int i = 0; i < 16; ++i) { const int pr = 8 * (i >> 2) + 4 * hf + (i & 3);
                    Hn[pr * 136 + 32 * w4 + l32] = (bf16)(cvt_pk_bf16(hs0[i], 0.f) & 0xffffu); Hn[(32 + pr) * 136 + 32 * w4 + l32] = (bf16)(cvt_pk_bf16(hs1[i], 0.f) & 0xffffu); } }
        }
        if (more) {
#pragma unroll
            for (int k = 0; k < 5; ++k) *(LAS v4u*)(lds + (buf ^ 1) * SS_TILE + soff[k]) = stg[k]; }
        __syncthreads();
        if (tid < 64) { const LAS float* sq = (const LAS float*)(lds + SS_SQ) + buf * 256; SSQ[(size_t)(tokc + tid) * 32 + h] = (sq[tid] + sq[64 + tid]) + (sq[128 + tid] + sq[192 + tid]); }
    }
    if (!ywave) {
#pragma unroll
        for (int i = 0; i < 16; ++i) { const int pr = 8 * (i >> 2) + 4 * hf + (i & 3); sout[(size_t)pr * 128 + 32 * w4 + l32] = hs0[i]; sout[(size_t)(32 + pr) * 128 + 32 * w4 + l32] = hs1[i]; } }
    __syncthreads();
}

constexpr int SCW = 2116;
__device__ __forceinline__ unsigned sortable(float x) { x += 0.0f; const unsigned b = __float_as_uint(x); return (b & 0x80000000u) ? ~b : (b | 0x80000000u); }
__device__ __forceinline__ void topk_unit(LAS unsigned char* lds, int tid, int lane, int wave, bool isS, int b, int qb,
                                          const bf16* QI, const bf16* KIP, const bf16* KIS, const float* WI, unsigned* MASK) {
    const int tok0 = isS ? TP + b * DSEQ + qb * 16 : b * SEQ + qb * 16;
    const int pos0 = (isS ? PAST : 0) + qb * 16, limit = ((pos0 >> 6) + 1) << 6, nslots = limit >> 6, ntile = limit >> 4;
    const bf16* KI = isS ? KIS + (size_t)b * NKS * 64 : KIP + (size_t)b * NKP * 64;
    LAS float* sc = (LAS float*)lds;
    const int l16 = lane & 15, kg = lane >> 4;
    if (limit > 256) {
        bf16x8 qf[8][2]; float wq[8];
#pragma unroll
        for (int hd = 0; hd < 8; ++hd) {
#pragma unroll
            for (int ks = 0; ks < 2; ++ks) qf[hd][ks] = *(const bf16x8*)(QI + (size_t)(tok0 + l16) * 512 + hd * 64 + 32 * ks + 8 * kg);
            wq[hd] = WI[(size_t)(tok0 + l16) * 8 + hd]; }
        for (int kt = wave; kt < ntile; kt += 8) {
            const bf16x8 a0 = *(const bf16x8*)(KI + (size_t)(16 * kt + l16) * 64 + 8 * kg), a1 = *(const bf16x8*)(KI + (size_t)(16 * kt + l16) * 64 + 32 + 8 * kg);
            f32x4 s = (f32x4){0.f, 0.f, 0.f, 0.f};
#pragma unroll
            for (int hd = 0; hd < 8; ++hd) { f32x4 c = (f32x4){0.f, 0.f, 0.f, 0.f};
                c = __builtin_amdgcn_mfma_f32_16x16x32_bf16(a0, qf[hd][0], c, 0, 0, 0); c = __builtin_amdgcn_mfma_f32_16x16x32_bf16(a1, qf[hd][1], c, 0, 0, 0);
#pragma unroll
                for (int i = 0; i < 4; ++i) s[i] += wq[hd] * fmaxf(c[i], 0.f); }
            *(LAS f32x4*)(sc + l16 * SCW + 16 * kt + 4 * kg) = s;
        }
    }
    __syncthreads();
    for (int qq = 0; qq < 2; ++qq) {
        const int q = 2 * wave + qq; unsigned* mrow = MASK + (size_t)(tok0 + q) * MASKW;
        if (limit <= 256) {
            if (lane < 33) { const unsigned v = (lane < nslots) ? 0xffffffffu : 0u; mrow[2 * lane] = v; mrow[2 * lane + 1] = v; }
            continue;
        }
        unsigned u[33];
#pragma unroll
        for (int j = 0; j < 33; ++j) u[j] = (j < nslots) ? sortable(sc[q * SCW + 64 * j + lane]) : 0u;
        const int ng = (nslots + 10) / 11;
#define CNT_GE(dst, val) do { int _c = 0; \
            _Pragma("unroll") for (int j = 0; j < 11; ++j) _c += __popcll(__ballot(u[j] >= (val))); \
            if (ng > 1) { _Pragma("unroll") for (int j = 11; j < 22; ++j) _c += __popcll(__ballot(u[j] >= (val))); } \
            if (ng > 2) { _Pragma("unroll") for (int j = 22; j < 33; ++j) _c += __popcll(__ballot(u[j] >= (val))); } \
            dst = _c; } while (0)
        unsigned thr = 0u; bool exact = false;
        for (int bit = 31; bit >= 0; --bit) { const unsigned cand = thr | (1u << bit); int cnt; CNT_GE(cnt, cand);
            if (cnt >= 256) thr = cand;
            if (cnt == 256) { exact = true; break; } }
        int rem = 0;
        if (!exact) { int cgt; CNT_GE(cgt, thr + 1u); rem = 256 - cgt; }
#pragma unroll
        for (int j = 0; j < 33; ++j) {
            unsigned long long wv;
            if (exact) wv = __ballot(u[j] >= thr);
            else { const unsigned long long gt = __ballot(u[j] > thr); unsigned long long eq = __ballot(u[j] == thr), sel = 0ull;
                const int pe = __popcll(eq);
                if (pe <= rem) { sel = eq; rem -= pe; }
                else { while (rem > 0) { const unsigned long long low = eq & (0ull - eq); sel |= low; eq ^= low; --rem; } }
                wv = gt | sel; }
            if (lane == 0) { mrow[2 * j] = (unsigned)wv; mrow[2 * j + 1] = (unsigned)(wv >> 32); }
        }
#undef CNT_GE
    }
    __syncthreads();
}

constexpr int AT_K = 0, AT_V = 18432, AT_M = 59392, AT_VP = 160, AT_VSZ = 64 * AT_VP;
__device__ __forceinline__ void attn_unit(LAS unsigned char* lds, int tid, int lane, int wave, bool isS, int b, int c, int kvh,
                                          bf16* Q, const bf16* KP, const bf16* KSn, const bf16* VP, const bf16* VSn, const float* CK, const float* CV, const unsigned* MASK) {
    const int tok0 = isS ? TP + b * DSEQ : b * SEQ + 64 * c;
    const int limit = isS ? NKS : 64 * (c + 1), nt = limit >> 6;
    const bf16* Kb = isS ? KSn + (size_t)(b * 4 + kvh) * DSEQ * 64 : KP + (size_t)(b * 4 + kvh) * NKP * 64;
    const bf16* Vb = isS ? VSn + (size_t)(b * 4 + kvh) * DSEQ * 64 : VP + (size_t)(b * 4 + kvh) * NKP * 64;
    const float* Kc = CK + ((size_t)b * PAST * 4 + kvh) * 64; const float* Vc32 = CV + ((size_t)b * PAST * 4 + kvh) * 64;
    LAS bf16* Kt = (LAS bf16*)(lds + AT_K); LAS bf16* Vt = (LAS bf16*)(lds + AT_V); LAS unsigned* MK = (LAS unsigned*)(lds + AT_M);
    const int l32 = lane & 31, hf = lane >> 5, r = 32 * wave + l32, tl = r >> 2, gq = r & 3;
    bf16* qp = Q + (size_t)(tok0 + tl) * DM + (kvh * 4 + gq) * 64;
    bf16x8 qf[4];
#pragma unroll
    for (int ks = 0; ks < 4; ++ks) qf[ks] = *(const bf16x8*)(qp + hf * 32 + 8 * ks);
    const int srow = tid >> 3, sseg = tid & 7;
    v4u kr0, kr1, vr0, vr1;
#define AT_LOAD(kt_) do { if (isS && (kt_) < 32) { const float* kp_ = Kc + (size_t)(64 * (kt_) + srow) * 256 + 8 * sseg; const float* vp_ = Vc32 + (size_t)(64 * (kt_) + srow) * 256 + 8 * sseg; \
            kr0 = *(const v4u*)kp_; kr1 = *(const v4u*)(kp_ + 4); vr0 = *(const v4u*)vp_; vr1 = *(const v4u*)(vp_ + 4); } \
        else { const int kk_ = isS ? srow : 64 * (kt_) + srow; kr0 = *(const v4u*)(Kb + (size_t)kk_ * 64 + 8 * sseg); vr0 = *(const v4u*)(Vb + (size_t)kk_ * 64 + 8 * sseg); } } while (0)
#define AT_STORE(kt_, buf_) do { v4u ko_ = kr0, vo_ = vr0; \
        if (isS && (kt_) < 32) { ko_.x = cvt_pk_bf16(__uint_as_float(kr0.x), __uint_as_float(kr0.y)); ko_.y = cvt_pk_bf16(__uint_as_float(kr0.z), __uint_as_float(kr0.w)); ko_.z = cvt_pk_bf16(__uint_as_float(kr1.x), __uint_as_float(kr1.y)); ko_.w = cvt_pk_bf16(__uint_as_float(kr1.z), __uint_as_float(kr1.w)); \
            vo_.x = cvt_pk_bf16(__uint_as_float(vr0.x), __uint_as_float(vr0.y)); vo_.y = cvt_pk_bf16(__uint_as_float(vr0.z), __uint_as_float(vr0.w)); vo_.z = cvt_pk_bf16(__uint_as_float(vr1.x), __uint_as_float(vr1.y)); vo_.w = cvt_pk_bf16(__uint_as_float(vr1.z), __uint_as_float(vr1.w)); } \
        *(LAS v4u*)(Kt + (buf_) * 4608 + srow * 72 + 8 * sseg) = ko_; *(LAS v4u*)(Vt + (buf_) * AT_VSZ + srow * AT_VP + 8 * sseg) = vo_; } while (0)
    AT_LOAD(0);
    for (int i = tid; i < 64 * MASKW; i += 512) MK[i] = MASK[(size_t)tok0 * MASKW + i];
    AT_STORE(0, 0);
    __syncthreads();
    f32x16 o0, o1;
#pragma unroll
    for (int i = 0; i < 16; ++i) { o0[i] = 0.f; o1[i] = 0.f; }
    float lpart = 0.f;
    for (int kt = 0; kt < nt; ++kt) {
        const int buf = kt & 1;
        if (kt + 1 < nt) AT_LOAD(kt + 1);
        const LAS bf16* Kc2 = Kt + buf * 4608; const LAS bf16* Vc = Vt + buf * AT_VSZ;
        f32x16 s0, s1;
#pragma unroll
        for (int i = 0; i < 16; ++i) { s0[i] = 0.f; s1[i] = 0.f; }
#pragma unroll
        for (int ks = 0; ks < 4; ++ks) { const bf16x8 a0 = *(const LAS bf16x8*)(Kc2 + l32 * 72 + hf * 32 + 8 * ks), a1 = *(const LAS bf16x8*)(Kc2 + (32 + l32) * 72 + hf * 32 + 8 * ks);
            s0 = MFMA32(a0, qf[ks], s0); s1 = MFMA32(a1, qf[ks], s1); }
        const unsigned w0 = MK[tl * MASKW + 2 * kt] >> (4 * hf), w1 = MK[tl * MASKW + 2 * kt + 1] >> (4 * hf);
        float p0[16], p1[16], ls = 0.f;
#pragma unroll
        for (int i = 0; i < 16; ++i) { const int bp = 8 * (i >> 2) + (i & 3);
            p0[i] = ((w0 >> bp) & 1u) ? __builtin_amdgcn_exp2f(s0[i]) : 0.f; p1[i] = ((w1 >> bp) & 1u) ? __builtin_amdgcn_exp2f(s1[i]) : 0.f; ls += p0[i] + p1[i]; }
        lpart += ls;
#pragma unroll
        for (int sub = 0; sub < 2; ++sub)
#pragma unroll
            for (int jj = 0; jj < 2; ++jj) {
                const v4u pk = pack8((sub ? p1 : p0) + 8 * jj); bf16x8 bv; __builtin_memcpy(&bv, &pk, 16);
                const int ja = 32 * sub + 16 * jj + 4 * hf;
                const bf16x8 av0 = tr_frag(Vc, AT_VP, ja, ja + 8, l32, lane), av1 = tr_frag(Vc, AT_VP, ja, ja + 8, 32 + l32, lane);
                o0 = MFMA32(av0, bv, o0); o1 = MFMA32(av1, bv, o1);
            }
        if (kt + 1 < nt) AT_STORE(kt + 1, buf ^ 1);
        __syncthreads();
    }
#undef AT_LOAD
#undef AT_STORE
    const float lt = lpart + __shfl_xor(lpart, 32), inv = 1.f / lt;
#pragma unroll
    for (int q = 0; q < 4; ++q) {
        v2u a; a.x = cvt_pk_bf16(o0[4 * q] * inv, o0[4 * q + 1] * inv); a.y = cvt_pk_bf16(o0[4 * q + 2] * inv, o0[4 * q + 3] * inv); *(v2u*)(qp + 8 * q + 4 * hf) = a;
        v2u c2; c2.x = cvt_pk_bf16(o1[4 * q] * inv, o1[4 * q + 1] * inv); c2.y = cvt_pk_bf16(o1[4 * q + 2] * inv, o1[4 * q + 3] * inv); *(v2u*)(qp + 32 + 8 * q + 4 * hf) = c2;
    }
    __syncthreads();
}
constexpr int NPHASES = 12;

#ifdef NOSSD
#define SSDCALL(...) (void)0
#else
#define SSDCALL ssd_unit
#endif
#ifdef NOATT
#define ATTCALL(...) (void)0
#else
#define ATTCALL attn_unit
#endif
#define XB_TMO      128
#define XB_XCNT(j)  (256  + 64 * (j))
#define XB_XSUB(j)  (1280 + 64 * (j))
#define XB_XGEN(j)  (2304 + 64 * (j))
#define XB_TOP      3328
#define XB_TOPGEN   3392
#define XCD_BAR_WORDS 3456
#define XB_SPIN_CAP (1u << 18)

__device__ __forceinline__ unsigned xb_ld(unsigned* p)              { return __hip_atomic_load(p, __ATOMIC_RELAXED, __HIP_MEMORY_SCOPE_AGENT); }
__device__ __forceinline__ unsigned xb_add(unsigned* p, unsigned v) { return __hip_atomic_fetch_add(p, v, __ATOMIC_RELAXED, __HIP_MEMORY_SCOPE_AGENT); }
__device__ __forceinline__ unsigned xb_xcc_id() { return (unsigned)__builtin_amdgcn_s_getreg((3 << 11) | 20) & 0xFu; }
#define XB_SPIN(cond, bar) do { unsigned _sp = 0; while (cond) { __builtin_amdgcn_s_sleep(1); \
    if ((++_sp & 255u) == 0u) { if (xb_ld(&(bar)[XB_TMO])) break; if (_sp > XB_SPIN_CAP) { atomicAdd(&(bar)[XB_TMO], 1u); break; } } } } while (0)

struct XcdBarrier {
    unsigned* bar; unsigned x;
    volatile LAS unsigned* st;
};

__device__ __forceinline__ XcdBarrier xcd_barrier_post(unsigned* bar, volatile LAS unsigned* st) {
    XcdBarrier b; b.bar = bar; b.x = xb_xcc_id(); b.st = st;
    if (threadIdx.x == 0) (void)xb_add(&bar[XB_XCNT(b.x)], 1u);
    return b;
}
__device__ __forceinline__ void xcd_barrier_complete(unsigned* bar, unsigned x, unsigned& nloc, unsigned& nx) {
    const unsigned G = gridDim.x * gridDim.y * gridDim.z;
    unsigned sum, cnt, mine, sp = 0u;
    for (;;) {
        sum = 0u; cnt = 0u; mine = 0u;
#pragma unroll
        for (unsigned j = 0; j < 16; ++j) { const unsigned c = xb_ld(&bar[XB_XCNT(j)]); sum += c; cnt += (c > 0u) ? 1u : 0u; mine = (j == x) ? c : mine; }
        if (sum == G) break;
        __builtin_amdgcn_s_sleep(1);
        if ((++sp & 255u) == 0u) { if (xb_ld(&bar[XB_TMO])) break; if (sp > XB_SPIN_CAP) { atomicAdd(&bar[XB_TMO], 1u); break; } }
    }
    nloc = mine > 0u ? mine : 1u; nx = cnt > 0u ? cnt : 1u;
}

__device__ __forceinline__ void xcd_barrier(const XcdBarrier& b) {
    asm volatile("s_waitcnt vmcnt(0)" ::: "memory");
    __syncthreads();
    if (threadIdx.x == 0) {
        unsigned* bar = b.bar;
        __builtin_amdgcn_s_waitcnt(0);
        unsigned nloc = b.st[0], nx = b.st[1];
        if (nloc == 0u) { xcd_barrier_complete(bar, b.x, nloc, nx); b.st[0] = nloc; b.st[1] = nx; }
        const unsigned old = xb_add(&bar[XB_XSUB(b.x)], 1u);
        const unsigned gen = old / nloc;
        if (old + 1u == (gen + 1u) * nloc) {
            __builtin_amdgcn_fence(__ATOMIC_RELEASE, "agent");
            asm volatile("s_waitcnt vmcnt(0)" ::: "memory");
            const unsigned og = xb_add(&bar[XB_TOP], 1u);
            const unsigned tg = og / nx;
            if (og + 1u == (tg + 1u) * nx) xb_add(&bar[XB_TOPGEN], 1u);
            else XB_SPIN(xb_ld(&bar[XB_TOPGEN]) == tg, bar);
            __builtin_amdgcn_fence(__ATOMIC_ACQUIRE, "agent");
            xb_add(&bar[XB_XGEN(b.x)], 1u);
            asm volatile("s_waitcnt vmcnt(0)" ::: "memory");
        } else {
            XB_SPIN(xb_ld(&bar[XB_XGEN(b.x)]) == gen, bar);
            __builtin_amdgcn_fence(__ATOMIC_ACQUIRE, "agent");
            asm volatile("s_waitcnt vmcnt(0)" ::: "memory");
        }
    }
    __syncthreads();
}

__global__ void __launch_bounds__(512) mega(Params p) {
    extern __shared__ __attribute__((aligned(16))) unsigned char lds_raw[];
    LAS unsigned char* lds = (LAS unsigned char*)lds_raw;
    cg::grid_group grid = cg::this_grid();
    const int tid = threadIdx.x, lane = tid & 63, wave = __builtin_amdgcn_readfirstlane(tid >> 6);
    unsigned char* ws = p.ws;
#define IN(k) (p.ph_hi > (k))
#define SEAM(k) xcd_barrier(xbar)
    volatile LAS unsigned* xst = (volatile LAS unsigned*)(lds + LDS_BYTES - 16);
    if (tid < 4) xst[tid] = 0u;
    __syncthreads();
    if (p.ph_hi < 0) grid.sync();
    XcdBarrier xbar = xcd_barrier_post((unsigned*)(ws + WS_CTL), xst);
    bf16* Hb = (bf16*)(ws + WS_H);
    bf16* QIb = (bf16*)(p.out + O_SSMS); bf16* KIPb = QIb + (size_t)TT * 512; bf16* KISb = KIPb + (size_t)NBP * NKP * 64;
    bf16* Zb = (bf16*)(p.out + O_Y);

    if (IN(0)) phase0(p, lds, tid, lane, wave);
    SEAM(0);
    if (IN(1)) normmod_phase<true>(p, lds, tid, lane, wave, p.in[0], p.in[1], p.in[11], 0, 1024, Hb);
    SEAM(1);
    if (IN(2)) {
        pg8::Gemm g{Hb, (const bf16*)(ws + WS_WIN), TT, NIN, DM}; pg8::StaticOrder S; S.init(TT, NIN, gridDim.x, (int)blockIdx.x);
        EpiIn E{(bf16*)(ws + WS_Q), (bf16*)(ws + WS_KP), (bf16*)(ws + WS_KS), (bf16*)(ws + WS_VTP), (bf16*)(ws + WS_VTS), QIb, KIPb, KISb, Zb, (bf16*)(ws + WS_XBC),
                (float*)(ws + WS_WI), (float*)(ws + WS_DT), p.out, p.in[14], p.in[15], p.in[18], (const float*)(ws + WS_ROPE)};
        pg8::gemm_phase<EpiIn, pg8::StaticOrder, true, true>(lds, g, S, E);
    }
    SEAM(2);
    bf16* Qb = (bf16*)(ws + WS_Q); unsigned* MASKb = (unsigned*)(ws + WS_MASK); float* SSQb = (float*)(ws + WS_SSQ);
    bf16* GATESb = (bf16*)(ws + WS_GATES); bf16* P1b = (bf16*)(ws + WS_P1); bf16* MXb = (bf16*)(ws + WS_MIXED); bf16* ACTb = (bf16*)(ws + WS_ACT);
    const float* MODb = (const float*)(ws + WS_MOD);
    const int G = gridDim.x, bx = blockIdx.x;
    const int bxr = ((G & 7) == 0) ? ((G >> 3) - 1 - (bx >> 3)) * 8 + (bx & 7) : G - 1 - bx;
    if (IN(3)) {
        conv_phase(p, tid, (bf16*)(ws + WS_XBC));
        __syncthreads();
        for (int rd = 0; rd * G < 1152; ++rd) { const int u = rd * G + ((rd & 1) ? bxr : bx); if (u >= 1152) continue;
            bool us; int ub, uq;
            if (u < 128) { us = true; ub = u >> 2; uq = u & 3; } else { const int v = u - 128; us = false; ub = v & 7; uq = 127 - (v >> 3); }
            topk_unit(lds, tid, lane, wave, us, ub, uq, QIb, KIPb, KISb, (const float*)(ws + WS_WI), MASKb); }
    }
    SEAM(3);
    if (IN(4)) {
        for (int rd = 0; rd * G < 2432; ++rd) { const int u = rd * G + ((rd & 1) ? bxr : bx); if (u >= 2432) continue;
            int kind, ub, uc, uh; bool us;
            if (u < 256) { kind = 0; us = false; const int gi = ((u >> 5) << 3) + (u & 7); ub = gi >> 3; uh = ((gi & 7) << 2) + ((u >> 3) & 3); uc = 0; }
            else if (u < 384) { const int v = u - 256; kind = 1; us = true; ub = v >> 2; uh = v & 3; uc = 0; }
            else if (u < 1408) { const int v = u - 384, w = v & 31; kind = 1; us = false; ub = w >> 2; uh = w & 3; uc = 31 - (v >> 5); }
            else { const int v = u - 1408; kind = 0; us = true; const int gi = ((v >> 5) << 3) + (v & 7); ub = gi >> 3; uh = ((gi & 7) << 2) + ((v >> 3) & 3); uc = 0; }
            if (kind == 0) SSDCALL(p, lds, tid, lane, wave, us, ub, uh, (const bf16*)(ws + WS_XBC), (const float*)(ws + WS_DT), Zb, SSQb);
            else ATTCALL(lds, tid, lane, wave, us, ub, uc, uh, Qb, (const bf16*)(ws + WS_KP), (const bf16*)(ws + WS_KS), (const bf16*)(ws + WS_VTP), (const bf16*)(ws + WS_VTS), p.in[2], p.in[3], MASKb); }
    }
    SEAM(4);
    if (IN(5)) {
        ynorm_phase(p, lane, wave, Zb, SSQb);
        __syncthreads();
        { pg8::Gemm g{Hb, (const bf16*)(ws + WS_WG), TT, 2048, DM}; pg8::StaticOrder S; S.init(TT, 2048, G, bx);
          EpiGates E{GATESb};
          pg8::gemm_phase<EpiGates, pg8::StaticOrder, true, true>(lds, g, S, E); }
        { pg8::Gemm g{Qb, (const bf16*)(ws + WS_WBA), TT, DM, DM}; pg8::StaticOrder S; S.init(TT, DM, G, G - 1 - bx);
          EpiP1 E{GATESb, P1b};
          pg8::gemm_phase<EpiP1, pg8::StaticOrder, true, true>(lds, g, S, E); }
    }
    SEAM(5);
    if (IN(7)) {
        pg8::Gemm g{Zb, (const bf16*)(ws + WS_WBS), TT, DM, DINNER}; pg8::StaticOrder S; S.init(TT, DM, G, bx);
        EpiMixed E{GATESb, P1b, MXb};
        pg8::gemm_phase<EpiMixed, pg8::StaticOrder, true, true>(lds, g, S, E);
    }
    SEAM(7);
    if (IN(8)) {
        pg8::Gemm g{MXb, (const bf16*)(ws + WS_WOUT), TT, DM, DM}; pg8::StaticOrder S; S.init(TT, DM, G, bx);
        EpiRes E{p.in[0], p.in[1], MODb, 2048, p.out};
        pg8::gemm_phase<EpiRes, pg8::StaticOrder, true, true>(lds, g, S, E);
    }
    SEAM(8);
    if (IN(9)) normmod_phase<false>(p, lds, tid, lane, wave, p.out, p.out + (size_t)TP * DM, p.in[12], 3072, 4096, Hb);
    SEAM(9);
    if (IN(10)) {
        pg8::Gemm g{Hb, (const bf16*)(ws + WS_WGU), TT, 2 * DFF, DM}; pg8::StaticOrder S; S.init(TT, 2 * DFF, G, bx);
        EpiAct E{ACTb};
        pg8::gemm_phase<EpiAct, pg8::StaticOrder, true, true>(lds, g, S, E);
    }
    SEAM(10);
    if (IN(11)) {
        pg8::Gemm g{ACTb, (const bf16*)(ws + WS_WDN), TT, DM, DFF}; pg8::StaticOrder S; S.init(TT, DM, G, bx);
        EpiRes E{p.out, p.out + (size_t)TP * DM, MODb, 5120, p.out};
        pg8::gemm_phase<EpiRes, pg8::StaticOrder, true, true>(lds, g, S, E);
    }
#undef IN
#undef SEAM
}

extern "C" void kernel_launch(void* const* d_in, const int* in_sizes, int n_in, void* d_out, int out_size, void* d_ws, size_t ws_size, hipStream_t stream) {
    static int grid = 0;
    if (grid == 0) {
        if (n_in != 27 || ws_size < WS_END) { fprintf(stderr, "kernel_launch: unexpected n_in %d / ws %zu\n", n_in, ws_size); grid = -1; return; }
        int dev = 0, cus = 0, per_cu = 0;
        hipGetDevice(&dev); hipDeviceGetAttribute(&cus, hipDeviceAttributeMultiprocessorCount, dev);
        hipFuncSetAttribute((const void*)mega, hipFuncAttributeMaxDynamicSharedMemorySize, LDS_BYTES);
        hipOccupancyMaxActiveBlocksPerMultiprocessor(&per_cu, (const void*)mega, 512, LDS_BYTES);
        (void)hipGetLastError();
        if (per_cu < 1) per_cu = 1;
        grid = cus;
    }
    if (grid < 0) return;
    Params prm{};
    for (int i = 0; i < 27; ++i) prm.in[i] = (const float*)d_in[i];
    prm.out = (float*)d_out; prm.ws = (unsigned char*)d_ws; prm.ph_lo = 0; prm.ph_hi = NPHASES;
    (void)hipMemsetAsync((char*)d_ws + WS_CTL, 0, 16384, stream);
    void* args[] = {&prm};
    hipError_t e = hipLaunchCooperativeKernel((const void*)mega, dim3(grid), dim3(512), args, LDS_BYTES, stream);
    if (e != hipSuccess) fprintf(stderr, "cooperative launch failed: %s (grid %d)\n", hipGetErrorString(e), grid);
}
```

```cpp
#include <hip/hip_runtime.h>
#include <hip/hip_cooperative_groups.h>
#include <cstdio>
#include <cstdint>
namespace cg = cooperative_groups;

namespace pg8 {
#define PG8_LAS __attribute__((address_space(3)))
typedef unsigned short bf16_t;
typedef short bf16x8 __attribute__((ext_vector_type(8)));
typedef float f32x4 __attribute__((ext_vector_type(4)));
typedef unsigned u32x4 __attribute__((ext_vector_type(4)));
constexpr int BM = 256, BK = 64, HALF = 128, HTB = HALF * BK * 2  , STAGE_BYTES = 8 * HTB, NXCD = 8, WGM = 9;

__host__ __device__ __forceinline__ int lds_byte(int r, int c) { const int st = (r >> 4) * 2 + (c >> 5), rr = r & 15, cc = c & 31, ob = rr * 64 + cc * 2; return st * 1024 + (ob ^ (((ob >> 9) & 1) << 5)); }
__host__ __device__ __forceinline__ void stage_rc(int b, int& R, int& C) { const int st = b / 1024, sb = b % 1024, swz = sb ^ (((sb >> 9) & 1) << 5); R = (st >> 1) * 16 + swz / 64; C = (st & 1) * 32 + (swz % 64) / 2; }
__host__ __device__ __forceinline__ int perm32(int rho) { const int n = rho >> 4, i = rho & 15; return 8 * (i >> 2) + 4 * n + (i & 3); }

struct Unit { int pm, pn; };
struct Gemm { const bf16_t* A; const bf16_t* Bt; int M, N, K; int ld = 0; int ncol = 0; };

struct StaticOrder {
    int nM, nN, nwg, G, c;
    __host__ __device__ void init(int M, int N, int G_, int c_) { nM = M / BM; nN = N / BM; nwg = nM * nN; G = G_; c = c_; }
    __host__ __device__ bool next(int i, Unit& u) const {
        const long L = (long)i * G + c; if (L >= nwg) return false;
        int wgid = (int)L; { const int q = nwg / NXCD, r = nwg % NXCD, xcd = wgid % NXCD, off = wgid / NXCD; wgid = (xcd < r ? xcd * (q + 1) : r * (q + 1) + (xcd - r) * q) + off; }
        const int nig = WGM * nN, gid = wgid / nig, fm = gid * WGM, gsz = (nM - fm) < WGM ? (nM - fm) : WGM;
        u.pm = fm + ((wgid % nig) % gsz); u.pn = (wgid % nig) / gsz; return true;
    }
    __device__ __forceinline__ void a_ready(const Unit&) const {}
    __device__ __forceinline__ void done(const Unit&) const {}
};
typedef float f32x2_t __attribute__((ext_vector_type(2)));
typedef __bf16 bf16x2_t __attribute__((ext_vector_type(2)));
__device__ __forceinline__ unsigned cvt_pk_bf16(float lo, float hi) { const bf16x2_t r = __builtin_convertvector((f32x2_t){lo, hi}, bf16x2_t); unsigned u; __builtin_memcpy(&u, &r, 4); return u; }
template <class Epi, class Sched, bool ALIGN_EPI = false, bool SP2 = false>
__device__ __forceinline__ void gemm_phase(PG8_LAS unsigned char* lds, const Gemm g, const Sched& S, const Epi& E) {
    const int tid = threadIdx.x, wid = __builtin_amdgcn_readfirstlane(tid >> 6), lane = tid & 63, wr = wid >> 2, wc = wid & 3, fr = lane & 15, fq = lane >> 4;
    const int K = g.ld ? g.ld : g.K, nt = g.K / BK;
    const int ncol = g.ncol ? g.ncol : (1 << 30); const size_t ksplit = (size_t)g.K * 2;
    unsigned voffA[2], voffB[2];
#pragma unroll
    for (int i = 0; i < 2; ++i) { int R, C; stage_rc(tid * 16 + i * 8192, R, C); const int Rb = Epi::PERM ? ((R & ~31) + perm32(R & 31)) : R;
        voffA[i] = (unsigned)(R * K + C) * 2u; voffB[i] = (unsigned)(Rb * K + C) * 2u; }
    const size_t kstep = (size_t)(BK * 2);
    const size_t hstep = (size_t)HALF * K * 2;
    const size_t tstep = 2 * hstep;
    const unsigned ldsw = (unsigned)wid * 1024u;
    const int aoff = lds_byte(wr * 64 + fr, fq * 8), boff = lds_byte(wc * 32 + fr, fq * 8);
#define PG8_SA(b, h) (((b) * 2 + (h)) * HTB)
#define PG8_SB(b, h) ((4 + (b) * 2 + (h)) * HTB)
#define PG8_STAGE(bufoff, gbase, voff) do { _Pragma("unroll") for (int _i = 0; _i < 2; ++_i) \
        __builtin_amdgcn_global_load_lds((const unsigned*)((const char*)(gbase) + (voff)[_i]), (PG8_LAS unsigned*)(lds + (bufoff) + ldsw + _i * 8192), 16, 0, 0); } while (0)
#define PG8_LDA(dst, b, h) do { _Pragma("unroll") for (int m = 0; m < 4; ++m) _Pragma("unroll") for (int k = 0; k < 2; ++k) dst[m][k] = *(const PG8_LAS bf16x8*)(lds + PG8_SA(b, h) + aoff + m * 2048 + k * 1024); } while (0)
#define PG8_LDB(dst, b, h) do { _Pragma("unroll") for (int n = 0; n < 2; ++n) _Pragma("unroll") for (int k = 0; k < 2; ++k) dst[n][k] = *(const PG8_LAS bf16x8*)(lds + PG8_SB(b, h) + boff + n * 2048 + k * 1024); } while (0)
#define PG8_MMA(ai, bj, At, Bt) do { __builtin_amdgcn_s_setprio(1); _Pragma("unroll") for (int m = 0; m < 4; ++m) _Pragma("unroll") for (int n = 0; n < 2; ++n) _Pragma("unroll") for (int k = 0; k < 2; ++k) \
        acc[ai][bj][m][n] = __builtin_amdgcn_mfma_f32_16x16x32_bf16(Bt[n][k], At[m][k], acc[ai][bj][m][n], 0, 0, 0); __builtin_amdgcn_s_setprio(0); } while (0)
#define PG8_WAIT_V(n) asm volatile("s_waitcnt vmcnt(" #n ")" ::: "memory")
#define PG8_WAIT_L(n) asm volatile("s_waitcnt lgkmcnt(" #n ")" ::: "memory")
#define PG8_BAR __builtin_amdgcn_s_barrier()
#define PG8_SCHED __builtin_amdgcn_sched_barrier(0)
    Unit cur, nxt; int ui = 0;
    if (!S.next(0, cur)) return;
    f32x4 acc[2][2][4][2];
#pragma unroll
    for (int a = 0; a < 2; ++a)
#pragma unroll
        for (int b = 0; b < 2; ++b)
#pragma unroll
            for (int m = 0; m < 4; ++m)
#pragma unroll
                for (int n = 0; n < 2; ++n) acc[a][b][m][n] = (f32x4){0.f, 0.f, 0.f, 0.f};
    bf16x8 At[4][2], B0[2][2], B1[2][2];
    const char* cA = (const char*)g.A + (size_t)cur.pm * tstep + (size_t)(cur.pn / ncol) * ksplit; const char* cB = (const char*)g.Bt + (size_t)(cur.pn % ncol) * tstep + (size_t)(cur.pn / ncol) * ksplit;
    S.a_ready(cur);
    if constexpr (SP2) {
        PG8_STAGE(PG8_SB(0, 0), cB, voffB); PG8_STAGE(PG8_SB(0, 1), cB + hstep, voffB); PG8_STAGE(PG8_SA(0, 0), cA, voffA); PG8_STAGE(PG8_SA(0, 1), cA + hstep, voffA);
        if (wr == 1) PG8_BAR;
        PG8_WAIT_V(2); PG8_BAR;
        PG8_STAGE(PG8_SB(1, 0), cB + kstep, voffB); PG8_STAGE(PG8_SA(1, 0), cA + kstep, voffA); PG8_STAGE(PG8_SB(1, 1), cB + hstep + kstep, voffB);
        PG8_WAIT_V(6); PG8_BAR;
    } else {
        PG8_STAGE(PG8_SB(0, 0), cB, voffB); PG8_STAGE(PG8_SA(0, 0), cA, voffA); PG8_STAGE(PG8_SB(0, 1), cB + hstep, voffB); PG8_STAGE(PG8_SA(0, 1), cA + hstep, voffA);
        if (wr == 1) PG8_BAR;
        PG8_WAIT_V(4); PG8_BAR;
        PG8_STAGE(PG8_SB(1, 0), cB + kstep, voffB); PG8_STAGE(PG8_SA(1, 0), cA + kstep, voffA); PG8_STAGE(PG8_SB(1, 1), cB + hstep + kstep, voffB);
        PG8_WAIT_V(6); PG8_BAR;
    }
    for (;;) {
        const bool has_next = S.next(ui + 1, nxt);
        const char* nA = has_next ? (const char*)g.A + (size_t)nxt.pm * tstep + (size_t)(nxt.pn / ncol) * ksplit : cA; const char* nB = has_next ? (const char*)g.Bt + (size_t)(nxt.pn % ncol) * tstep + (size_t)(nxt.pn / ncol) * ksplit : cB;
        for (int t = 0; t < nt; t += 2) {
            const bool last = (t == nt - 2);
            const char* a1 = cA + (size_t)(t + 1) * kstep;
            const char* a2 = last ? nA : cA + (size_t)(t + 2) * kstep; const char* b2 = last ? nB : cB + (size_t)(t + 2) * kstep;
            const char* a3 = a2 + kstep; const char* b3 = b2 + kstep;
            if (last && has_next) S.a_ready(nxt);
            if constexpr (SP2) {
            PG8_LDB(B0, 0, 0); PG8_LDB(B1, 0, 1); PG8_SCHED; PG8_LDA(At, 0, 0); PG8_STAGE(PG8_SA(1, 1), a1 + hstep, voffA);
            PG8_WAIT_V(8); PG8_WAIT_L(0); PG8_BAR; PG8_MMA(0, 0, At, B0); PG8_MMA(0, 1, At, B1); PG8_BAR; PG8_SCHED;
            PG8_LDA(At, 0, 1); PG8_STAGE(PG8_SB(0, 0), b2, voffB); PG8_STAGE(PG8_SB(0, 1), b2 + hstep, voffB); PG8_STAGE(PG8_SA(0, 0), a2, voffA);
            PG8_WAIT_V(8); PG8_WAIT_L(0); PG8_BAR; PG8_MMA(1, 0, At, B0); PG8_MMA(1, 1, At, B1); PG8_BAR; PG8_SCHED;
            PG8_LDB(B0, 1, 0); PG8_LDB(B1, 1, 1); PG8_SCHED; PG8_LDA(At, 1, 0); PG8_STAGE(PG8_SA(0, 1), a2 + hstep, voffA);
            PG8_WAIT_V(8); PG8_WAIT_L(0); PG8_BAR; PG8_MMA(0, 0, At, B0); PG8_MMA(0, 1, At, B1); PG8_BAR; PG8_SCHED;
            PG8_LDA(At, 1, 1); PG8_STAGE(PG8_SB(1, 0), b3, voffB); PG8_STAGE(PG8_SB(1, 1), b3 + hstep, voffB); PG8_STAGE(PG8_SA(1, 0), a3, voffA);
            PG8_WAIT_V(8); PG8_WAIT_L(0); PG8_BAR; PG8_MMA(1, 0, At, B0); PG8_MMA(1, 1, At, B1); PG8_BAR; PG8_SCHED;
            } else {
            PG8_LDB(B0, 0, 0); PG8_SCHED; PG8_LDA(At, 0, 0); PG8_STAGE(PG8_SA(1, 1), a1 + hstep, voffA);
            PG8_WAIT_L(8); PG8_BAR; PG8_WAIT_L(0); PG8_MMA(0, 0, At, B0); PG8_BAR; PG8_SCHED;
            PG8_LDB(B1, 0, 1); PG8_STAGE(PG8_SB(0, 0), b2, voffB);
            PG8_BAR; PG8_WAIT_L(0); PG8_MMA(0, 1, At, B1); PG8_BAR;
            PG8_LDA(At, 0, 1); PG8_STAGE(PG8_SA(0, 0), a2, voffA);
            PG8_BAR; PG8_WAIT_L(0); PG8_MMA(1, 0, At, B0); PG8_BAR; PG8_SCHED;
            PG8_STAGE(PG8_SB(0, 1), b2 + hstep, voffB);
            PG8_WAIT_V(6); PG8_BAR; PG8_MMA(1, 1, At, B1); PG8_BAR;
            PG8_LDB(B0, 1, 0); PG8_SCHED; PG8_LDA(At, 1, 0); PG8_STAGE(PG8_SA(0, 1), a2 + hstep, voffA);
            PG8_WAIT_L(8); PG8_BAR; PG8_WAIT_L(0); PG8_MMA(0, 0, At, B0); PG8_BAR; PG8_SCHED;
            PG8_LDB(B1, 1, 1); PG8_STAGE(PG8_SB(1, 0), b3, voffB);
            PG8_BAR; PG8_WAIT_L(0); PG8_MMA(0, 1, At, B1); PG8_BAR;
            PG8_LDA(At, 1, 1); PG8_STAGE(PG8_SA(1, 0), a3, voffA);
            PG8_BAR; PG8_WAIT_L(0); PG8_MMA(1, 0, At, B0); PG8_BAR; PG8_SCHED;
            PG8_STAGE(PG8_SB(1, 1), b3 + hstep, voffB);
            PG8_WAIT_V(6); PG8_BAR; PG8_MMA(1, 1, At, B1); PG8_BAR;
            }
        }
        if constexpr (ALIGN_EPI) { if (wr == 0) PG8_BAR; }
        if constexpr (!Epi::AFTER_DRAIN) { E(acc, cur, wr, wc, fr, fq); S.done(cur); }
        if (!has_next) break;
#pragma unroll
        for (int a = 0; a < 2; ++a)
#pragma unroll
            for (int b = 0; b < 2; ++b)
#pragma unroll
                for (int m = 0; m < 4; ++m)
#pragma unroll
                    for (int n = 0; n < 2; ++n) acc[a][b][m][n] = (f32x4){0.f, 0.f, 0.f, 0.f};
        cur = nxt; cA = nA; cB = nB; ++ui;
        if constexpr (ALIGN_EPI) { if (wr == 1) PG8_BAR; }
    }
    PG8_WAIT_V(0);
    if constexpr (!ALIGN_EPI) { if (wr == 0) PG8_BAR; }
    PG8_BAR;
    if constexpr (Epi::AFTER_DRAIN) { E.fused(acc, cur, wr, wc, fr, fq, lds, wid, lane); S.done(cur); }
#undef PG8_SA
#undef PG8_SB
#undef PG8_STAGE
#undef PG8_LDA
#undef PG8_LDB
#undef PG8_MMA
#undef PG8_WAIT_V
#undef PG8_WAIT_L
#undef PG8_BAR
#undef PG8_SCHED
}
}

constexpr int DM = 1024, NBP = 8, SEQ = 2048, NBS = 32, DSEQ = 64, PAST = 2048;
constexpr int TP = NBP * SEQ, TS = NBS * DSEQ, TT = TP + TS;
constexpr int NKP = 2048, NKS = 2112;
constexpr int DFF = 2816, DINNER = 2048, CONVC = 4096;
constexpr int IN_DIM = 10344;
constexpr int CQ = 0, CK = 1024, CV = 1280, CQI = 1536, CKI = 2048, CWI = 2112, CZ = 2120, CXBC = 4168, CDT = 8264, CGATE = 8296;
constexpr int NIN = 33 * 256;
constexpr float EPS = 1e-6f;
constexpr int MASKW = 68;
constexpr size_t O_Y = 0, O_KP = 18874368, O_VP = 23068672, O_KIP = 27262976, O_CONVP = 28311552, O_SSMP = 28409856,
                 O_KS = 30507008, O_VS = 31031296, O_KIS = 31555584, O_CONVS = 31686656, O_SSMS = 32079872;
constexpr size_t MiB = 1u << 20;
constexpr size_t WS_CTL = 0, WS_MOD = 1 * MiB, WS_ROPE = 2 * MiB, WS_WI = 3 * MiB, WS_DT = 4 * MiB;
constexpr size_t WS_WBA = 8 * MiB, WS_WOUT = 10 * MiB, WS_WBS = 12 * MiB, WS_WGU = 16 * MiB, WS_WDN = 27 * MiB, WS_WG = 33 * MiB, WS_WIN = 37 * MiB;
constexpr size_t WS_MASK = 37 * MiB, WS_SSQ = 43 * MiB;
constexpr size_t WS_H = 54 * MiB, WS_Q = 90 * MiB, WS_KP = 126 * MiB, WS_KS = 134 * MiB, WS_VTP = 167 * MiB, WS_VTS = 175 * MiB, WS_XBC = 208 * MiB;
constexpr size_t WS_PART = WS_XBC;
constexpr size_t WS_GATES = 208 * MiB, WS_P1 = 280 * MiB, WS_MIXED = 316 * MiB, WS_ACT = 208 * MiB, WS_END = 352 * MiB;
constexpr int LDS_BYTES = 147456;

#define LAS __attribute__((address_space(3)))
typedef unsigned short bf16;
typedef unsigned v4u __attribute__((ext_vector_type(4)));
typedef unsigned v2u __attribute__((ext_vector_type(2)));
typedef float f32x4 __attribute__((ext_vector_type(4)));
typedef float f32x16 __attribute__((ext_vector_type(16)));
typedef short bf16x8 __attribute__((ext_vector_type(8)));
typedef short bf16x4 __attribute__((ext_vector_type(4)));
using pg8::cvt_pk_bf16;
#define LDS_WAIT() asm volatile("s_waitcnt lgkmcnt(0)" ::: "memory")
__device__ __forceinline__ float bf2f(unsigned h) { return __uint_as_float(h << 16); }
__device__ __forceinline__ float wave_sum(float v) {
#pragma unroll
    for (int o = 1; o < 64; o <<= 1) v += __shfl_xor(v, o);
    return v;
}
__device__ __forceinline__ float silu_f(float v) { return v * __builtin_amdgcn_rcpf(1.f + __expf(-v)); }
__device__ __forceinline__ float sigmoid_f(float v) { return __builtin_amdgcn_rcpf(1.f + __expf(-v)); }
__device__ __forceinline__ v4u pack8(const float* a) { v4u o; o.x = cvt_pk_bf16(a[0], a[1]); o.y = cvt_pk_bf16(a[2], a[3]); o.z = cvt_pk_bf16(a[4], a[5]); o.w = cvt_pk_bf16(a[6], a[7]); return o; }

struct Params { const float* in[27]; float* out; unsigned char* ws; int ph_lo, ph_hi; };

__device__ __forceinline__ void tr_item(const float* __restrict__ W, int ldw, int srccol, int nvalid, bf16* WT, size_t ldd, int dstrow, int k0, LAS float* scr, int lane) {
    { float t[32]; const int c = lane & 31;
#pragma unroll
      for (int i = 0; i < 32; ++i) t[i] = (c < nvalid) ? W[(size_t)(k0 + 2 * i + (lane >> 5)) * ldw + srccol + c] : 0.f;
#pragma unroll
      for (int i = 0; i < 32; ++i) scr[(2 * i + (lane >> 5)) * 33 + c] = t[i]; }
    LDS_WAIT();
    const int c = lane & 7;
#pragma unroll
    for (int j = 0; j < 4; ++j) { const int n = (lane >> 3) + 8 * j; const LAS float* s = scr + (8 * c) * 33 + n;
        v4u o; o.x = cvt_pk_bf16(s[0 * 33], s[1 * 33]); o.y = cvt_pk_bf16(s[2 * 33], s[3 * 33]); o.z = cvt_pk_bf16(s[4 * 33], s[5 * 33]); o.w = cvt_pk_bf16(s[6 * 33], s[7 * 33]);
        *(v4u*)(WT + (size_t)(dstrow + n) * ldd + k0 + 8 * c) = o; }
    LDS_WAIT();
}

__device__ __forceinline__ void phase0(const Params& p, LAS unsigned char* lds, int tid, int lane, int wave) {
    const int G = gridDim.x, bx = blockIdx.x;
    unsigned char* ws = p.ws;
    {
        LAS float* sc = (LAS float*)lds;
        const float* w_ada = p.in[9];
        float* part = (float*)(ws + WS_PART);
        for (int it = bx; it < 192; it += G) {
            const int ks = it / 24, cb = it % 24;
            __syncthreads();
            for (int i = tid; i < 40 * 128; i += 512) { const int r = i >> 7, k = i & 127; const float c = (r < 8) ? p.in[7][r * DM + ks * 128 + k] : p.in[8][(r - 8) * DM + ks * 128 + k]; sc[i] = silu_f(c); }
            __syncthreads();
            const int col = cb * 256 + (tid & 255), rh = tid >> 8;
            float a[20];
#pragma unroll
            for (int r = 0; r < 20; ++r) a[r] = 0.f;
            const float* wp = w_ada + (size_t)(ks * 128) * 6144 + col;
            for (int k0 = 0; k0 < 128; k0 += 16) {
                float w8[16];
#pragma unroll
                for (int i = 0; i < 16; ++i) w8[i] = wp[(size_t)(k0 + i) * 6144];
#pragma unroll
                for (int r = 0; r < 20; ++r) {
#pragma unroll
                    for (int q4 = 0; q4 < 4; ++q4) { const f32x4 s0 = *(const LAS f32x4*)(sc + (rh * 20 + r) * 128 + k0 + 4 * q4);
                        a[r] += (s0[0] * w8[4 * q4] + s0[1] * w8[4 * q4 + 1]) + (s0[2] * w8[4 * q4 + 2] + s0[3] * w8[4 * q4 + 3]); } }
            }
#pragma unroll
            for (int r = 0; r < 20; ++r) part[((size_t)ks * 40 + rh * 20 + r) * 6144 + col] = a[r];
        }
        __syncthreads();
    }
    {
        LAS float* scr = (LAS float*)(lds + wave * 8704);
        const int gw = bx * 8 + wave, NGW = G * 8;
        constexpr int I_IN = 16 * 264, I_G = 16 * 64, I_BA = 16 * 32, I_OUT = 16 * 32, I_BS = 32 * 32, I_GU = 16 * 176, I_DN = 44 * 32;
        constexpr int NIT = I_IN + I_G + I_BA + I_OUT + I_BS + I_GU + I_DN;
        for (int it = gw; it < NIT; it += NGW) {
            int r = it;
            if (r < I_IN) { const int kb = r / 264, rg = r % 264, pn = rg >> 3, w8 = rg & 7, bj = w8 >> 2, wc = w8 & 3; int src, nv = 32;
                if (pn < 8) src = 256 * pn + 64 * wc + 32 * bj;
                else if (pn == 8) { if (wc == 0) src = CKI + 32 * bj; else if (wc == 1) { if (bj == 0) { src = CWI; nv = 8; } else src = CDT; } else { src = 0; nv = 0; } }
                else if (pn < 17) src = CZ + (rg - 72) * 32; else src = CXBC + (rg - 136) * 32;
                tr_item(p.in[13], IN_DIM, src, nv, (bf16*)(ws + WS_WIN), 1024, rg * 32, kb * 64, scr, lane); continue; } r -= I_IN;
            if (r < I_G) { const int kb = r / 64, rg = r % 64; tr_item(p.in[13], IN_DIM, CGATE + rg * 32, 32, (bf16*)(ws + WS_WG), 1024, rg * 32, kb * 64, scr, lane); continue; } r -= I_G;
            if (r < I_BA) { const int kb = r / 32, rg = r % 32; tr_item(p.in[22], 1024, rg * 32, 32, (bf16*)(ws + WS_WBA), 1024, rg * 32, kb * 64, scr, lane); continue; } r -= I_BA;
            if (r < I_OUT) { const int kb = r / 32, rg = r % 32; tr_item(p.in[24], 1024, rg * 32, 32, (bf16*)(ws + WS_WOUT), 1024, rg * 32, kb * 64, scr, lane); continue; } r -= I_OUT;
            if (r < I_BS) { const int kb = r / 32, rg = r % 32; tr_item(p.in[23], 1024, rg * 32, 32, (bf16*)(ws + WS_WBS), 2048, rg * 32, kb * 64, scr, lane); continue; } r -= I_BS;
            if (r < I_GU) { const int kb = r / 176, rg = r % 176, pt = rg >> 3, w8 = rg & 7, half = w8 >> 2, r4 = w8 & 3;
                tr_item(p.in[25], 2 * DFF, half * DFF + 128 * pt + 32 * r4, 32, (bf16*)(ws + WS_WGU), 1024, rg * 32, kb * 64, scr, lane); continue; } r -= I_GU;
            { const int kb = r / 32, rg = r % 32; tr_item(p.in[26], 1024, rg * 32, 32, (bf16*)(ws + WS_WDN), DFF, rg * 32, kb * 64, scr, lane); }
        }
    }
    {
        const int gt = bx * 512 + tid, NGT = G * 512;
        const float* cki = p.in[4]; bf16* KIS = (bf16*)(p.out + O_SSMS) + (size_t)TT * 512 + (size_t)NBP * NKP * 64;
        for (int i = gt; i < 524288; i += NGT) { const size_t e = (size_t)i * 8; const int d = (int)(e & 63), s = (int)((e >> 6) & 2047), b = (int)(e >> 17);
            const f32x4 x0 = *(const f32x4*)(cki + e), x1 = *(const f32x4*)(cki + e + 4);
            v4u o; o.x = cvt_pk_bf16(x0[0], x0[1]); o.y = cvt_pk_bf16(x0[2], x0[3]); o.z = cvt_pk_bf16(x1[0], x1[1]); o.w = cvt_pk_bf16(x1[2], x1[3]);
            *(v4u*)(KIS + ((size_t)b * NKS + s) * 64 + d) = o; }
        float* rope = (float*)(ws + WS_ROPE);
        for (int i = gt; i < NKS * 32; i += NGT) { const int pos = i >> 5, j = i & 31;
            double invd = 1.0; for (int k = 0; k < j; ++k) invd *= 0.74989420933245582;
            const float inv = (float)invd; const float ang = (float)pos * inv;
            const double x = (double)ang; const double q = __builtin_rint(x * 0.63661977236758134); const double r = x - q * 1.5707963267948966; const double r2 = r * r;
            const double sn = r * (1.0 + r2 * (-1.0 / 6 + r2 * (1.0 / 120 + r2 * (-1.0 / 5040 + r2 * (1.0 / 362880 + r2 * (-1.0 / 39916800))))));
            const double cs = 1.0 + r2 * (-0.5 + r2 * (1.0 / 24 + r2 * (-1.0 / 720 + r2 * (1.0 / 40320 + r2 * (-1.0 / 3628800 + r2 * (1.0 / 479001600))))));
            const int iq = ((int)q) & 3; double so, co;
            if (iq == 0) { so = sn; co = cs; } else if (iq == 1) { so = cs; co = -sn; } else if (iq == 2) { so = -sn; co = -cs; } else { so = -cs; co = sn; }
            rope[i] = (float)co; rope[NKS * 32 + i] = (float)so; }
    }
}

template <bool FROM_PART>
__device__ __forceinline__ void normmod_phase(const Params& p, LAS unsigned char* lds, int tid, int lane, int wave, const float* xp, const float* xs, const float* g, int off_sh, int off_sc, bf16* H) {
    const int bx = blockIdx.x, G = gridDim.x;
    unsigned char* ws = p.ws;
    const float* part = (const float*)(ws + WS_PART); const float* b_ada = p.in[10]; float* MOD = (float*)(ws + WS_MOD);
    LAS float* lsh = (LAS float*)lds; LAS float* lsc = lsh + 1024;
    if (FROM_PART) {
        for (int it = bx; it < 240; it += G) { const int row = it / 6, seg = it % 6;
            for (int c = tid; c < 1024; c += 512) { float v = b_ada[seg * 1024 + c];
#pragma unroll
                for (int ks = 0; ks < 8; ++ks) v += part[((size_t)ks * 40 + row) * 6144 + seg * 1024 + c];
                MOD[row * 6144 + seg * 1024 + c] = v; } }
    }
    const int rows_per = (TT + G - 1) / G;
    const int r_lo = bx * rows_per, r_hi = (r_lo + rows_per < TT) ? r_lo + rows_per : TT;
    int r = r_lo;
    while (r < r_hi) {
        const int mrow = (r < TP) ? (r >> 11) : 8 + ((r - TP) >> 6);
        const int gend = (r < TP) ? ((r >> 11) + 1) << 11 : TP + ((((r - TP) >> 6) + 1) << 6);
        const int e = gend < r_hi ? gend : r_hi;
        __syncthreads();
        for (int c = tid; c < 1024; c += 512) {
            float vsh, vsc;
            if (FROM_PART) { vsh = b_ada[off_sh + c]; vsc = b_ada[off_sc + c];
#pragma unroll
                for (int ks = 0; ks < 8; ++ks) { vsh += part[((size_t)ks * 40 + mrow) * 6144 + off_sh + c]; vsc += part[((size_t)ks * 40 + mrow) * 6144 + off_sc + c]; } }
            else { vsh = MOD[mrow * 6144 + off_sh + c]; vsc = MOD[mrow * 6144 + off_sc + c]; }
            lsh[c] = vsh; lsc[c] = (1.f + vsc) * g[c];
        }
        __syncthreads();
        f32x4 vn[4];
        if (r + wave < e) { const int row0 = r + wave; const float* xr = (row0 < TP) ? xp + (size_t)row0 * DM : xs + (size_t)(row0 - TP) * DM;
#pragma unroll
            for (int j = 0; j < 4; ++j) vn[j] = *(const f32x4*)(xr + 4 * lane + 256 * j); }
        for (int row = r + wave; row < e; row += 8) {
            f32x4 v[4]; float s = 0.f;
#pragma unroll
            for (int j = 0; j < 4; ++j) { v[j] = vn[j]; s += (v[j][0] * v[j][0] + v[j][1] * v[j][1]) + (v[j][2] * v[j][2] + v[j][3] * v[j][3]); }
            if (row + 8 < e) { const int rn = row + 8; const float* xr = (rn < TP) ? xp + (size_t)rn * DM : xs + (size_t)(rn - TP) * DM;
#pragma unroll
                for (int j = 0; j < 4; ++j) vn[j] = *(const f32x4*)(xr + 4 * lane + 256 * j); }
            const float rstd = rsqrtf(wave_sum(s) * (1.f / DM) + EPS);
#pragma unroll
            for (int j = 0; j < 4; ++j) { const int c = 4 * lane + 256 * j; const f32x4 a = *(const LAS f32x4*)(lsc + c), b = *(const LAS f32x4*)(lsh + c);
                v2u o; o.x = cvt_pk_bf16(v[j][0] * rstd * a[0] + b[0], v[j][1] * rstd * a[1] + b[1]); o.y = cvt_pk_bf16(v[j][2] * rstd * a[2] + b[2], v[j][3] * rstd * a[3] + b[3]);
                *(v2u*)(H + (size_t)row * DM + c) = o; }
        }
        r = e;
    }
    __syncthreads();
}

#define EPI_ROWS_BEGIN \
    _Pragma("unroll") for (int ai = 0; ai < 2; ++ai) _Pragma("unroll") for (int m = 0; m < 4; ++m) { \
        const int row = u.pm * 256 + ai * 128 + wr * 64 + m * 16 + fr; float a[8], b[8]; \
        _Pragma("unroll") for (int e = 0; e < 4; ++e) { a[e] = acc[ai][0][m][0][e]; a[4 + e] = acc[ai][0][m][1][e]; b[e] = acc[ai][1][m][0][e]; b[4 + e] = acc[ai][1][m][1][e]; }
#define EPI_ROWS_END }

#define EPI_LOADROW(AI, M) { _Pragma("unroll") for (int e = 0; e < 4; ++e) { a[e] = acc[AI][0][M][0][e]; a[4 + e] = acc[AI][0][M][1][e]; b[e] = acc[AI][1][M][0][e]; b[4 + e] = acc[AI][1][M][1][e]; } }
#define EPI_ROWS_LOOP_BEGIN \
    _Pragma("unroll 1") for (int rr = 0; rr < 8; ++rr) { \
        const int row = u.pm * 256 + (rr >> 2) * 128 + wr * 64 + (rr & 3) * 16 + fr; float a[8], b[8]; \
        switch (rr) { case 0: EPI_LOADROW(0, 0) break; case 1: EPI_LOADROW(0, 1) break; case 2: EPI_LOADROW(0, 2) break; case 3: EPI_LOADROW(0, 3) break; \
                      case 4: EPI_LOADROW(1, 0) break; case 5: EPI_LOADROW(1, 1) break; case 6: EPI_LOADROW(1, 2) break; default: EPI_LOADROW(1, 3) break; }

struct EpiIn {
    static constexpr bool PERM = true, AFTER_DRAIN = false;
    bf16 *Q, *KP, *KS, *VTP, *VTS, *QI, *KIP, *KIS, *Z, *XBC; float *WI, *DT, *out; const float *gq, *gk, *dtb, *rope;
    __device__ __forceinline__ void operator()(const f32x4 (&acc)[2][2][4][2], const pg8::Unit& u, int wr, int wc, int fr, int fq) const {
        const int pn = u.pn;
        if (pn == 8 && wc >= 2) return;
        EPI_ROWS_LOOP_BEGIN
            const bool isS = row >= TP; int sb, t, pos;
            if (!isS) { sb = row >> 11; t = row & 2047; pos = t; } else { const int s = row - TP; sb = s >> 6; t = s & 63; pos = PAST + t; }
            if (pn >= 17) {
                const int col = 256 * (pn - 17) + 32 * wc + 8 * fq;
                *(v4u*)(XBC + (size_t)row * CONVC + col) = pack8(a); *(v4u*)(XBC + (size_t)row * CONVC + col + 128) = pack8(b);
                const int L = isS ? DSEQ : SEQ;
                if (t >= L - 3) { float* o = out + (isS ? O_CONVS : O_CONVP) + (size_t)(sb * 3 + (t - (L - 3))) * CONVC + col;
                    *(f32x4*)(o) = (f32x4){a[0], a[1], a[2], a[3]}; *(f32x4*)(o + 4) = (f32x4){a[4], a[5], a[6], a[7]};
                    *(f32x4*)(o + 128) = (f32x4){b[0], b[1], b[2], b[3]}; *(f32x4*)(o + 132) = (f32x4){b[4], b[5], b[6], b[7]}; }
            } else if (pn >= 9) {
                const int col = 256 * (pn - 9) + 32 * wc + 8 * fq;
#pragma unroll
                for (int e = 0; e < 8; ++e) { a[e] = silu_f(a[e]); b[e] = silu_f(b[e]); }
                *(v4u*)(Z + (size_t)row * DINNER + col) = pack8(a); *(v4u*)(Z + (size_t)row * DINNER + col + 128) = pack8(b);
            } else if (pn == 8 && wc == 1) {
                if (fq == 0) { float* w = WI + (size_t)row * 8; const float sc = 0.35355339059327373f * 0.125f;
                    *(f32x4*)w = (f32x4){a[0] * sc, a[1] * sc, a[2] * sc, a[3] * sc}; *(f32x4*)(w + 4) = (f32x4){a[4] * sc, a[5] * sc, a[6] * sc, a[7] * sc}; }
                float d[8];
#pragma unroll
                for (int e = 0; e < 8; ++e) { const float x = b[e] + dtb[8 * fq + e]; d[e] = x > 20.f ? x : log1pf(__expf(x)); }
                float* o = DT + (size_t)row * 32 + 8 * fq; *(f32x4*)o = (f32x4){d[0], d[1], d[2], d[3]}; *(f32x4*)(o + 4) = (f32x4){d[4], d[5], d[6], d[7]};
            } else if (pn == 5) {
                float* o = out + (isS ? O_VS + ((size_t)(row - TP) * 4 + wc) * 64 : O_VP + ((size_t)row * 4 + wc) * 64) + 8 * fq;
                *(f32x4*)(o) = (f32x4){a[0], a[1], a[2], a[3]}; *(f32x4*)(o + 4) = (f32x4){a[4], a[5], a[6], a[7]};
                *(f32x4*)(o + 32) = (f32x4){b[0], b[1], b[2], b[3]}; *(f32x4*)(o + 36) = (f32x4){b[4], b[5], b[6], b[7]};
                bf16* vb = (isS ? VTS + ((size_t)(sb * 4 + wc) * DSEQ + t) * 64 : VTP + ((size_t)(sb * 4 + wc) * NKP + t) * 64) + 8 * fq;
                *(v4u*)vb = pack8(a); *(v4u*)(vb + 32) = pack8(b);
            } else {
                if (pn <= 4) { float ss = 0.f;
#pragma unroll
                    for (int e = 0; e < 8; ++e) ss += a[e] * a[e] + b[e] * b[e];
                    ss += __shfl_xor(ss, 16); ss += __shfl_xor(ss, 32);
                    const float rstd = rsqrtf(ss * (1.f / 64.f) + EPS); const float* g = (pn < 4) ? gq : gk;
#pragma unroll
                    for (int e = 0; e < 8; ++e) { a[e] *= rstd * g[8 * fq + e]; b[e] *= rstd * g[32 + 8 * fq + e]; } }
                { const float* cp = rope + (size_t)pos * 32 + 8 * fq; const float* sp = cp + NKS * 32;
#pragma unroll
                  for (int e = 0; e < 8; ++e) { const float c = cp[e], s = sp[e], x1 = a[e], x2 = b[e]; a[e] = x1 * c - x2 * s; b[e] = x2 * c + x1 * s; } }
                if (pn < 4) { const float qs = 0.125f * 1.4426950408889634f;
#pragma unroll
                    for (int e = 0; e < 8; ++e) { a[e] *= qs; b[e] *= qs; }
                    bf16* q = Q + (size_t)row * DM + (4 * pn + wc) * 64 + 8 * fq; *(v4u*)q = pack8(a); *(v4u*)(q + 32) = pack8(b); }
                else if (pn == 4) {
                    float* o = out + (isS ? O_KS + ((size_t)(row - TP) * 4 + wc) * 64 : O_KP + ((size_t)row * 4 + wc) * 64) + 8 * fq;
                    *(f32x4*)(o) = (f32x4){a[0], a[1], a[2], a[3]}; *(f32x4*)(o + 4) = (f32x4){a[4], a[5], a[6], a[7]};
                    *(f32x4*)(o + 32) = (f32x4){b[0], b[1], b[2], b[3]}; *(f32x4*)(o + 36) = (f32x4){b[4], b[5], b[6], b[7]};
                    bf16* kb = (isS ? KS + ((size_t)(sb * 4 + wc) * DSEQ + t) * 64 : KP + ((size_t)(sb * 4 + wc) * NKP + t) * 64) + 8 * fq;
                    *(v4u*)kb = pack8(a); *(v4u*)(kb + 32) = pack8(b);
                } else if (pn < 8) { bf16* q = QI + (size_t)row * 512 + (4 * (pn - 6) + wc) * 64 + 8 * fq; *(v4u*)q = pack8(a); *(v4u*)(q + 32) = pack8(b); }
                else {
                    float* o = out + (isS ? O_KIS + (size_t)(row - TP) * 64 : O_KIP + (size_t)row * 64) + 8 * fq;
                    *(f32x4*)(o) = (f32x4){a[0], a[1], a[2], a[3]}; *(f32x4*)(o + 4) = (f32x4){a[4], a[5], a[6], a[7]};
                    *(f32x4*)(o + 32) = (f32x4){b[0], b[1], b[2], b[3]}; *(f32x4*)(o + 36) = (f32x4){b[4], b[5], b[6], b[7]};
                    bf16* kb = (isS ? KIS + ((size_t)sb * NKS + pos) * 64 : KIP + (size_t)row * 64) + 8 * fq;
                    *(v4u*)kb = pack8(a); *(v4u*)(kb + 32) = pack8(b);
                }
            }
        EPI_ROWS_END
    }
};

__device__ __forceinline__ void unpack8(const v4u w, float* f) {
    f[0] = __uint_as_float(w.x << 16); f[1] = __uint_as_float(w.x & 0xffff0000u); f[2] = __uint_as_float(w.y << 16); f[3] = __uint_as_float(w.y & 0xffff0000u);
    f[4] = __uint_as_float(w.z << 16); f[5] = __uint_as_float(w.z & 0xffff0000u); f[6] = __uint_as_float(w.w << 16); f[7] = __uint_as_float(w.w & 0xffff0000u);
}
__device__ __forceinline__ int mod_row(int row) { return (row < TP) ? (row >> 11) : 8 + ((row - TP) >> 6); }

struct EpiGates {
    static constexpr bool PERM = true, AFTER_DRAIN = false; bf16* G;
    __device__ __forceinline__ void operator()(const f32x4 (&acc)[2][2][4][2], const pg8::Unit& u, int wr, int wc, int fr, int fq) const {
        EPI_ROWS_BEGIN
            const int col = 256 * u.pn + 32 * wc + 8 * fq;
#pragma unroll
            for (int e = 0; e < 8; ++e) { a[e] = sigmoid_f(a[e]); b[e] = sigmoid_f(b[e]); }
            *(v4u*)(G + (size_t)row * 2048 + col) = pack8(a); *(v4u*)(G + (size_t)row * 2048 + col + 128) = pack8(b);
        EPI_ROWS_END
    }
};
struct EpiP1 {
    static constexpr bool PERM = true, AFTER_DRAIN = false; const bf16* G; bf16* P1;
    __device__ __forceinline__ void operator()(const f32x4 (&acc)[2][2][4][2], const pg8::Unit& u, int wr, int wc, int fr, int fq) const {
        EPI_ROWS_BEGIN
            const int col = 256 * u.pn + 32 * wc + 8 * fq;
            *(v4u*)(P1 + (size_t)row * DM + col) = pack8(a); *(v4u*)(P1 + (size_t)row * DM + col + 128) = pack8(b);
        EPI_ROWS_END
    }
};
struct EpiMixed {
    static constexpr bool PERM = true, AFTER_DRAIN = false; const bf16* G; const bf16* P1; bf16* MX;
    __device__ __forceinline__ void operator()(const f32x4 (&acc)[2][2][4][2], const pg8::Unit& u, int wr, int wc, int fr, int fq) const {
        EPI_ROWS_BEGIN
            const int col = 256 * u.pn + 32 * wc + 8 * fq; float g0[8], g1[8], p0[8], p1[8], h0[8], h1[8];
            unpack8(*(const v4u*)(G + (size_t)row * 2048 + 1024 + col), g0); unpack8(*(const v4u*)(G + (size_t)row * 2048 + 1024 + col + 128), g1);
            unpack8(*(const v4u*)(G + (size_t)row * 2048 + col), h0); unpack8(*(const v4u*)(G + (size_t)row * 2048 + col + 128), h1);
            unpack8(*(const v4u*)(P1 + (size_t)row * DM + col), p0); unpack8(*(const v4u*)(P1 + (size_t)row * DM + col + 128), p1);
#pragma unroll
            for (int e = 0; e < 8; ++e) { a[e] = p0[e] * h0[e] + a[e] * g0[e]; b[e] = p1[e] * h1[e] + b[e] * g1[e]; }
            *(v4u*)(MX + (size_t)row * DM + col) = pack8(a); *(v4u*)(MX + (size_t)row * DM + col + 128) = pack8(b);
        EPI_ROWS_END
    }
};
struct EpiRes {
    static constexpr bool PERM = true, AFTER_DRAIN = false; const float* xp; const float* xs; const float* MOD; int moff; float* out;
    __device__ __forceinline__ void operator()(const f32x4 (&acc)[2][2][4][2], const pg8::Unit& u, int wr, int wc, int fr, int fq) const {
        EPI_ROWS_BEGIN
            const int col = 256 * u.pn + 32 * wc + 8 * fq;
            const float* xr = ((row < TP) ? xp + (size_t)row * DM : xs + (size_t)(row - TP) * DM) + col;
            const float* mr = MOD + (size_t)mod_row(row) * 6144 + moff + col; float* o = out + (size_t)row * DM + col;
#pragma unroll
            for (int hh = 0; hh < 2; ++hh) { const float* v = hh ? b : a;
#pragma unroll
                for (int q = 0; q < 2; ++q) { const f32x4 x = *(const f32x4*)(xr + 128 * hh + 4 * q), g = *(const f32x4*)(mr + 128 * hh + 4 * q);
                    *(f32x4*)(o + 128 * hh + 4 * q) = (f32x4){x[0] + g[0] * v[4 * q], x[1] + g[1] * v[4 * q + 1], x[2] + g[2] * v[4 * q + 2], x[3] + g[3] * v[4 * q + 3]}; } }
        EPI_ROWS_END
    }
};
struct EpiResAdd {
    static constexpr bool PERM = true, AFTER_DRAIN = false; const float* MOD; int moff; float* out;
    __device__ __forceinline__ void operator()(const f32x4 (&acc)[2][2][4][2], const pg8::Unit& u, int wr, int wc, int fr, int fq) const {
        EPI_ROWS_BEGIN
            const int col = 256 * (u.pn & 3) + 32 * wc + 8 * fq;
            const float* mr = MOD + (size_t)mod_row(row) * 6144 + moff + col; float* o = out + (size_t)row * DM + col;
#pragma unroll
            for (int e = 0; e < 8; ++e) { unsafeAtomicAdd(o + e, mr[e] * a[e]); unsafeAtomicAdd(o + 128 + e, mr[128 + e] * b[e]); }
        EPI_ROWS_END
    }
};
struct EpiAct {
    static constexpr bool PERM = true, AFTER_DRAIN = false; bf16* ACT;
    __device__ __forceinline__ void operator()(const f32x4 (&acc)[2][2][4][2], const pg8::Unit& u, int wr, int wc, int fr, int fq) const {
        EPI_ROWS_BEGIN
            const int col = 128 * u.pn + 32 * wc + 8 * fq;
#pragma unroll
            for (int e = 0; e < 8; ++e) a[e] = silu_f(a[e]) * b[e];
            *(v4u*)(ACT + (size_t)row * DFF + col) = pack8(a);
        EPI_ROWS_END
    }
};

__device__ __forceinline__ void ynorm_phase(const Params& p, int lane, int wave, bf16* Y, const float* SSQ) {
    const float* gn = p.in[21];
    const int gw = blockIdx.x * 8 + wave, NGW = gridDim.x * 8;
    v4u yn[4]; f32x4 sn[4];
    if (gw < TT) {
#pragma unroll
        for (int j = 0; j < 4; ++j) { const int c = 8 * lane + 512 * j; yn[j] = *(const v4u*)(Y + (size_t)gw * DINNER + c); sn[j] = *(const f32x4*)(SSQ + (size_t)gw * 32 + 4 * (c >> 8)); } }
    for (int row = gw; row < TT; row += NGW) {
        v4u yc[4]; f32x4 sc4[4];
#pragma unroll
        for (int j = 0; j < 4; ++j) { yc[j] = yn[j]; sc4[j] = sn[j]; }
        if (row + NGW < TT) { const int rn = row + NGW;
#pragma unroll
            for (int j = 0; j < 4; ++j) { const int c = 8 * lane + 512 * j; yn[j] = *(const v4u*)(Y + (size_t)rn * DINNER + c); sn[j] = *(const f32x4*)(SSQ + (size_t)rn * 32 + 4 * (c >> 8)); } }
#pragma unroll
        for (int j = 0; j < 4; ++j) { const int c = 8 * lane + 512 * j;
            const f32x4 sq = sc4[j];
            const float rstd = rsqrtf(((sq[0] + sq[1]) + (sq[2] + sq[3])) * (1.f / 256.f) + EPS);
            float y[8]; unpack8(yc[j], y);
            const f32x4 g0 = *(const f32x4*)(gn + c), g1 = *(const f32x4*)(gn + c + 4);
            y[0] *= rstd * g0[0]; y[1] *= rstd * g0[1]; y[2] *= rstd * g0[2]; y[3] *= rstd * g0[3]; y[4] *= rstd * g1[0]; y[5] *= rstd * g1[1]; y[6] *= rstd * g1[2]; y[7] *= rstd * g1[3];
            *(v4u*)(Y + (size_t)row * DINNER + c) = pack8(y); }
    }
}

__device__ __forceinline__ void conv_stream(bf16* base, float (&h0)[8], float (&h1)[8], float (&h2)[8], const float* wconv, const float* bconv, int col) {
    float w[4][8], bias[8];
#pragma unroll
    for (int j = 0; j < 4; ++j) { const f32x4 w0 = *(const f32x4*)(wconv + j * CONVC + col), w1 = *(const f32x4*)(wconv + j * CONVC + col + 4);
        w[j][0] = w0[0]; w[j][1] = w0[1]; w[j][2] = w0[2]; w[j][3] = w0[3]; w[j][4] = w1[0]; w[j][5] = w1[1]; w[j][6] = w1[2]; w[j][7] = w1[3]; }
    { const f32x4 b0 = *(const f32x4*)(bconv + col), b1 = *(const f32x4*)(bconv + col + 4);
      bias[0] = b0[0]; bias[1] = b0[1]; bias[2] = b0[2]; bias[3] = b0[3]; bias[4] = b1[0]; bias[5] = b1[1]; bias[6] = b1[2]; bias[7] = b1[3]; }
    for (int r0 = 0; r0 < 64; r0 += 16) {
        v4u raw[16];
#pragma unroll
        for (int k = 0; k < 16; ++k) raw[k] = *(const v4u*)(base + (size_t)(r0 + k) * CONVC);
#pragma unroll
        for (int k = 0; k < 16; ++k) { float x[8], o[8]; unpack8(raw[k], x);
#pragma unroll
            for (int e = 0; e < 8; ++e) { o[e] = silu_f(bias[e] + w[0][e] * h0[e] + w[1][e] * h1[e] + w[2][e] * h2[e] + w[3][e] * x[e]); h0[e] = h1[e]; h1[e] = h2[e]; h2[e] = x[e]; }
            *(v4u*)(base + (size_t)(r0 + k) * CONVC) = pack8(o); }
    }
}
__device__ __forceinline__ void conv_phase(const Params& p, int tid, bf16* XBC) {
    const float* wconv = p.in[16]; const float* bconv = p.in[17];
    const int G = gridDim.x, bx = blockIdx.x;
    for (int it = bx; it < 256; it += G) {
        const int b = it >> 5, cb = it & 31, cg = tid & 15, run = tid >> 4, col = cb * 128 + cg * 8;
        bf16* base = XBC + (size_t)(b * SEQ + run * 64) * CONVC + col;
        float h0[8], h1[8], h2[8];
        if (run > 0) { unpack8(*(const v4u*)(base - 3 * CONVC), h0); unpack8(*(const v4u*)(base - 2 * CONVC), h1); unpack8(*(const v4u*)(base - CONVC), h2); }
        else {
#pragma unroll
            for (int e = 0; e < 8; ++e) { h0[e] = 0.f; h1[e] = 0.f; h2[e] = 0.f; } }
        __syncthreads();
        conv_stream(base, h0, h1, h2, wconv, bconv, col);
        __syncthreads();
    }
    for (int i = bx * 512 + tid; i < NBS * 512; i += G * 512) {
        const int b = i >> 9, col = (i & 511) * 8;
        bf16* base = XBC + (size_t)(TP + b * DSEQ) * CONVC + col;
        const float* sp = p.in[5] + (size_t)b * 3 * CONVC + col;
        float h0[8], h1[8], h2[8];
#pragma unroll
        for (int e = 0; e < 8; ++e) { h0[e] = sp[e]; h1[e] = sp[CONVC + e]; h2[e] = sp[2 * CONVC + e]; }
        conv_stream(base, h0, h1, h2, wconv, bconv, col);
    }
}

#define MFMA32(a, b, c) __builtin_amdgcn_mfma_f32_32x32x16_bf16((a), (b), (c), 0, 0, 0)
typedef short s16x4 __attribute__((ext_vector_type(4)));
#ifndef TR_SLOW
#define TR_SLOW 0
#endif
__device__ __forceinline__ bf16x8 tr_frag(const LAS bf16* tile, int pitch, int ra, int rb, int col, int lane) {
#if TR_SLOW
    bf16x8 r;
#pragma unroll
    for (int e = 0; e < 4; ++e) { r[e] = (short)tile[(ra + e) * pitch + col]; r[4 + e] = (short)tile[(rb + e) * pitch + col]; }
    return r;
#else
    const int tq = (lane & 15) >> 2, tp = lane & 3, cb = (col & ~15) + 4 * tp;
    const s16x4 lo = __builtin_amdgcn_ds_read_tr16_b64_v4i16((LAS s16x4*)(tile + (ra + tq) * pitch + cb)), hi = __builtin_amdgcn_ds_read_tr16_b64_v4i16((LAS s16x4*)(tile + (rb + tq) * pitch + cb));
    return (bf16x8){lo[0], lo[1], lo[2], lo[3], hi[0], hi[1], hi[2], hi[3]};
#endif
}
constexpr int SS_TILE = 44032, SS_XN = 0, SS_BN = 9216, SS_CN = 26624, SS_HS = 88064, SS_HSZ = 17408, SS_ACS = 122880, SS_SQ = 126976;
__device__ __forceinline__ void ssd_unit(const Params& p, LAS unsigned char* lds, int tid, int lane, int wave, bool isS, int b, int h,
                                         const bf16* XBC, const float* DT, bf16* Y, float* SSQ) {
    const int g = h >> 2, nch = isS ? 1 : 32, tok0 = isS ? TP + b * DSEQ : b * SEQ;
    const float a_h = -__expf(p.in[19][h]), d_h = p.in[20][h];
    LAS float* acs = (LAS float*)(lds + SS_ACS + wave * 512); LAS float* dtv = acs + 64;
    const int l32 = lane & 31, hf = lane >> 5, blk = (lane >> 4) & 1, tq = (lane & 15) >> 2, tp = lane & 3;
    const bool ywave = wave < 4; const int w4 = wave & 3;
    f32x16 hs0, hs1;
    float* sout = p.out + (isS ? O_SSMS : O_SSMP) + ((size_t)(b * 32 + h) * 64) * 128;
#pragma unroll
    for (int i = 0; i < 16; ++i) { hs0[i] = 0.f; hs1[i] = 0.f; }
    if (isS && !ywave) { const float* s0 = p.in[6] + ((size_t)(b * 32 + h) * 64) * 128;
#pragma unroll
        for (int i = 0; i < 16; ++i) { const int pr = 8 * (i >> 2) + 4 * hf + (i & 3); hs0[i] = s0[(size_t)pr * 128 + 32 * w4 + l32]; hs1[i] = s0[(size_t)(32 + pr) * 128 + 32 * w4 + l32]; } }
    int soff[5]; int goff[5];
#pragma unroll
    for (int k = 0; k < 5; ++k) { const int pc = tid + 512 * k;
        if (pc < 512) { const int r = pc >> 3, s8 = pc & 7; soff[k] = SS_XN + (r * 72 + 8 * s8) * 2; goff[k] = r * CONVC + h * 64 + 8 * s8; }
        else if (pc < 1536) { const int q = pc - 512, r = q >> 4, s8 = q & 15; soff[k] = SS_BN + (r * 136 + 8 * s8) * 2; goff[k] = r * CONVC + 2048 + g * 128 + 8 * s8; }
        else { const int q = pc - 1536, r = q >> 4, s8 = q & 15; soff[k] = SS_CN + (r * 136 + 8 * s8) * 2; goff[k] = r * CONVC + 3072 + g * 128 + 8 * s8; } }
    v4u stg[5]; float dtn; v2u zn[4];
    const int pt = wave >> 1, it = wave & 1, irow = 32 * it + l32;
#pragma unroll
    for (int k = 0; k < 5; ++k) stg[k] = *(const v4u*)(XBC + (size_t)tok0 * CONVC + goff[k]);
    dtn = DT[(size_t)(tok0 + lane) * 32 + h];
    if (ywave) {
#pragma unroll
        for (int q = 0; q < 4; ++q) zn[q] = *(const v2u*)(Y + (size_t)(tok0 + irow) * DINNER + h * 64 + 32 * pt + 8 * q + 4 * hf); }
#pragma unroll
    for (int k = 0; k < 5; ++k) *(LAS v4u*)(lds + soff[k]) = stg[k];
    if (!ywave) { LAS bf16* Hs = (LAS bf16*)(lds + SS_HS);
#pragma unroll
        for (int i = 0; i < 16; ++i) { const int pr = 8 * (i >> 2) + 4 * hf + (i & 3);
            Hs[pr * 136 + 32 * w4 + l32] = (bf16)(cvt_pk_bf16(hs0[i], 0.f) & 0xffffu); Hs[(32 + pr) * 136 + 32 * w4 + l32] = (bf16)(cvt_pk_bf16(hs1[i], 0.f) & 0xffffu); } }
    __syncthreads();
    for (int c = 0; c < nch; ++c) {
        const int tokc = tok0 + 64 * c, buf = c & 1;
        LAS unsigned char* tb = lds + buf * SS_TILE;
        const LAS bf16* Xn = (const LAS bf16*)(tb + SS_XN); const LAS bf16* Bn = (const LAS bf16*)(tb + SS_BN); const LAS bf16* Cn = (const LAS bf16*)(tb + SS_CN);
        const LAS bf16* Hs = (const LAS bf16*)(lds + SS_HS + buf * SS_HSZ);
        const float dtc = dtn; float av = dtc * a_h;
        av += __int_as_float(__builtin_amdgcn_update_dpp(0, __float_as_int(av), 0x111, 0xf, 0xf, true));
        av += __int_as_float(__builtin_amdgcn_update_dpp(0, __float_as_int(av), 0x112, 0xf, 0xf, true));
        av += __int_as_float(__builtin_amdgcn_update_dpp(0, __float_as_int(av), 0x114, 0xf, 0xf, true));
        av += __int_as_float(__builtin_amdgcn_update_dpp(0, __float_as_int(av), 0x118, 0xf, 0xf, true));
        { const float t0 = __int_as_float(__builtin_amdgcn_readlane(__float_as_int(av), 15)), t1 = __int_as_float(__builtin_amdgcn_readlane(__float_as_int(av), 31)), t2 = __int_as_float(__builtin_amdgcn_readlane(__float_as_int(av), 47));
          const int rw = lane >> 4; av += (rw == 1) ? t0 : (rw == 2) ? (t0 + t1) : (rw == 3) ? ((t0 + t1) + t2) : 0.f; }
        acs[lane] = av; dtv[lane] = dtc;
        const v2u zc0 = zn[0], zc1 = zn[1], zc2 = zn[2], zc3 = zn[3];
        const bool more = (c + 1 < nch);
        if (more) {
#pragma unroll
            for (int k = 0; k < 5; ++k) stg[k] = *(const v4u*)(XBC + (size_t)(tokc + 64) * CONVC + goff[k]);
            dtn = DT[(size_t)(tokc + 64 + lane) * 32 + h];
            if (ywave) {
#pragma unroll
                for (int q = 0; q < 4; ++q) zn[q] = *(const v2u*)(Y + (size_t)(tokc + 64 + irow) * DINNER + h * 64 + 32 * pt + 8 * q + 4 * hf); }
        }
        if (ywave) {
            const int prow = 32 * pt + l32;
            f32x16 yo;
#pragma unroll
            for (int i = 0; i < 16; ++i) yo[i] = 0.f;
#pragma unroll
            for (int ks = 0; ks < 8; ++ks) { const bf16x8 av8 = *(const LAS bf16x8*)(Hs + prow * 136 + 16 * ks + 8 * hf), bv8 = *(const LAS bf16x8*)(Cn + irow * 136 + 16 * ks + 8 * hf); yo = MFMA32(av8, bv8, yo); }
            const float ai = acs[irow]; const float ei = __expf(ai);
#pragma unroll
            for (int i = 0; i < 16; ++i) yo[i] *= ei;
            for (int jt = 0; jt <= it; ++jt) {
                f32x16 s;
#pragma unroll
                for (int i = 0; i < 16; ++i) s[i] = 0.f;
#pragma unroll
                for (int ks = 0; ks < 8; ++ks) { const bf16x8 av8 = *(const LAS bf16x8*)(Bn + (32 * jt + l32) * 136 + 16 * ks + 8 * hf), bv8 = *(const LAS bf16x8*)(Cn + irow * 136 + 16 * ks + 8 * hf); s = MFMA32(av8, bv8, s); }
                float mv[16];
#pragma unroll
                for (int i = 0; i < 16; ++i) { const int j = 32 * jt + 8 * (i >> 2) + 4 * hf + (i & 3); mv[i] = (j <= irow) ? s[i] * __expf(ai - acs[j]) * dtv[j] : 0.f; }
#pragma unroll
                for (int jj = 0; jj < 2; ++jj) {
                    const v4u pk = pack8(mv + 8 * jj); bf16x8 bv8; __builtin_memcpy(&bv8, &pk, 16);
                    const int ja = 32 * jt + 16 * jj + 4 * hf;
                    const bf16x8 av8 = tr_frag(Xn, 72, ja, ja + 8, 32 * pt + l32, lane);
                    yo = MFMA32(av8, bv8, yo);
                }
            }
            float sq = 0.f; bf16* zp = Y + (size_t)(tokc + irow) * DINNER + h * 64 + 32 * pt + 4 * hf;
#pragma unroll
            for (int q = 0; q < 4; ++q) { const int p4 = 32 * pt + 8 * q + 4 * hf;
                const v2u xr = *(const LAS v2u*)(Xn + irow * 72 + p4); const v2u zr = (q == 0) ? zc0 : (q == 1) ? zc1 : (q == 2) ? zc2 : zc3;
                const float x0 = bf2f(xr.x & 0xffffu), x1 = __uint_as_float(xr.x & 0xffff0000u), x2 = bf2f(xr.y & 0xffffu), x3 = __uint_as_float(xr.y & 0xffff0000u);
                const float z0 = bf2f(zr.x & 0xffffu), z1 = __uint_as_float(zr.x & 0xffff0000u), z2 = bf2f(zr.y & 0xffffu), z3 = __uint_as_float(zr.y & 0xffff0000u);
                const float y0 = (yo[4 * q] + d_h * x0) * z0, y1 = (yo[4 * q + 1] + d_h * x1) * z1, y2 = (yo[4 * q + 2] + d_h * x2) * z2, y3 = (yo[4 * q + 3] + d_h * x3) * z3;
                sq += (y0 * y0 + y1 * y1) + (y2 * y2 + y3 * y3);
                v2u o; o.x = cvt_pk_bf16(y0, y1); o.y = cvt_pk_bf16(y2, y3); *(v2u*)(zp + 8 * q) = o; }
            ((LAS float*)(lds + SS_SQ))[buf * 256 + (pt * 2 + hf) * 64 + irow] = sq;
        } else {
            const float a63 = acs[63]; const float dec = __expf(a63);
#pragma unroll
            for (int i = 0; i < 16; ++i) { hs0[i] *= dec; hs1[i] *= dec; }
#pragma unroll
            for (int ks = 0; ks < 4; ++ks) {
                const int j0 = 16 * ks + 8 * hf;
                const bf16x8 bv8 = tr_frag(Bn, 136, j0, j0 + 4, 32 * w4 + l32, lane);
                float wj[8];
#pragma unroll
                for (int e = 0; e < 8; ++e) wj[e] = __expf(a63 - acs[j0 + e]) * dtv[j0 + e];
#pragma unroll
                for (int ptt = 0; ptt < 2; ++ptt) {
                    const bf16x8 xr = tr_frag(Xn, 72, j0, j0 + 4, 32 * ptt + l32, lane);
                    v4u xu; __builtin_memcpy(&xu, &xr, 16); float xf[8]; unpack8(xu, xf);
#pragma unroll
                    for (int e = 0; e < 8; ++e) xf[e] *= wj[e];
                    const v4u xp = pack8(xf); bf16x8 av8; __builtin_memcpy(&av8, &xp, 16);
                    if (ptt == 0) hs0 = MFMA32(av8, bv8, hs0); else hs1 = MFMA32(av8, bv8, hs1);
                }
            }
            if (more) { LAS bf16* Hn = (LAS bf16*)(lds + SS_HS + (buf ^ 1) * SS_HSZ);
#pragma unroll
                for (int i = 0; i < 16; ++i) { const int pr = 8 * (i >> 2) + 4 * hf + (i & 3);
                    Hn[pr * 136 + 32 * w4 + l32] = (bf16)(cvt_pk_bf16(hs0[i], 0.f) & 0xffffu); Hn[(32 + pr) * 136 + 32 * w4 + l32] = (bf16)(cvt_pk_bf16(hs1[i], 0.f) & 0xffffu); } }
        }
        if (more) {
#pragma unroll
            for (int k = 0; k < 5; ++k) *(LAS v4u*)(lds + (buf ^ 1) * SS_TILE + soff[k]) = stg[k]; }
        __syncthreads();
        if (tid < 64) { const LAS float* sq = (const LAS float*)(lds + SS_SQ) + buf * 256; SSQ[(size_t)(tokc + tid) * 32 + h] = (sq[tid] + sq[64 + tid]) + (sq[128 + tid] + sq[192 + tid]); }
    }
    if (!ywave) {
#pragma unroll
        for (int i = 0; i < 16; ++i) { const int pr = 8 * (i >> 2) + 4 * hf + (i & 3); sout[(size_t)pr * 128 + 32 * w4 + l32] = hs0[i]; sout[(size_t)(32 + pr) * 128 + 32 * w4 + l32] = hs1[i]; } }
    __syncthreads();
}

constexpr int SCW = 2116;
__device__ __forceinline__ unsigned sortable(float x) { x += 0.0f; const unsigned b = __float_as_uint(x); return (b & 0x80000000u) ? ~b : (b | 0x80000000u); }
__device__ __forceinline__ void topk_unit(LAS unsigned char* lds, int tid, int lane, int wave, bool isS, int b, int qb,
                                          const bf16* QI, const bf16* KIP, const bf16* KIS, const float* WI, unsigned* MASK) {
    const int tok0 = isS ? TP + b * DSEQ + qb * 16 : b * SEQ + qb * 16;
    const int pos0 = (isS ? PAST : 0) + qb * 16, limit = ((pos0 >> 6) + 1) << 6, nslots = limit >> 6, ntile = limit >> 4;
    const bf16* KI = isS ? KIS + (size_t)b * NKS * 64 : KIP + (size_t)b * NKP * 64;
    LAS float* sc = (LAS float*)lds;
    const int l16 = lane & 15, kg = lane >> 4;
    if (limit > 256) {
        bf16x8 qf[8][2]; float wq[8];
#pragma unroll
        for (int hd = 0; hd < 8; ++hd) {
#pragma unroll
            for (int ks = 0; ks < 2; ++ks) qf[hd][ks] = *(const bf16x8*)(QI + (size_t)(tok0 + l16) * 512 + hd * 64 + 32 * ks + 8 * kg);
            wq[hd] = WI[(size_t)(tok0 + l16) * 8 + hd]; }
        for (int kt = wave; kt < ntile; kt += 8) {
            const bf16x8 a0 = *(const bf16x8*)(KI + (size_t)(16 * kt + l16) * 64 + 8 * kg), a1 = *(const bf16x8*)(KI + (size_t)(16 * kt + l16) * 64 + 32 + 8 * kg);
            f32x4 s = (f32x4){0.f, 0.f, 0.f, 0.f};
#pragma unroll
            for (int hd = 0; hd < 8; ++hd) { f32x4 c = (f32x4){0.f, 0.f, 0.f, 0.f};
                c = __builtin_amdgcn_mfma_f32_16x16x32_bf16(a0, qf[hd][0], c, 0, 0, 0); c = __builtin_amdgcn_mfma_f32_16x16x32_bf16(a1, qf[hd][1], c, 0, 0, 0);
#pragma unroll
                for (int i = 0; i < 4; ++i) s[i] += wq[hd] * fmaxf(c[i], 0.f); }
            *(LAS f32x4*)(sc + l16 * SCW + 16 * kt + 4 * kg) = s;
        }
    }
    __syncthreads();
    for (int qq = 0; qq < 2; ++qq) {
        const int q = 2 * wave + qq; unsigned* mrow = MASK + (size_t)(tok0 + q) * MASKW;
        if (limit <= 256) {
            if (lane < 33) { const unsigned v = (lane < nslots) ? 0xffffffffu : 0u; mrow[2 * lane] = v; mrow[2 * lane + 1] = v; }
            continue;
        }
        unsigned u[33];
#pragma unroll
        for (int j = 0; j < 33; ++j) u[j] = (j < nslots) ? sortable(sc[q * SCW + 64 * j + lane]) : 0u;
        const int ng = (nslots + 10) / 11;
#define CNT_GE(dst, val) do { int _c = 0; \
            _Pragma("unroll") for (int j = 0; j < 11; ++j) _c += __popcll(__ballot(u[j] >= (val))); \
            if (ng > 1) { _Pragma("unroll") for (int j = 11; j < 22; ++j) _c += __popcll(__ballot(u[j] >= (val))); } \
            if (ng > 2) { _Pragma("unroll") for (int j = 22; j < 33; ++j) _c += __popcll(__ballot(u[j] >= (val))); } \
            dst = _c; } while (0)
        unsigned thr = 0u; bool exact = false;
        for (int bit = 31; bit >= 0; --bit) { const unsigned cand = thr | (1u << bit); int cnt; CNT_GE(cnt, cand);
            if (cnt >= 256) thr = cand;
            if (cnt == 256) { exact = true; break; } }
        int rem = 0;
        if (!exact) { int cgt; CNT_GE(cgt, thr + 1u); rem = 256 - cgt; }
#pragma unroll
        for (int j = 0; j < 33; ++j) {
            unsigned long long wv;
            if (exact) wv = __ballot(u[j] >= thr);
            else { const unsigned long long gt = __ballot(u[j] > thr); unsigned long long eq = __ballot(u[j] == thr), sel = 0ull;
                const int pe = __popcll(eq);
                if (pe <= rem) { sel = eq; rem -= pe; }
                else { while (rem > 0) { const unsigned long long low = eq & (0ull - eq); sel |= low; eq ^= low; --rem; } }
                wv = gt | sel; }
            if (lane == 0) { mrow[2 * j] = (unsigned)wv; mrow[2 * j + 1] = (unsigned)(wv >> 32); }
        }
#undef CNT_GE
    }
    __syncthreads();
}

constexpr int AT_K = 0, AT_V = 18432, AT_M = 59392, AT_VP = 160, AT_VSZ = 64 * AT_VP;
__device__ __forceinline__ void attn_unit(LAS unsigned char* lds, int tid, int lane, int wave, bool isS, int b, int c, int kvh,
                                          bf16* Q, const bf16* KP, const bf16* KSn, const bf16* VP, const bf16* VSn, const float* CK, const float* CV, const unsigned* MASK) {
    const int tok0 = isS ? TP + b * DSEQ : b * SEQ + 64 * c;
    const int limit = isS ? NKS : 64 * (c + 1), nt = limit >> 6;
    const bf16* Kb = isS ? KSn + (size_t)(b * 4 + kvh) * DSEQ * 64 : KP + (size_t)(b * 4 + kvh) * NKP * 64;
    const bf16* Vb = isS ? VSn + (size_t)(b * 4 + kvh) * DSEQ * 64 : VP + (size_t)(b * 4 + kvh) * NKP * 64;
    const float* Kc = CK + ((size_t)b * PAST * 4 + kvh) * 64; const float* Vc32 = CV + ((size_t)b * PAST * 4 + kvh) * 64;
    LAS bf16* Kt = (LAS bf16*)(lds + AT_K); LAS bf16* Vt = (LAS bf16*)(lds + AT_V); LAS unsigned* MK = (LAS unsigned*)(lds + AT_M);
    const int l32 = lane & 31, hf = lane >> 5, r = 32 * wave + l32, tl = r >> 2, gq = r & 3;
    bf16* qp = Q + (size_t)(tok0 + tl) * DM + (kvh * 4 + gq) * 64;
    bf16x8 qf[4];
#pragma unroll
    for (int ks = 0; ks < 4; ++ks) qf[ks] = *(const bf16x8*)(qp + hf * 32 + 8 * ks);
    const int srow = tid >> 3, sseg = tid & 7;
    v4u kr0, kr1, vr0, vr1;
#define AT_LOAD(kt_) do { if (isS && (kt_) < 32) { const float* kp_ = Kc + (size_t)(64 * (kt_) + srow) * 256 + 8 * sseg; const float* vp_ = Vc32 + (size_t)(64 * (kt_) + srow) * 256 + 8 * sseg; \
            kr0 = *(const v4u*)kp_; kr1 = *(const v4u*)(kp_ + 4); vr0 = *(const v4u*)vp_; vr1 = *(const v4u*)(vp_ + 4); } \
        else { const int kk_ = isS ? srow : 64 * (kt_) + srow; kr0 = *(const v4u*)(Kb + (size_t)kk_ * 64 + 8 * sseg); vr0 = *(const v4u*)(Vb + (size_t)kk_ * 64 + 8 * sseg); } } while (0)
#define AT_STORE(kt_, buf_) do { v4u ko_ = kr0, vo_ = vr0; \
        if (isS && (kt_) < 32) { ko_.x = cvt_pk_bf16(__uint_as_float(kr0.x), __uint_as_float(kr0.y)); ko_.y = cvt_pk_bf16(__uint_as_float(kr0.z), __uint_as_float(kr0.w)); ko_.z = cvt_pk_bf16(__uint_as_float(kr1.x), __uint_as_float(kr1.y)); ko_.w = cvt_pk_bf16(__uint_as_float(kr1.z), __uint_as_float(kr1.w)); \
            vo_.x = cvt_pk_bf16(__uint_as_float(vr0.x), __uint_as_float(vr0.y)); vo_.y = cvt_pk_bf16(__uint_as_float(vr0.z), __uint_as_float(vr0.w)); vo_.z = cvt_pk_bf16(__uint_as_float(vr1.x), __uint_as_float(vr1.y)); vo_.w = cvt_pk_bf16(__uint_as_float(vr1.z), __uint_as_float(vr1.w)); } \
        *(LAS v4u*)(Kt + (buf_) * 4608 + srow * 72 + 8 * sseg) = ko_; *(LAS v4u*)(Vt + (buf_) * AT_VSZ + srow * AT_VP + 8 * sseg) = vo_; } while (0)
    AT_LOAD(0);
    for (int i = tid; i < 64 * MASKW; i += 512) MK[i] = MASK[(size_t)tok0 * MASKW + i];
    AT_STORE(0, 0);
    __syncthreads();
    f32x16 o0, o1;
#pragma unroll
    for (int i = 0; i < 16; ++i) { o0[i] = 0.f; o1[i] = 0.f; }
    float lpart = 0.f;
    for (int kt = 0; kt < nt; ++kt) {
        const int buf = kt & 1;
        if (kt + 1 < nt) AT_LOAD(kt + 1);
        const LAS bf16* Kc2 = Kt + buf * 4608; const LAS bf16* Vc = Vt + buf * AT_VSZ;
        f32x16 s0, s1;
#pragma unroll
        for (int i = 0; i < 16; ++i) { s0[i] = 0.f; s1[i] = 0.f; }
#pragma unroll
        for (int ks = 0; ks < 4; ++ks) { const bf16x8 a0 = *(const LAS bf16x8*)(Kc2 + l32 * 72 + hf * 32 + 8 * ks), a1 = *(const LAS bf16x8*)(Kc2 + (32 + l32) * 72 + hf * 32 + 8 * ks);
            s0 = MFMA32(a0, qf[ks], s0); s1 = MFMA32(a1, qf[ks], s1); }
        const unsigned w0 = MK[tl * MASKW + 2 * kt] >> (4 * hf), w1 = MK[tl * MASKW + 2 * kt + 1] >> (4 * hf);
        float p0[16], p1[16], ls = 0.f;
#pragma unroll
        for (int i = 0; i < 16; ++i) { const int bp = 8 * (i >> 2) + (i & 3);
            p0[i] = ((w0 >> bp) & 1u) ? __builtin_amdgcn_exp2f(s0[i]) : 0.f; p1[i] = ((w1 >> bp) & 1u) ? __builtin_amdgcn_exp2f(s1[i]) : 0.f; ls += p0[i] + p1[i]; }
        lpart += ls;
#pragma unroll
        for (int sub = 0; sub < 2; ++sub)
#pragma unroll
            for (int jj = 0; jj < 2; ++jj) {
                const v4u pk = pack8((sub ? p1 : p0) + 8 * jj); bf16x8 bv; __builtin_memcpy(&bv, &pk, 16);
                const int ja = 32 * sub + 16 * jj + 4 * hf;
                const bf16x8 av0 = tr_frag(Vc, AT_VP, ja, ja + 8, l32, lane), av1 = tr_frag(Vc, AT_VP, ja, ja + 8, 32 + l32, lane);
                o0 = MFMA32(av0, bv, o0); o1 = MFMA32(av1, bv, o1);
            }
        if (kt + 1 < nt) AT_STORE(kt + 1, buf ^ 1);
        __syncthreads();
    }
#undef AT_LOAD
#undef AT_STORE
    const float lt = lpart + __shfl_xor(lpart, 32), inv = 1.f / lt;
#pragma unroll
    for (int q = 0; q < 4; ++q) {
        v2u a; a.x = cvt_pk_bf16(o0[4 * q] * inv, o0[4 * q + 1] * inv); a.y = cvt_pk_bf16(o0[4 * q + 2] * inv, o0[4 * q + 3] * inv); *(v2u*)(qp + 8 * q + 4 * hf) = a;
        v2u c2; c2.x = cvt_pk_bf16(o1[4 * q] * inv, o1[4 * q + 1] * inv); c2.y = cvt_pk_bf16(o1[4 * q + 2] * inv, o1[4 * q + 3] * inv); *(v2u*)(qp + 32 + 8 * q + 4 * hf) = c2;
    }
    __syncthreads();
}
constexpr int NPHASES = 12;

#ifdef NOSSD
#define SSDCALL(...) (void)0
#else
#define SSDCALL ssd_unit
#endif
#ifdef NOATT
#define ATTCALL(...) (void)0
#else
#define ATTCALL attn_unit
#endif
#define XB_TMO      128
#define XB_XCNT(j)  (256  + 64 * (j))
#define XB_XSUB(j)  (1280 + 64 * (j))
#define XB_XGEN(j)  (2304 + 64 * (j))
#define XB_TOP      3328
#define XB_TOPGEN   3392
#define XCD_BAR_WORDS 3456
#define XB_SPIN_CAP (1u << 18)

__device__ __forceinline__ unsigned xb_ld(unsigned* p)              { return __hip_atomic_load(p, __ATOMIC_RELAXED, __HIP_MEMORY_SCOPE_AGENT); }
__device__ __forceinline__ unsigned xb_add(unsigned* p, unsigned v) { return __hip_atomic_fetch_add(p, v, __ATOMIC_RELAXED, __HIP_MEMORY_SCOPE_AGENT); }
__device__ __forceinline__ unsigned xb_xcc_id() { return (unsigned)__builtin_amdgcn_s_getreg((3 << 11) | 20) & 0xFu; }
#define XB_SPIN(cond, bar) do { unsigned _sp = 0; while (cond) { __builtin_amdgcn_s_sleep(1); \
    if ((++_sp & 255u) == 0u) { if (xb_ld(&(bar)[XB_TMO])) break; if (_sp > XB_SPIN_CAP) { atomicAdd(&(bar)[XB_TMO], 1u); break; } } } } while (0)

struct XcdBarrier {
    unsigned* bar; unsigned x;
    volatile LAS unsigned* st;
};

__device__ __forceinline__ XcdBarrier xcd_barrier_post(unsigned* bar, volatile LAS unsigned* st) {
    XcdBarrier b; b.bar = bar; b.x = xb_xcc_id(); b.st = st;
    if (threadIdx.x == 0) (void)xb_add(&bar[XB_XCNT(b.x)], 1u);
    return b;
}
__device__ __forceinline__ void xcd_barrier_complete(unsigned* bar, unsigned x, unsigned& nloc, unsigned& nx) {
    const unsigned G = gridDim.x * gridDim.y * gridDim.z;
    unsigned sum, cnt, mine, sp = 0u;
    for (;;) {
        sum = 0u; cnt = 0u; mine = 0u;
#pragma unroll
        for (unsigned j = 0; j < 16; ++j) { const unsigned c = xb_ld(&bar[XB_XCNT(j)]); sum += c; cnt += (c > 0u) ? 1u : 0u; mine = (j == x) ? c : mine; }
        if (sum == G) break;
        __builtin_amdgcn_s_sleep(1);
        if ((++sp & 255u) == 0u) { if (xb_ld(&bar[XB_TMO])) break; if (sp > XB_SPIN_CAP) { atomicAdd(&bar[XB_TMO], 1u); break; } }
    }
    nloc = mine > 0u ? mine : 1u; nx = cnt > 0u ? cnt : 1u;
}

__device__ __forceinline__ void xcd_barrier(const XcdBarrier& b) {
    asm volatile("s_waitcnt vmcnt(0)" ::: "memory");
    __syncthreads();
    if (threadIdx.x == 0) {
        unsigned* bar = b.bar;
        __builtin_amdgcn_s_waitcnt(0);
        unsigned nloc = b.st[0], nx = b.st[1];
        if (nloc == 0u) { xcd_barrier_complete(bar, b.x, nloc, nx); b.st[0] = nloc; b.st[1] = nx; }
        const unsigned old = xb_add(&bar[XB_XSUB(b.x)], 1u);
        const unsigned gen = old / nloc;
        if (old + 1u == (gen + 1u) * nloc) {
            __builtin_amdgcn_fence(__ATOMIC_RELEASE, "agent");
            asm volatile("s_waitcnt vmcnt(0)" ::: "memory");
            const unsigned og = xb_add(&bar[XB_TOP], 1u);
            const unsigned tg = og / nx;
            if (og + 1u == (tg + 1u) * nx) xb_add(&bar[XB_TOPGEN], 1u);
            else XB_SPIN(xb_ld(&bar[XB_TOPGEN]) == tg, bar);
            __builtin_amdgcn_fence(__ATOMIC_ACQUIRE, "agent");
            xb_add(&bar[XB_XGEN(b.x)], 1u);
            asm volatile("s_waitcnt vmcnt(0)" ::: "memory");
        } else {
            XB_SPIN(xb_ld(&bar[XB_XGEN(b.x)]) == gen, bar);
            __builtin_amdgcn_fence(__ATOMIC_ACQUIRE, "agent");
            asm volatile("s_waitcnt vmcnt(0)" ::: "memory");
        }
    }
    __syncthreads();
}

__global__ void __launch_bounds__(512) mega(Params p) {
    extern __shared__ __attribute__((aligned(16))) unsigned char lds_raw[];
    LAS unsigned char* lds = (LAS unsigned char*)lds_raw;
    cg::grid_group grid = cg::this_grid();
    const int tid = threadIdx.x, lane = tid & 63, wave = __builtin_amdgcn_readfirstlane(tid >> 6);
    unsigned char* ws = p.ws;
#define IN(k) (p.ph_hi > (k))
#define SEAM(k) xcd_barrier(xbar)
    volatile LAS unsigned* xst = (volatile LAS unsigned*)(lds + LDS_BYTES - 16);
    if (tid < 4) xst[tid] = 0u;
    __syncthreads();
    if (p.ph_hi < 0) grid.sync();
    XcdBarrier xbar = xcd_barrier_post((unsigned*)(ws + WS_CTL), xst);
    bf16* Hb = (bf16*)(ws + WS_H);
    bf16* QIb = (bf16*)(p.out + O_SSMS); bf16* KIPb = QIb + (size_t)TT * 512; bf16* KISb = KIPb + (size_t)NBP * NKP * 64;
    bf16* Zb = (bf16*)(p.out + O_Y);

    if (IN(0)) phase0(p, lds, tid, lane, wave);
    SEAM(0);
    if (IN(1)) normmod_phase<true>(p, lds, tid, lane, wave, p.in[0], p.in[1], p.in[11], 0, 1024, Hb);
    SEAM(1);
    if (IN(2)) {
        pg8::Gemm g{Hb, (const bf16*)(ws + WS_WIN), TT, NIN, DM}; pg8::StaticOrder S; S.init(TT, NIN, gridDim.x, (int)blockIdx.x);
        EpiIn E{(bf16*)(ws + WS_Q), (bf16*)(ws + WS_KP), (bf16*)(ws + WS_KS), (bf16*)(ws + WS_VTP), (bf16*)(ws + WS_VTS), QIb, KIPb, KISb, Zb, (bf16*)(ws + WS_XBC),
                (float*)(ws + WS_WI), (float*)(ws + WS_DT), p.out, p.in[14], p.in[15], p.in[18], (const float*)(ws + WS_ROPE)};
        pg8::gemm_phase<EpiIn, pg8::StaticOrder, true, true>(lds, g, S, E);
    }
    SEAM(2);
    bf16* Qb = (bf16*)(ws + WS_Q); unsigned* MASKb = (unsigned*)(ws + WS_MASK); float* SSQb = (float*)(ws + WS_SSQ);
    bf16* GATESb = (bf16*)(ws + WS_GATES); bf16* P1b = (bf16*)(ws + WS_P1); bf16* MXb = (bf16*)(ws + WS_MIXED); bf16* ACTb = (bf16*)(ws + WS_ACT);
    const float* MODb = (const float*)(ws + WS_MOD);
    const int G = gridDim.x, bx = blockIdx.x;
    const int bxr = ((G & 7) == 0) ? ((G >> 3) - 1 - (bx >> 3)) * 8 + (bx & 7) : G - 1 - bx;
    if (IN(3)) {
        conv_phase(p, tid, (bf16*)(ws + WS_XBC));
        __syncthreads();
        for (int rd = 0; rd * G < 1152; ++rd) { const int u = rd * G + ((rd & 1) ? bxr : bx); if (u >= 1152) continue;
            bool us; int ub, uq;
            if (u < 128) { us = true; ub = u >> 2; uq = u & 3; } else { const int v = u - 128; us = false; ub = v & 7; uq = 127 - (v >> 3); }
            topk_unit(lds, tid, lane, wave, us, ub, uq, QIb, KIPb, KISb, (const float*)(ws + WS_WI), MASKb); }
    }
    SEAM(3);
    if (IN(4)) {
        for (int rd = 0; rd * G < 2432; ++rd) { const int u = rd * G + ((rd & 1) ? bxr : bx); if (u >= 2432) continue;
            int kind, ub, uc, uh; bool us;
            if (u < 256) { kind = 0; us = false; const int gi = ((u >> 5) << 3) + (u & 7); ub = gi >> 3; uh = ((gi & 7) << 2) + ((u >> 3) & 3); uc = 0; }
            else if (u < 384) { const int v = u - 256; kind = 1; us = true; ub = v >> 2; uh = v & 3; uc = 0; }
            else if (u < 1408) { const int v = u - 384, w = v & 31; kind = 1; us = false; ub = w >> 2; uh = w & 3; uc = 31 - (v >> 5); }
            else { const int v = u - 1408; kind = 0; us = true; const int gi = ((v >> 5) << 3) + (v & 7); ub = gi >> 3; uh = ((gi & 7) << 2) + ((v >> 3) & 3); uc = 0; }
            if (kind == 0) SSDCALL(p, lds, tid, lane, wave, us, ub, uh, (const bf16*)(ws + WS_XBC), (const float*)(ws + WS_DT), Zb, SSQb);
            else ATTCALL(lds, tid, lane, wave, us, ub, uc, uh, Qb, (const bf16*)(ws + WS_KP), (const bf16*)(ws + WS_KS), (const bf16*)(ws + WS_VTP), (const bf16*)(ws + WS_VTS), p.in[2], p.in[3], MASKb); }
    }
    SEAM(4);
    if (IN(5)) {
        ynorm_phase(p, lane, wave, Zb, SSQb);
        __syncthreads();
        { pg8::Gemm g{Hb, (const bf16*)(ws + WS_WG), TT, 2048, DM}; pg8::StaticOrder S; S.init(TT, 2048, G, bx);
          EpiGates E{GATESb};
          pg8::gemm_phase<EpiGates, pg8::StaticOrder, true, true>(lds, g, S, E); }
        { pg8::Gemm g{Qb, (const bf16*)(ws + WS_WBA), TT, DM, DM}; pg8::StaticOrder S; S.init(TT, DM, G, G - 1 - bx);
          EpiP1 E{GATESb, P1b};
          pg8::gemm_phase<EpiP1, pg8::StaticOrder, true, true>(lds, g, S, E); }
    }
    SEAM(5);
    if (IN(7)) {
        pg8::Gemm g{Zb, (const bf16*)(ws + WS_WBS), TT, DM, DINNER}; pg8::StaticOrder S; S.init(TT, DM, G, bx);
        EpiMixed E{GATESb, P1b, MXb};
        pg8::gemm_phase<EpiMixed, pg8::StaticOrder, true, true>(lds, g, S, E);
    }
    SEAM(7);
    if (IN(8)) {
        pg8::Gemm g{MXb, (const bf16*)(ws + WS_WOUT), TT, DM, DM}; pg8::StaticOrder S; S.init(TT, DM, G, bx);
        EpiRes E{p.in[0], p.in[1], MODb, 2048, p.out};
        pg8::gemm_phase<EpiRes, pg8::StaticOrder, true, true>(lds, g, S, E);
    }
    SEAM(8);
    if (IN(9)) normmod_phase<false>(p, lds, tid, lane, wave, p.out, p.out + (size_t)TP * DM, p.in[12], 3072, 4096, Hb);
    SEAM(9);
    if (IN(10)) {
        pg8::Gemm g{Hb, (const bf16*)(ws + WS_WGU), TT, 2 * DFF, DM}; pg8::StaticOrder S; S.init(TT, 2 * DFF, G, bx);
        EpiAct E{ACTb};
        pg8::gemm_phase<EpiAct, pg8::StaticOrder, true, true>(lds, g, S, E);
    }
    SEAM(10);
    if (IN(11)) {
        pg8::Gemm g{ACTb, (const bf16*)(ws + WS_WDN), TT, DM, DFF}; pg8::StaticOrder S; S.init(TT, DM, G, bx);
        EpiRes E{p.out, p.out + (size_t)TP * DM, MODb, 5120, p.out};
        pg8::gemm_phase<EpiRes, pg8::StaticOrder, true, true>(lds, g, S, E);
    }
#undef IN
#undef SEAM
}

extern "C" void kernel_launch(void* const* d_in, const int* in_sizes, int n_in, void* d_out, int out_size, void* d_ws, size_t ws_size, hipStream_t stream) {
    static int grid = 0;
    if (grid == 0) {
        if (n_in != 27 || ws_size < WS_END) { fprintf(stderr, "kernel_launch: unexpected n_in %d / ws %zu\n", n_in, ws_size); grid = -1; return; }
        int dev = 0, cus = 0, per_cu = 0;
        hipGetDevice(&dev); hipDeviceGetAttribute(&cus, hipDeviceAttributeMultiprocessorCount, dev);
        hipFuncSetAttribute((const void*)mega, hipFuncAttributeMaxDynamicSharedMemorySize, LDS_BYTES);
        hipOccupancyMaxActiveBlocksPerMultiprocessor(&per_cu, (const void*)mega, 512, LDS_BYTES);
        (void)hipGetLastError();
        if (per_cu < 1) per_cu = 1;
        grid = cus;
    }
    if (grid < 0) return;
    Params prm{};
    for (int i = 0; i < 27; ++i) prm.in[i] = (const float*)d_in[i];
    prm.out = (float*)d_out; prm.ws = (unsigned char*)d_ws; prm.ph_lo = 0; prm.ph_hi = NPHASES;
    (void)hipMemsetAsync((char*)d_ws + WS_CTL, 0, 16384, stream);
    void* args[] = {&prm};
    hipError_t e = hipLaunchCooperativeKernel((const void*)mega, dim3(grid), dim3(512), args, LDS_BYTES, stream);
    if (e != hipSuccess) fprintf(stderr, "cooperative launch failed: %s (grid %d)\n", hipGetErrorString(e), grid);
}
```

```cpp
#include <hip/hip_runtime.h>
#include <hip/hip_cooperative_groups.h>
#include <cstdio>
#include <cstdint>
namespace cg = cooperative_groups;

namespace pg8 {
#define PG8_LAS __attribute__((address_space(3)))
typedef unsigned short bf16_t;
typedef short bf16x8 __attribute__((ext_vector_type(8)));
typedef float f32x4 __attribute__((ext_vector_type(4)));
typedef unsigned u32x4 __attribute__((ext_vector_type(4)));
constexpr int BM = 256, BK = 64, HALF = 128, HTB = HALF * BK * 2  , STAGE_BYTES = 8 * HTB, NXCD = 8, WGM = 9;

__host__ __device__ __forceinline__ int lds_byte(int r, int c) { const int st = (r >> 4) * 2 + (c >> 5), rr = r & 15, cc = c & 31, ob = rr * 64 + cc * 2; return st * 1024 + (ob ^ (((ob >> 9) & 1) << 5)); }
__host__ __device__ __forceinline__ void stage_rc(int b, int& R, int& C) { const int st = b / 1024, sb = b % 1024, swz = sb ^ (((sb >> 9) & 1) << 5); R = (st >> 1) * 16 + swz / 64; C = (st & 1) * 32 + (swz % 64) / 2; }
__host__ __device__ __forceinline__ int perm32(int rho) { const int n = rho >> 4, i = rho & 15; return 8 * (i >> 2) + 4 * n + (i & 3); }

struct Unit { int pm, pn; };
struct Gemm { const bf16_t* A; const bf16_t* Bt; int M, N, K; int ld = 0; int ncol = 0; };

struct StaticOrder {
    int nM, nN, nwg, G, c;
    __host__ __device__ void init(int M, int N, int G_, int c_) { nM = M / BM; nN = N / BM; nwg = nM * nN; G = G_; c = c_; }
    __host__ __device__ bool next(int i, Unit& u) const {
        const long L = (long)i * G + c; if (L >= nwg) return false;
        int wgid = (int)L; { const int q = nwg / NXCD, r = nwg % NXCD, xcd = wgid % NXCD, off = wgid / NXCD; wgid = (xcd < r ? xcd * (q + 1) : r * (q + 1) + (xcd - r) * q) + off; }
        const int nig = WGM * nN, gid = wgid / nig, fm = gid * WGM, gsz = (nM - fm) < WGM ? (nM - fm) : WGM;
        u.pm = fm + ((wgid % nig) % gsz); u.pn = (wgid % nig) / gsz; return true;
    }
    __device__ __forceinline__ void a_ready(const Unit&) const {}
    __device__ __forceinline__ void done(const Unit&) const {}
};
typedef float f32x2_t __attribute__((ext_vector_type(2)));
typedef __bf16 bf16x2_t __attribute__((ext_vector_type(2)));
__device__ __forceinline__ unsigned cvt_pk_bf16(float lo, float hi) { const bf16x2_t r = __builtin_convertvector((f32x2_t){lo, hi}, bf16x2_t); unsigned u; __builtin_memcpy(&u, &r, 4); return u; }
template <class Epi, class Sched, bool ALIGN_EPI = false, bool SP2 = false>
__device__ __forceinline__ void gemm_phase(PG8_LAS unsigned char* lds, const Gemm g, const Sched& S, const Epi& E) {
    const int tid = threadIdx.x, wid = __builtin_amdgcn_readfirstlane(tid >> 6), lane = tid & 63, wr = wid >> 2, wc = wid & 3, fr = lane & 15, fq = lane >> 4;
    const int K = g.ld ? g.ld : g.K, nt = g.K / BK;
    const int ncol = g.ncol ? g.ncol : (1 << 30); const size_t ksplit = (size_t)g.K * 2;
    unsigned voffA[2], voffB[2];
#pragma unroll
    for (int i = 0; i < 2; ++i) { int R, C; stage_rc(tid * 16 + i * 8192, R, C); const int Rb = Epi::PERM ? ((R & ~31) + perm32(R & 31)) : R;
        voffA[i] = (unsigned)(R * K + C) * 2u; voffB[i] = (unsigned)(Rb * K + C) * 2u; }
    const size_t kstep = (size_t)(BK * 2);
    const size_t hstep = (size_t)HALF * K * 2;
    const size_t tstep = 2 * hstep;
    const unsigned ldsw = (unsigned)wid * 1024u;
    const int aoff = lds_byte(wr * 64 + fr, fq * 8), boff = lds_byte(wc * 32 + fr, fq * 8);
#define PG8_SA(b, h) (((b) * 2 + (h)) * HTB)
#define PG8_SB(b, h) ((4 + (b) * 2 + (h)) * HTB)
#define PG8_STAGE(bufoff, gbase, voff) do { _Pragma("unroll") for (int _i = 0; _i < 2; ++_i) \
        __builtin_amdgcn_global_load_lds((const unsigned*)((const char*)(gbase) + (voff)[_i]), (PG8_LAS unsigned*)(lds + (bufoff) + ldsw + _i * 8192), 16, 0, 0); } while (0)
#define PG8_LDA(dst, b, h) do { _Pragma("unroll") for (int m = 0; m < 4; ++m) _Pragma("unroll") for (int k = 0; k < 2; ++k) dst[m][k] = *(const PG8_LAS bf16x8*)(lds + PG8_SA(b, h) + aoff + m * 2048 + k * 1024); } while (0)
#define PG8_LDB(dst, b, h) do { _Pragma("unroll") for (int n = 0; n < 2; ++n) _Pragma("unroll") for (int k = 0; k < 2; ++k) dst[n][k] = *(const PG8_LAS bf16x8*)(lds + PG8_SB(b, h) + boff + n * 2048 + k * 1024); } while (0)
#define PG8_MMA(ai, bj, At, Bt) do { __builtin_amdgcn_s_setprio(1); _Pragma("unroll") for (int m = 0; m < 4; ++m) _Pragma("unroll") for (int n = 0; n < 2; ++n) _Pragma("unroll") for (int k = 0; k < 2; ++k) \
        acc[ai][bj][m][n] = __builtin_amdgcn_mfma_f32_16x16x32_bf16(Bt[n][k], At[m][k], acc[ai][bj][m][n], 0, 0, 0); __builtin_amdgcn_s_setprio(0); } while (0)
#define PG8_WAIT_V(n) asm volatile("s_waitcnt vmcnt(" #n ")" ::: "memory")
#define PG8_WAIT_L(n) asm volatile("s_waitcnt lgkmcnt(" #n ")" ::: "memory")
#define PG8_BAR __builtin_amdgcn_s_barrier()
#define PG8_SCHED __builtin_amdgcn_sched_barrier(0)
    Unit cur, nxt; int ui = 0;
    if (!S.next(0, cur)) return;
    f32x4 acc[2][2][4][2];
#pragma unroll
    for (int a = 0; a < 2; ++a)
#pragma unroll
        for (int b = 0; b < 2; ++b)
#pragma unroll
            for (int m = 0; m < 4; ++m)
#pragma unroll
                for (int n = 0; n < 2; ++n) acc[a][b][m][n] = (f32x4){0.f, 0.f, 0.f, 0.f};
    bf16x8 At[4][2], B0[2][2], B1[2][2];
    const char* cA = (const char*)g.A + (size_t)cur.pm * tstep + (size_t)(cur.pn / ncol) * ksplit; const char* cB = (const char*)g.Bt + (size_t)(cur.pn % ncol) * tstep + (size_t)(cur.pn / ncol) * ksplit;
    S.a_ready(cur);
    if constexpr (SP2) {
        PG8_STAGE(PG8_SB(0, 0), cB, voffB); PG8_STAGE(PG8_SB(0, 1), cB + hstep, voffB); PG8_STAGE(PG8_SA(0, 0), cA, voffA); PG8_STAGE(PG8_SA(0, 1), cA + hstep, voffA);
        if (wr == 1) PG8_BAR;
        PG8_WAIT_V(2); PG8_BAR;
        PG8_STAGE(PG8_SB(1, 0), cB + kstep, voffB); PG8_STAGE(PG8_SA(1, 0), cA + kstep, voffA); PG8_STAGE(PG8_SB(1, 1), cB + hstep + kstep, voffB);
        PG8_WAIT_V(6); PG8_BAR;
    } else {
        PG8_STAGE(PG8_SB(0, 0), cB, voffB); PG8_STAGE(PG8_SA(0, 0), cA, voffA); PG8_STAGE(PG8_SB(0, 1), cB + hstep, voffB); PG8_STAGE(PG8_SA(0, 1), cA + hstep, voffA);
        if (wr == 1) PG8_BAR;
        PG8_WAIT_V(4); PG8_BAR;
        PG8_STAGE(PG8_SB(1, 0), cB + kstep, voffB); PG8_STAGE(PG8_SA(1, 0), cA + kstep, voffA); PG8_STAGE(PG8_SB(1, 1), cB + hstep + kstep, voffB);
        PG8_WAIT_V(6); PG8_BAR;
    }
    for (;;) {
        const bool has_next = S.next(ui + 1, nxt);
        const char* nA = has_next ? (const char*)g.A + (size_t)nxt.pm * tstep + (size_t)(nxt.pn / ncol) * ksplit : cA; const char* nB = has_next ? (const char*)g.Bt + (size_t)(nxt.pn % ncol) * tstep + (size_t)(nxt.pn / ncol) * ksplit : cB;
        for (int t = 0; t < nt; t += 2) {
            const bool last = (t == nt - 2);
            const char* a1 = cA + (size_t)(t + 1) * kstep;
            const char* a2 = last ? nA : cA + (size_t)(t + 2) * kstep; const char* b2 = last ? nB : cB + (size_t)(t + 2) * kstep;
            const char* a3 = a2 + kstep; const char* b3 = b2 + kstep;
            if (last && has_next) S.a_ready(nxt);
            if constexpr (SP2) {
            PG8_LDB(B0, 0, 0); PG8_LDB(B1, 0, 1); PG8_SCHED; PG8_LDA(At, 0, 0); PG8_STAGE(PG8_SA(1, 1), a1 + hstep, voffA);
            PG8_WAIT_V(8); PG8_WAIT_L(0); PG8_BAR; PG8_MMA(0, 0, At, B0); PG8_MMA(0, 1, At, B1); PG8_BAR; PG8_SCHED;
            PG8_LDA(At, 0, 1); PG8_STAGE(PG8_SB(0, 0), b2, voffB); PG8_STAGE(PG8_SB(0, 1), b2 + hstep, voffB); PG8_STAGE(PG8_SA(0, 0), a2, voffA);
            PG8_WAIT_V(8); PG8_WAIT_L(0); PG8_BAR; PG8_MMA(1, 0, At, B0); PG8_MMA(1, 1, At, B1); PG8_BAR; PG8_SCHED;
            PG8_LDB(B0, 1, 0); PG8_LDB(B1, 1, 1); PG8_SCHED; PG8_LDA(At, 1, 0); PG8_STAGE(PG8_SA(0, 1), a2 + hstep, voffA);
            PG8_WAIT_V(8); PG8_WAIT_L(0); PG8_BAR; PG8_MMA(0, 0, At, B0); PG8_MMA(0, 1, At, B1); PG8_BAR; PG8_SCHED;
            PG8_LDA(At, 1, 1); PG8_STAGE(PG8_SB(1, 0), b3, voffB); PG8_STAGE(PG8_SB(1, 1), b3 + hstep, voffB); PG8_STAGE(PG8_SA(1, 0), a3, voffA);
            PG8_WAIT_V(8); PG8_WAIT_L(0); PG8_BAR; PG8_MMA(1, 0, At, B0); PG8_MMA(1, 1, At, B1); PG8_BAR; PG8_SCHED;
            } else {
            PG8_LDB(B0, 0, 0); PG8_SCHED; PG8_LDA(At, 0, 0); PG8_STAGE(PG8_SA(1, 1), a1 + hstep, voffA);
            PG8_WAIT_L(8); PG8_BAR; PG8_WAIT_L(0); PG8_MMA(0, 0, At, B0); PG8_BAR; PG8_SCHED;
            PG8_LDB(B1, 0, 1); PG8_STAGE(PG8_SB(0, 0), b2, voffB);
            PG8_BAR; PG8_WAIT_L(0); PG8_MMA(0, 1, At, B1); PG8_BAR;
            PG8_LDA(At, 0, 1); PG8_STAGE(PG8_SA(0, 0), a2, voffA);
            PG8_BAR; PG8_WAIT_L(0); PG8_MMA(1, 0, At, B0); PG8_BAR; PG8_SCHED;
            PG8_STAGE(PG8_SB(0, 1), b2 + hstep, voffB);
            PG8_WAIT_V(6); PG8_BAR; PG8_MMA(1, 1, At, B1); PG8_BAR;
            PG8_LDB(B0, 1, 0); PG8_SCHED; PG8_LDA(At, 1, 0); PG8_STAGE(PG8_SA(0, 1), a2 + hstep, voffA);
            PG8_WAIT_L(8); PG8_BAR; PG8_WAIT_L(0); PG8_MMA(0, 0, At, B0); PG8_BAR; PG8_SCHED;
            PG8_LDB(B1, 1, 1); PG8_STAGE(PG8_SB(1, 0), b3, voffB);
            PG8_BAR; PG8_WAIT_L(0); PG8_MMA(0, 1, At, B1); PG8_BAR;
            PG8_LDA(At, 1, 1); PG8_STAGE(PG8_SA(1, 0), a3, voffA);
            PG8_BAR; PG8_WAIT_L(0); PG8_MMA(1, 0, At, B0); PG8_BAR; PG8_SCHED;
            PG8_STAGE(PG8_SB(1, 1), b3 + hstep, voffB);
            PG8_WAIT_V(6); PG8_BAR; PG8_MMA(1, 1, At, B1); PG8_BAR;
            }
        }
        if constexpr (ALIGN_EPI) { if (wr == 0) PG8_BAR; }
        if constexpr (!Epi::AFTER_DRAIN) { E(acc, cur, wr, wc, fr, fq); S.done(cur); }
        if (!has_next) break;
#pragma unroll
        for (int a = 0; a < 2; ++a)
#pragma unroll
            for (int b = 0; b < 2; ++b)
#pragma unroll
                for (int m = 0; m < 4; ++m)
#pragma unroll
                    for (int n = 0; n < 2; ++n) acc[a][b][m][n] = (f32x4){0.f, 0.f, 0.f, 0.f};
        cur = nxt; cA = nA; cB = nB; ++ui;
        if constexpr (ALIGN_EPI) { if (wr == 1) PG8_BAR; }
    }
    PG8_WAIT_V(0);
    if constexpr (!ALIGN_EPI) { if (wr == 0) PG8_BAR; }
    PG8_BAR;
    if constexpr (Epi::AFTER_DRAIN) { E.fused(acc, cur, wr, wc, fr, fq, lds, wid, lane); S.done(cur); }
#undef PG8_SA
#undef PG8_SB
#undef PG8_STAGE
#undef PG8_LDA
#undef PG8_LDB
#undef PG8_MMA
#undef PG8_WAIT_V
#undef PG8_WAIT_L
#undef PG8_BAR
#undef PG8_SCHED
}
}

constexpr int DM = 1024, NBP = 8, SEQ = 2048, NBS = 32, DSEQ = 64, PAST = 2048;
constexpr int TP = NBP * SEQ, TS = NBS * DSEQ, TT = TP + TS;
constexpr int NKP = 2048, NKS = 2112;
constexpr int DFF = 2816, DINNER = 2048, CONVC = 4096;
constexpr int IN_DIM = 10344;
constexpr int CQ = 0, CK = 1024, CV = 1280, CQI = 1536, CKI = 2048, CWI = 2112, CZ = 2120, CXBC = 4168, CDT = 8264, CGATE = 8296;
constexpr int NIN = 33 * 256;
constexpr float EPS = 1e-6f;
constexpr int MASKW = 68;
constexpr size_t O_Y = 0, O_KP = 18874368, O_VP = 23068672, O_KIP = 27262976, O_CONVP = 28311552, O_SSMP = 28409856,
                 O_KS = 30507008, O_VS = 31031296, O_KIS = 31555584, O_CONVS = 31686656, O_SSMS = 32079872;
constexpr size_t MiB = 1u << 20;
constexpr size_t WS_CTL = 0, WS_MOD = 1 * MiB, WS_ROPE = 2 * MiB, WS_WI = 3 * MiB, WS_DT = 4 * MiB;
constexpr size_t WS_WBA = 8 * MiB, WS_WOUT = 10 * MiB, WS_WBS = 12 * MiB, WS_WGU = 16 * MiB, WS_WDN = 27 * MiB, WS_WG = 33 * MiB, WS_WIN = 37 * MiB;
constexpr size_t WS_MASK = 37 * MiB, WS_SSQ = 43 * MiB;
constexpr size_t WS_H = 54 * MiB, WS_Q = 90 * MiB, WS_KP = 126 * MiB, WS_KS = 134 * MiB, WS_VTP = 167 * MiB, WS_VTS = 175 * MiB, WS_XBC = 208 * MiB;
constexpr size_t WS_PART = WS_XBC;
constexpr size_t WS_GATES = 208 * MiB, WS_P1 = 280 * MiB, WS_MIXED = 316 * MiB, WS_ACT = 208 * MiB, WS_END = 352 * MiB;
constexpr int LDS_BYTES = 147456;

#define LAS __attribute__((address_space(3)))
typedef unsigned short bf16;
typedef unsigned v4u __attribute__((ext_vector_type(4)));
typedef unsigned v2u __attribute__((ext_vector_type(2)));
typedef float f32x4 __attribute__((ext_vector_type(4)));
typedef float f32x16 __attribute__((ext_vector_type(16)));
typedef short bf16x8 __attribute__((ext_vector_type(8)));
typedef short bf16x4 __attribute__((ext_vector_type(4)));
using pg8::cvt_pk_bf16;
#define LDS_WAIT() asm volatile("s_waitcnt lgkmcnt(0)" ::: "memory")
__device__ __forceinline__ float bf2f(unsigned h) { return __uint_as_float(h << 16); }
__device__ __forceinline__ float wave_sum(float v) {
#pragma unroll
    for (int o = 1; o < 64; o <<= 1) v += __shfl_xor(v, o);
    return v;
}
__device__ __forceinline__ float silu_f(float v) { return v * __builtin_amdgcn_rcpf(1.f + __expf(-v)); }
__device__ __forceinline__ float sigmoid_f(float v) { return __builtin_amdgcn_rcpf(1.f + __expf(-v)); }
__device__ __forceinline__ v4u pack8(const float* a) { v4u o; o.x = cvt_pk_bf16(a[0], a[1]); o.y = cvt_pk_bf16(a[2], a[3]); o.z = cvt_pk_bf16(a[4], a[5]); o.w = cvt_pk_bf16(a[6], a[7]); return o; }

struct Params { const float* in[27]; float* out; unsigned char* ws; int ph_lo, ph_hi; };

__device__ __forceinline__ void tr_item(const float* __restrict__ W, int ldw, int srccol, int nvalid, bf16* WT, size_t ldd, int dstrow, int k0, LAS float* scr, int lane) {
    { float t[32]; const int c = lane & 31;
#pragma unroll
      for (int i = 0; i < 32; ++i) t[i] = (c < nvalid) ? __builtin_nontemporal_load(W + (size_t)(k0 + 2 * i + (lane >> 5)) * ldw + srccol + c) : 0.f;
#pragma unroll
      for (int i = 0; i < 32; ++i) scr[(2 * i + (lane >> 5)) * 33 + c] = t[i]; }
    LDS_WAIT();
    const int c = lane & 7;
#pragma unroll
    for (int j = 0; j < 4; ++j) { const int n = (lane >> 3) + 8 * j; const LAS float* s = scr + (8 * c) * 33 + n;
        v4u o; o.x = cvt_pk_bf16(s[0 * 33], s[1 * 33]); o.y = cvt_pk_bf16(s[2 * 33], s[3 * 33]); o.z = cvt_pk_bf16(s[4 * 33], s[5 * 33]); o.w = cvt_pk_bf16(s[6 * 33], s[7 * 33]);
        *(v4u*)(WT + (size_t)(dstrow + n) * ldd + k0 + 8 * c) = o; }
    LDS_WAIT();
}

__device__ __forceinline__ void phase0(const Params& p, LAS unsigned char* lds, int tid, int lane, int wave) {
    const int G = gridDim.x, bx = blockIdx.x;
    unsigned char* ws = p.ws;
    {
        LAS float* sc = (LAS float*)lds;
        const float* w_ada = p.in[9];
        float* part = (float*)(ws + WS_PART);
        for (int it = bx; it < 192; it += G) {
            const int ks = it / 24, cb = it % 24;
            __syncthreads();
            for (int i = tid; i < 40 * 128; i += 512) { const int r = i >> 7, k = i & 127; const float c = (r < 8) ? p.in[7][r * DM + ks * 128 + k] : p.in[8][(r - 8) * DM + ks * 128 + k]; sc[i] = silu_f(c); }
            __syncthreads();
            const int col = cb * 256 + (tid & 255), rh = tid >> 8;
            float a[20];
#pragma unroll
            for (int r = 0; r < 20; ++r) a[r] = 0.f;
            const float* wp = w_ada + (size_t)(ks * 128) * 6144 + col;
            for (int k0 = 0; k0 < 128; k0 += 16) {
                float w8[16];
#pragma unroll
                for (int i = 0; i < 16; ++i) w8[i] = __builtin_nontemporal_load(wp + (size_t)(k0 + i) * 6144);
#pragma unroll
                for (int r = 0; r < 20; ++r) {
#pragma unroll
                    for (int q4 = 0; q4 < 4; ++q4) { const f32x4 s0 = *(const LAS f32x4*)(sc + (rh * 20 + r) * 128 + k0 + 4 * q4);
                        a[r] += (s0[0] * w8[4 * q4] + s0[1] * w8[4 * q4 + 1]) + (s0[2] * w8[4 * q4 + 2] + s0[3] * w8[4 * q4 + 3]); } }
            }
#pragma unroll
            for (int r = 0; r < 20; ++r) part[((size_t)ks * 40 + rh * 20 + r) * 6144 + col] = a[r];
        }
        __syncthreads();
    }
    {
        LAS float* scr = (LAS float*)(lds + wave * 8704);
        const int gw = bx * 8 + wave, NGW = G * 8;
        constexpr int I_IN = 16 * 264, I_G = 16 * 64, I_BA = 16 * 32, I_OUT = 16 * 32, I_BS = 32 * 32, I_GU = 16 * 176, I_DN = 44 * 32;
        constexpr int NIT = I_IN + I_G + I_BA + I_OUT + I_BS + I_GU + I_DN;
        for (int it = gw; it < NIT; it += NGW) {
            int r = it;
            if (r < I_IN) { const int kb = r / 264, rg = r % 264, pn = rg >> 3, w8 = rg & 7, bj = w8 >> 2, wc = w8 & 3; int src, nv = 32;
                if (pn < 8) src = 256 * pn + 64 * wc + 32 * bj;
                else if (pn == 8) { if (wc == 0) src = CKI + 32 * bj; else if (wc == 1) { if (bj == 0) { src = CWI; nv = 8; } else src = CDT; } else { src = 0; nv = 0; } }
                else if (pn < 17) src = CZ + (rg - 72) * 32; else src = CXBC + (rg - 136) * 32;
                tr_item(p.in[13], IN_DIM, src, nv, (bf16*)(ws + WS_WIN), 1024, rg * 32, kb * 64, scr, lane); continue; } r -= I_IN;
            if (r < I_G) { const int kb = r / 64, rg = r % 64; tr_item(p.in[13], IN_DIM, CGATE + rg * 32, 32, (bf16*)(ws + WS_WG), 1024, rg * 32, kb * 64, scr, lane); continue; } r -= I_G;
            if (r < I_BA) { const int kb = r / 32, rg = r % 32; tr_item(p.in[22], 1024, rg * 32, 32, (bf16*)(ws + WS_WBA), 1024, rg * 32, kb * 64, scr, lane); continue; } r -= I_BA;
            if (r < I_OUT) { const int kb = r / 32, rg = r % 32; tr_item(p.in[24], 1024, rg * 32, 32, (bf16*)(ws + WS_WOUT), 1024, rg * 32, kb * 64, scr, lane); continue; } r -= I_OUT;
            if (r < I_BS) { const int kb = r / 32, rg = r % 32; tr_item(p.in[23], 1024, rg * 32, 32, (bf16*)(ws + WS_WBS), 2048, rg * 32, kb * 64, scr, lane); continue; } r -= I_BS;
            if (r < I_GU) { const int kb = r / 176, rg = r % 176, pt = rg >> 3, w8 = rg & 7, half = w8 >> 2, r4 = w8 & 3;
                tr_item(p.in[25], 2 * DFF, half * DFF + 128 * pt + 32 * r4, 32, (bf16*)(ws + WS_WGU), 1024, rg * 32, kb * 64, scr, lane); continue; } r -= I_GU;
            { const int kb = r / 32, rg = r % 32; tr_item(p.in[26], 1024, rg * 32, 32, (bf16*)(ws + WS_WDN), DFF, rg * 32, kb * 64, scr, lane); }
        }
    }
    {
        const int gt = bx * 512 + tid, NGT = G * 512;
        const float* cki = p.in[4]; bf16* KIS = (bf16*)(p.out + O_SSMS) + (size_t)TT * 512 + (size_t)NBP * NKP * 64;
        for (int i = gt; i < 524288; i += NGT) { const size_t e = (size_t)i * 8; const int d = (int)(e & 63), s = (int)((e >> 6) & 2047), b = (int)(e >> 17);
            const f32x4 x0 = *(const f32x4*)(cki + e), x1 = *(const f32x4*)(cki + e + 4);
            v4u o; o.x = cvt_pk_bf16(x0[0], x0[1]); o.y = cvt_pk_bf16(x0[2], x0[3]); o.z = cvt_pk_bf16(x1[0], x1[1]); o.w = cvt_pk_bf16(x1[2], x1[3]);
            *(v4u*)(KIS + ((size_t)b * NKS + s) * 64 + d) = o; }
        float* rope = (float*)(ws + WS_ROPE);
        for (int i = gt; i < NKS * 32; i += NGT) { const int pos = i >> 5, j = i & 31;
            double invd = 1.0; for (int k = 0; k < j; ++k) invd *= 0.74989420933245582;
            const float inv = (float)invd; const float ang = (float)pos * inv;
            const double x = (double)ang; const double q = __builtin_rint(x * 0.63661977236758134); const double r = x - q * 1.5707963267948966; const double r2 = r * r;
            const double sn = r * (1.0 + r2 * (-1.0 / 6 + r2 * (1.0 / 120 + r2 * (-1.0 / 5040 + r2 * (1.0 / 362880 + r2 * (-1.0 / 39916800))))));
            const double cs = 1.0 + r2 * (-0.5 + r2 * (1.0 / 24 + r2 * (-1.0 / 720 + r2 * (1.0 / 40320 + r2 * (-1.0 / 3628800 + r2 * (1.0 / 479001600))))));
            const int iq = ((int)q) & 3; double so, co;
            if (iq == 0) { so = sn; co = cs; } else if (iq == 1) { so = cs; co = -sn; } else if (iq == 2) { so = -sn; co = -cs; } else { so = -cs; co = sn; }
            rope[i] = (float)co; rope[NKS * 32 + i] = (float)so; }
    }
}

template <bool FROM_PART>
__device__ __forceinline__ void normmod_phase(const Params& p, LAS unsigned char* lds, int tid, int lane, int wave, const float* xp, const float* xs, const float* g, int off_sh, int off_sc, bf16* H) {
    const int bx = blockIdx.x, G = gridDim.x;
    unsigned char* ws = p.ws;
    const float* part = (const float*)(ws + WS_PART); const float* b_ada = p.in[10]; float* MOD = (float*)(ws + WS_MOD);
    LAS float* lsh = (LAS float*)lds; LAS float* lsc = lsh + 1024;
    if (FROM_PART) {
        for (int it = bx; it < 240; it += G) { const int row = it / 6, seg = it % 6;
            for (int c = tid; c < 1024; c += 512) { float v = b_ada[seg * 1024 + c];
#pragma unroll
                for (int ks = 0; ks < 8; ++ks) v += part[((size_t)ks * 40 + row) * 6144 + seg * 1024 + c];
                MOD[row * 6144 + seg * 1024 + c] = v; } }
    }
    const int rows_per = (TT + G - 1) / G;
    const int r_lo = bx * rows_per, r_hi = (r_lo + rows_per < TT) ? r_lo + rows_per : TT;
    int r = r_lo;
    while (r < r_hi) {
        const int mrow = (r < TP) ? (r >> 11) : 8 + ((r - TP) >> 6);
        const int gend = (r < TP) ? ((r >> 11) + 1) << 11 : TP + ((((r - TP) >> 6) + 1) << 6);
        const int e = gend < r_hi ? gend : r_hi;
        __syncthreads();
        for (int c = tid; c < 1024; c += 512) {
            float vsh, vsc;
            if (FROM_PART) { vsh = b_ada[off_sh + c]; vsc = b_ada[off_sc + c];
#pragma unroll
                for (int ks = 0; ks < 8; ++ks) { vsh += part[((size_t)ks * 40 + mrow) * 6144 + off_sh + c]; vsc += part[((size_t)ks * 40 + mrow) * 6144 + off_sc + c]; } }
            else { vsh = MOD[mrow * 6144 + off_sh + c]; vsc = MOD[mrow * 6144 + off_sc + c]; }
            lsh[c] = vsh; lsc[c] = (1.f + vsc) * g[c];
        }
        __syncthreads();
        f32x4 vn[4];
        if (r + wave < e) { const int row0 = r + wave; const float* xr = (row0 < TP) ? xp + (size_t)row0 * DM : xs + (size_t)(row0 - TP) * DM;
#pragma unroll
            for (int j = 0; j < 4; ++j) vn[j] = FROM_PART ? __builtin_nontemporal_load((const f32x4*)(xr + 4 * lane + 256 * j)) : *(const f32x4*)(xr + 4 * lane + 256 * j); }
        for (int row = r + wave; row < e; row += 8) {
            f32x4 v[4]; float s = 0.f;
#pragma unroll
            for (int j = 0; j < 4; ++j) { v[j] = vn[j]; s += (v[j][0] * v[j][0] + v[j][1] * v[j][1]) + (v[j][2] * v[j][2] + v[j][3] * v[j][3]); }
            if (row + 8 < e) { const int rn = row + 8; const float* xr = (rn < TP) ? xp + (size_t)rn * DM : xs + (size_t)(rn - TP) * DM;
#pragma unroll
                for (int j = 0; j < 4; ++j) vn[j] = FROM_PART ? __builtin_nontemporal_load((const f32x4*)(xr + 4 * lane + 256 * j)) : *(const f32x4*)(xr + 4 * lane + 256 * j); }
            const float rstd = rsqrtf(wave_sum(s) * (1.f / DM) + EPS);
#pragma unroll
            for (int j = 0; j < 4; ++j) { const int c = 4 * lane + 256 * j; const f32x4 a = *(const LAS f32x4*)(lsc + c), b = *(const LAS f32x4*)(lsh + c);
                v2u o; o.x = cvt_pk_bf16(v[j][0] * rstd * a[0] + b[0], v[j][1] * rstd * a[1] + b[1]); o.y = cvt_pk_bf16(v[j][2] * rstd * a[2] + b[2], v[j][3] * rstd * a[3] + b[3]);
                *(v2u*)(H + (size_t)row * DM + c) = o; }
        }
        r = e;
    }
    __syncthreads();
}

#define EPI_ROWS_BEGIN \
    _Pragma("unroll") for (int ai = 0; ai < 2; ++ai) _Pragma("unroll") for (int m = 0; m < 4; ++m) { \
        const int row = u.pm * 256 + ai * 128 + wr * 64 + m * 16 + fr; float a[8], b[8]; \
        _Pragma("unroll") for (int e = 0; e < 4; ++e) { a[e] = acc[ai][0][m][0][e]; a[4 + e] = acc[ai][0][m][1][e]; b[e] = acc[ai][1][m][0][e]; b[4 + e] = acc[ai][1][m][1][e]; }
#define EPI_ROWS_END }

#define EPI_LOADROW(AI, M) { _Pragma("unroll") for (int e = 0; e < 4; ++e) { a[e] = acc[AI][0][M][0][e]; a[4 + e] = acc[AI][0][M][1][e]; b[e] = acc[AI][1][M][0][e]; b[4 + e] = acc[AI][1][M][1][e]; } }
#define EPI_ROWS_LOOP_BEGIN \
    _Pragma("unroll 1") for (int rr = 0; rr < 8; ++rr) { \
        const int row = u.pm * 256 + (rr >> 2) * 128 + wr * 64 + (rr & 3) * 16 + fr; float a[8], b[8]; \
        switch (rr) { case 0: EPI_LOADROW(0, 0) break; case 1: EPI_LOADROW(0, 1) break; case 2: EPI_LOADROW(0, 2) break; case 3: EPI_LOADROW(0, 3) break; \
                      case 4: EPI_LOADROW(1, 0) break; case 5: EPI_LOADROW(1, 1) break; case 6: EPI_LOADROW(1, 2) break; default: EPI_LOADROW(1, 3) break; }

struct EpiIn {
    static constexpr bool PERM = true, AFTER_DRAIN = false;
    bf16 *Q, *KP, *KS, *VTP, *VTS, *QI, *KIP, *KIS, *Z, *XBC; float *WI, *DT, *out; const float *gq, *gk, *dtb, *rope;
    __device__ __forceinline__ void operator()(const f32x4 (&acc)[2][2][4][2], const pg8::Unit& u, int wr, int wc, int fr, int fq) const {
        const int pn = u.pn;
        if (pn == 8 && wc >= 2) return;
        EPI_ROWS_LOOP_BEGIN
            const bool isS = row >= TP; int sb, t, pos;
            if (!isS) { sb = row >> 11; t = row & 2047; pos = t; } else { const int s = row - TP; sb = s >> 6; t = s & 63; pos = PAST + t; }
            if (pn >= 17) {
                const int col = 256 * (pn - 17) + 32 * wc + 8 * fq;
                *(v4u*)(XBC + (size_t)row * CONVC + col) = pack8(a); *(v4u*)(XBC + (size_t)row * CONVC + col + 128) = pack8(b);
                const int L = isS ? DSEQ : SEQ;
                if (t >= L - 3) { float* o = out + (isS ? O_CONVS : O_CONVP) + (size_t)(sb * 3 + (t - (L - 3))) * CONVC + col;
                    __builtin_nontemporal_store((f32x4){a[0], a[1], a[2], a[3]}, (f32x4*)(o)); __builtin_nontemporal_store((f32x4){a[4], a[5], a[6], a[7]}, (f32x4*)(o + 4));
                    __builtin_nontemporal_store((f32x4){b[0], b[1], b[2], b[3]}, (f32x4*)(o + 128)); __builtin_nontemporal_store((f32x4){b[4], b[5], b[6], b[7]}, (f32x4*)(o + 132)); }
            } else if (pn >= 9) {
                const int col = 256 * (pn - 9) + 32 * wc + 8 * fq;
#pragma unroll
                for (int e = 0; e < 8; ++e) { a[e] = silu_f(a[e]); b[e] = silu_f(b[e]); }
                *(v4u*)(Z + (size_t)row * DINNER + col) = pack8(a); *(v4u*)(Z + (size_t)row * DINNER + col + 128) = pack8(b);
            } else if (pn == 8 && wc == 1) {
                if (fq == 0) { float* w = WI + (size_t)row * 8; const float sc = 0.35355339059327373f * 0.125f;
                    *(f32x4*)w = (f32x4){a[0] * sc, a[1] * sc, a[2] * sc, a[3] * sc}; *(f32x4*)(w + 4) = (f32x4){a[4] * sc, a[5] * sc, a[6] * sc, a[7] * sc}; }
                float d[8];
#pragma unroll
                for (int e = 0; e < 8; ++e) { const float x = b[e] + dtb[8 * fq + e]; d[e] = x > 20.f ? x : log1pf(__expf(x)); }
                float* o = DT + (size_t)row * 32 + 8 * fq; *(f32x4*)o = (f32x4){d[0], d[1], d[2], d[3]}; __builtin_nontemporal_store((f32x4){d[4], d[5], d[6], d[7]}, (f32x4*)(o + 4));
            } else if (pn == 5) {
                float* o = out + (isS ? O_VS + ((size_t)(row - TP) * 4 + wc) * 64 : O_VP + ((size_t)row * 4 + wc) * 64) + 8 * fq;
                __builtin_nontemporal_store((f32x4){a[0], a[1], a[2], a[3]}, (f32x4*)(o)); __builtin_nontemporal_store((f32x4){a[4], a[5], a[6], a[7]}, (f32x4*)(o + 4));
                __builtin_nontemporal_store((f32x4){b[0], b[1], b[2], b[3]}, (f32x4*)(o + 32)); __builtin_nontemporal_store((f32x4){b[4], b[5], b[6], b[7]}, (f32x4*)(o + 36));
                bf16* vb = (isS ? VTS + ((size_t)(sb * 4 + wc) * DSEQ + t) * 64 : VTP + ((size_t)(sb * 4 + wc) * NKP + t) * 64) + 8 * fq;
                *(v4u*)vb = pack8(a); *(v4u*)(vb + 32) = pack8(b);
            } else {
                if (pn <= 4) { float ss = 0.f;
#pragma unroll
                    for (int e = 0; e < 8; ++e) ss += a[e] * a[e] + b[e] * b[e];
                    ss += __shfl_xor(ss, 16); ss += __shfl_xor(ss, 32);
                    const float rstd = rsqrtf(ss * (1.f / 64.f) + EPS); const float* g = (pn < 4) ? gq : gk;
#pragma unroll
                    for (int e = 0; e < 8; ++e) { a[e] *= rstd * g[8 * fq + e]; b[e] *= rstd * g[32 + 8 * fq + e]; } }
                { const float* cp = rope + (size_t)pos * 32 + 8 * fq; const float* sp = cp + NKS * 32;
#pragma unroll
                  for (int e = 0; e < 8; ++e) { const float c = cp[e], s = sp[e], x1 = a[e], x2 = b[e]; a[e] = x1 * c - x2 * s; b[e] = x2 * c + x1 * s; } }
                if (pn < 4) { const float qs = 0.125f * 1.4426950408889634f;
#pragma unroll
                    for (int e = 0; e < 8; ++e) { a[e] *= qs; b[e] *= qs; }
                    bf16* q = Q + (size_t)row * DM + (4 * pn + wc) * 64 + 8 * fq; *(v4u*)q = pack8(a); *(v4u*)(q + 32) = pack8(b); }
                else if (pn == 4) {
                    float* o = out + (isS ? O_KS + ((size_t)(row - TP) * 4 + wc) * 64 : O_KP + ((size_t)row * 4 + wc) * 64) + 8 * fq;
                    __builtin_nontemporal_store((f32x4){a[0], a[1], a[2], a[3]}, (f32x4*)(o)); __builtin_nontemporal_store((f32x4){a[4], a[5], a[6], a[7]}, (f32x4*)(o + 4));
                    __builtin_nontemporal_store((f32x4){b[0], b[1], b[2], b[3]}, (f32x4*)(o + 32)); __builtin_nontemporal_store((f32x4){b[4], b[5], b[6], b[7]}, (f32x4*)(o + 36));
                    bf16* kb = (isS ? KS + ((size_t)(sb * 4 + wc) * DSEQ + t) * 64 : KP + ((size_t)(sb * 4 + wc) * NKP + t) * 64) + 8 * fq;
                    *(v4u*)kb = pack8(a); *(v4u*)(kb + 32) = pack8(b);
                } else if (pn < 8) { bf16* q = QI + (size_t)row * 512 + (4 * (pn - 6) + wc) * 64 + 8 * fq; *(v4u*)q = pack8(a); *(v4u*)(q + 32) = pack8(b); }
                else {
                    float* o = out + (isS ? O_KIS + (size_t)(row - TP) * 64 : O_KIP + (size_t)row * 64) + 8 * fq;
                    __builtin_nontemporal_store((f32x4){a[0], a[1], a[2], a[3]}, (f32x4*)(o)); __builtin_nontemporal_store((f32x4){a[4], a[5], a[6], a[7]}, (f32x4*)(o + 4));
                    __builtin_nontemporal_store((f32x4){b[0], b[1], b[2], b[3]}, (f32x4*)(o + 32)); __builtin_nontemporal_store((f32x4){b[4], b[5], b[6], b[7]}, (f32x4*)(o + 36));
                    bf16* kb = (isS ? KIS + ((size_t)sb * NKS + pos) * 64 : KIP + (size_t)row * 64) + 8 * fq;
                    *(v4u*)kb = pack8(a); *(v4u*)(kb + 32) = pack8(b);
                }
            }
        EPI_ROWS_END
    }
};

__device__ __forceinline__ void unpack8(const v4u w, float* f) {
    f[0] = __uint_as_float(w.x << 16); f[1] = __uint_as_float(w.x & 0xffff0000u); f[2] = __uint_as_float(w.y << 16); f[3] = __uint_as_float(w.y & 0xffff0000u);
    f[4] = __uint_as_float(w.z << 16); f[5] = __uint_as_float(w.z & 0xffff0000u); f[6] = __uint_as_float(w.w << 16); f[7] = __uint_as_float(w.w & 0xffff0000u);
}
__device__ __forceinline__ int mod_row(int row) { return (row < TP) ? (row >> 11) : 8 + ((row - TP) >> 6); }

struct EpiGates {
    static constexpr bool PERM = true, AFTER_DRAIN = false; bf16* G;
    __device__ __forceinline__ void operator()(const f32x4 (&acc)[2][2][4][2], const pg8::Unit& u, int wr, int wc, int fr, int fq) const {
        EPI_ROWS_BEGIN
            const int col = 256 * u.pn + 32 * wc + 8 * fq;
#pragma unroll
            for (int e = 0; e < 8; ++e) { a[e] = sigmoid_f(a[e]); b[e] = sigmoid_f(b[e]); }
            *(v4u*)(G + (size_t)row * 2048 + col) = pack8(a); *(v4u*)(G + (size_t)row * 2048 + col + 128) = pack8(b);
        EPI_ROWS_END
    }
};
struct EpiP1 {
    static constexpr bool PERM = true, AFTER_DRAIN = false; const bf16* G; bf16* P1;
    __device__ __forceinline__ void operator()(const f32x4 (&acc)[2][2][4][2], const pg8::Unit& u, int wr, int wc, int fr, int fq) const {
        EPI_ROWS_BEGIN
            const int col = 256 * u.pn + 32 * wc + 8 * fq;
            *(v4u*)(P1 + (size_t)row * DM + col) = pack8(a); *(v4u*)(P1 + (size_t)row * DM + col + 128) = pack8(b);
        EPI_ROWS_END
    }
};
struct EpiMixed {
    static constexpr bool PERM = true, AFTER_DRAIN = false; const bf16* G; const bf16* P1; bf16* MX;
    __device__ __forceinline__ void operator()(const f32x4 (&acc)[2][2][4][2], const pg8::Unit& u, int wr, int wc, int fr, int fq) const {
        EPI_ROWS_BEGIN
            const int col = 256 * u.pn + 32 * wc + 8 * fq; float g0[8], g1[8], p0[8], p1[8], h0[8], h1[8];
            unpack8(*(const v4u*)(G + (size_t)row * 2048 + 1024 + col), g0); unpack8(*(const v4u*)(G + (size_t)row * 2048 + 1024 + col + 128), g1);
            unpack8(*(const v4u*)(G + (size_t)row * 2048 + col), h0); unpack8(*(const v4u*)(G + (size_t)row * 2048 + col + 128), h1);
            unpack8(*(const v4u*)(P1 + (size_t)row * DM + col), p0); unpack8(*(const v4u*)(P1 + (size_t)row * DM + col + 128), p1);
#pragma unroll
            for (int e = 0; e < 8; ++e) { a[e] = p0[e] * h0[e] + a[e] * g0[e]; b[e] = p1[e] * h1[e] + b[e] * g1[e]; }
            *(v4u*)(MX + (size_t)row * DM + col) = pack8(a); *(v4u*)(MX + (size_t)row * DM + col + 128) = pack8(b);
        EPI_ROWS_END
    }
};
struct EpiRes {
    static constexpr bool PERM = true, AFTER_DRAIN = false; const float* xp; const float* xs; const float* MOD; int moff; float* out; bool last = false;
    __device__ __forceinline__ void operator()(const f32x4 (&acc)[2][2][4][2], const pg8::Unit& u, int wr, int wc, int fr, int fq) const {
        EPI_ROWS_BEGIN
            const int col = 256 * u.pn + 32 * wc + 8 * fq;
            const float* xr = ((row < TP) ? xp + (size_t)row * DM : xs + (size_t)(row - TP) * DM) + col;
            const float* mr = MOD + (size_t)mod_row(row) * 6144 + moff + col; float* o = out + (size_t)row * DM + col;
#pragma unroll
            for (int hh = 0; hh < 2; ++hh) { const float* v = hh ? b : a;
#pragma unroll
                for (int q = 0; q < 2; ++q) { const f32x4 x = *(const f32x4*)(xr + 128 * hh + 4 * q), g = *(const f32x4*)(mr + 128 * hh + 4 * q);
                    const f32x4 r_ = (f32x4){x[0] + g[0] * v[4 * q], x[1] + g[1] * v[4 * q + 1], x[2] + g[2] * v[4 * q + 2], x[3] + g[3] * v[4 * q + 3]};
                    if (last) __builtin_nontemporal_store(r_, (f32x4*)(o + 128 * hh + 4 * q)); else *(f32x4*)(o + 128 * hh + 4 * q) = r_; } }
        EPI_ROWS_END
    }
};
struct EpiResAdd {
    static constexpr bool PERM = true, AFTER_DRAIN = false; const float* MOD; int moff; float* out;
    __device__ __forceinline__ void operator()(const f32x4 (&acc)[2][2][4][2], const pg8::Unit& u, int wr, int wc, int fr, int fq) const {
        EPI_ROWS_BEGIN
            const int col = 256 * (u.pn & 3) + 32 * wc + 8 * fq;
            const float* mr = MOD + (size_t)mod_row(row) * 6144 + moff + col; float* o = out + (size_t)row * DM + col;
#pragma unroll
            for (int e = 0; e < 8; ++e) { unsafeAtomicAdd(o + e, mr[e] * a[e]); unsafeAtomicAdd(o + 128 + e, mr[128 + e] * b[e]); }
        EPI_ROWS_END
    }
};
struct EpiAct {
    static constexpr bool PERM = true, AFTER_DRAIN = false; bf16* ACT;
    __device__ __forceinline__ void operator()(const f32x4 (&acc)[2][2][4][2], const pg8::Unit& u, int wr, int wc, int fr, int fq) const {
        EPI_ROWS_BEGIN
            const int col = 128 * u.pn + 32 * wc + 8 * fq;
#pragma unroll
            for (int e = 0; e < 8; ++e) a[e] = silu_f(a[e]) * b[e];
            *(v4u*)(ACT + (size_t)row * DFF + col) = pack8(a);
        EPI_ROWS_END
    }
};

__device__ __forceinline__ void ynorm_phase(const Params& p, int lane, int wave, bf16* Y, const float* SSQ) {
    const float* gn = p.in[21];
    const int gw = blockIdx.x * 8 + wave, NGW = gridDim.x * 8;
    v4u yn[4]; f32x4 sn[4];
    if (gw < TT) {
#pragma unroll
        for (int j = 0; j < 4; ++j) { const int c = 8 * lane + 512 * j; yn[j] = *(const v4u*)(Y + (size_t)gw * DINNER + c); sn[j] = *(const f32x4*)(SSQ + (size_t)gw * 32 + 4 * (c >> 8)); } }
    for (int row = gw; row < TT; row += NGW) {
        v4u yc[4]; f32x4 sc4[4];
#pragma unroll
        for (int j = 0; j < 4; ++j) { yc[j] = yn[j]; sc4[j] = sn[j]; }
        if (row + NGW < TT) { const int rn = row + NGW;
#pragma unroll
            for (int j = 0; j < 4; ++j) { const int c = 8 * lane + 512 * j; yn[j] = *(const v4u*)(Y + (size_t)rn * DINNER + c); sn[j] = *(const f32x4*)(SSQ + (size_t)rn * 32 + 4 * (c >> 8)); } }
#pragma unroll
        for (int j = 0; j < 4; ++j) { const int c = 8 * lane + 512 * j;
            const f32x4 sq = sc4[j];
            const float rstd = rsqrtf(((sq[0] + sq[1]) + (sq[2] + sq[3])) * (1.f / 256.f) + EPS);
            float y[8]; unpack8(yc[j], y);
            const f32x4 g0 = *(const f32x4*)(gn + c), g1 = *(const f32x4*)(gn + c + 4);
            y[0] *= rstd * g0[0]; y[1] *= rstd * g0[1]; y[2] *= rstd * g0[2]; y[3] *= rstd * g0[3]; y[4] *= rstd * g1[0]; y[5] *= rstd * g1[1]; y[6] *= rstd * g1[2]; y[7] *= rstd * g1[3];
            *(v4u*)(Y + (size_t)row * DINNER + c) = pack8(y); }
    }
}

__device__ __forceinline__ void conv_stream(bf16* base, float (&h0)[8], float (&h1)[8], float (&h2)[8], const float* wconv, const float* bconv, int col) {
    float w[4][8], bias[8];
#pragma unroll
    for (int j = 0; j < 4; ++j) { const f32x4 w0 = *(const f32x4*)(wconv + j * CONVC + col), w1 = *(const f32x4*)(wconv + j * CONVC + col + 4);
        w[j][0] = w0[0]; w[j][1] = w0[1]; w[j][2] = w0[2]; w[j][3] = w0[3]; w[j][4] = w1[0]; w[j][5] = w1[1]; w[j][6] = w1[2]; w[j][7] = w1[3]; }
    { const f32x4 b0 = *(const f32x4*)(bconv + col), b1 = *(const f32x4*)(bconv + col + 4);
      bias[0] = b0[0]; bias[1] = b0[1]; bias[2] = b0[2]; bias[3] = b0[3]; bias[4] = b1[0]; bias[5] = b1[1]; bias[6] = b1[2]; bias[7] = b1[3]; }
    for (int r0 = 0; r0 < 64; r0 += 16) {
        v4u raw[16];
#pragma unroll
        for (int k = 0; k < 16; ++k) raw[k] = *(const v4u*)(base + (size_t)(r0 + k) * CONVC);
#pragma unroll
        for (int k = 0; k < 16; ++k) { float x[8], o[8]; unpack8(raw[k], x);
#pragma unroll
            for (int e = 0; e < 8; ++e) { o[e] = silu_f(bias[e] + w[0][e] * h0[e] + w[1][e] * h1[e] + w[2][e] * h2[e] + w[3][e] * x[e]); h0[e] = h1[e]; h1[e] = h2[e]; h2[e] = x[e]; }
            *(v4u*)(base + (size_t)(r0 + k) * CONVC) = pack8(o); }
    }
}
__device__ __forceinline__ void conv_phase(const Params& p, int tid, bf16* XBC) {
    const float* wconv = p.in[16]; const float* bconv = p.in[17];
    const int G = gridDim.x, bx = blockIdx.x;
    for (int it = bx; it < 256; it += G) {
        const int b = it >> 5, cb = it & 31, cg = tid & 15, run = tid >> 4, col = cb * 128 + cg * 8;
        bf16* base = XBC + (size_t)(b * SEQ + run * 64) * CONVC + col;
        float h0[8], h1[8], h2[8];
        if (run > 0) { unpack8(*(const v4u*)(base - 3 * CONVC), h0); unpack8(*(const v4u*)(base - 2 * CONVC), h1); unpack8(*(const v4u*)(base - CONVC), h2); }
        else {
#pragma unroll
            for (int e = 0; e < 8; ++e) { h0[e] = 0.f; h1[e] = 0.f; h2[e] = 0.f; } }
        __syncthreads();
        conv_stream(base, h0, h1, h2, wconv, bconv, col);
        __syncthreads();
    }
    for (int i = bx * 512 + tid; i < NBS * 512; i += G * 512) {
        const int b = i >> 9, col = (i & 511) * 8;
        bf16* base = XBC + (size_t)(TP + b * DSEQ) * CONVC + col;
        const float* sp = p.in[5] + (size_t)b * 3 * CONVC + col;
        float h0[8], h1[8], h2[8];
#pragma unroll
        for (int e = 0; e < 8; ++e) { h0[e] = sp[e]; h1[e] = sp[CONVC + e]; h2[e] = sp[2 * CONVC + e]; }
        conv_stream(base, h0, h1, h2, wconv, bconv, col);
    }
}

#define MFMA32(a, b, c) __builtin_amdgcn_mfma_f32_32x32x16_bf16((a), (b), (c), 0, 0, 0)
typedef short s16x4 __attribute__((ext_vector_type(4)));
#ifndef TR_SLOW
#define TR_SLOW 0
#endif
__device__ __forceinline__ bf16x8 tr_frag(const LAS bf16* tile, int pitch, int ra, int rb, int col, int lane) {
#if TR_SLOW
    bf16x8 r;
#pragma unroll
    for (int e = 0; e < 4; ++e) { r[e] = (short)tile[(ra + e) * pitch + col]; r[4 + e] = (short)tile[(rb + e) * pitch + col]; }
    return r;
#else
    const int tq = (lane & 15) >> 2, tp = lane & 3, cb = (col & ~15) + 4 * tp;
    const s16x4 lo = __builtin_amdgcn_ds_read_tr16_b64_v4i16((LAS s16x4*)(tile + (ra + tq) * pitch + cb)), hi = __builtin_amdgcn_ds_read_tr16_b64_v4i16((LAS s16x4*)(tile + (rb + tq) * pitch + cb));
    return (bf16x8){lo[0], lo[1], lo[2], lo[3], hi[0], hi[1], hi[2], hi[3]};
#endif
}
constexpr int SS_TILE = 44032, SS_XN = 0, SS_BN = 9216, SS_CN = 26624, SS_HS = 88064, SS_HSZ = 17408, SS_ACS = 122880, SS_SQ = 126976;
__device__ __forceinline__ void ssd_unit(const Params& p, LAS unsigned char* lds, int tid, int lane, int wave, bool isS, int b, int h,
                                         const bf16* XBC, const float* DT, bf16* Y, float* SSQ) {
    const int g = h >> 2, nch = isS ? 1 : 32, tok0 = isS ? TP + b * DSEQ : b * SEQ;
    const float a_h = -__expf(p.in[19][h]), d_h = p.in[20][h];
    LAS float* acs = (LAS float*)(lds + SS_ACS + wave * 512); LAS float* dtv = acs + 64;
    const int l32 = lane & 31, hf = lane >> 5, blk = (lane >> 4) & 1, tq = (lane & 15) >> 2, tp = lane & 3;
    const bool ywave = wave < 4; const int w4 = wave & 3;
    f32x16 hs0, hs1;
    float* sout = p.out + (isS ? O_SSMS : O_SSMP) + ((size_t)(b * 32 + h) * 64) * 128;
#pragma unroll
    for (int i = 0; i < 16; ++i) { hs0[i] = 0.f; hs1[i] = 0.f; }
    if (isS && !ywave) { const float* s0 = p.in[6] + ((size_t)(b * 32 + h) * 64) * 128;
#pragma unroll
        for (int i = 0; i < 16; ++i) { const int pr = 8 * (i >> 2) + 4 * hf + (i & 3); hs0[i] = s0[(size_t)pr * 128 + 32 * w4 + l32]; hs1[i] = s0[(size_t)(32 + pr) * 128 + 32 * w4 + l32]; } }
    int soff[5]; int goff[5];
#pragma unroll
    for (int k = 0; k < 5; ++k) { const int pc = tid + 512 * k;
        if (pc < 512) { const int r = pc >> 3, s8 = pc & 7; soff[k] = SS_XN + (r * 72 + 8 * s8) * 2; goff[k] = r * CONVC + h * 64 + 8 * s8; }
        else if (pc < 1536) { const int q = pc - 512, r = q >> 4, s8 = q & 15; soff[k] = SS_BN + (r * 136 + 8 * s8) * 2; goff[k] = r * CONVC + 2048 + g * 128 + 8 * s8; }
        else { const int q = pc - 1536, r = q >> 4, s8 = q & 15; soff[k] = SS_CN + (r * 136 + 8 * s8) * 2; goff[k] = r * CONVC + 3072 + g * 128 + 8 * s8; } }
    v4u stg[5]; float dtn; v2u zn[4];
    const int pt = wave >> 1, it = wave & 1, irow = 32 * it + l32;
#pragma unroll
    for (int k = 0; k < 5; ++k) stg[k] = *(const v4u*)(XBC + (size_t)tok0 * CONVC + goff[k]);
    dtn = DT[(size_t)(tok0 + lane) * 32 + h];
    if (ywave) {
#pragma unroll
        for (int q = 0; q < 4; ++q) zn[q] = *(const v2u*)(Y + (size_t)(tok0 + irow) * DINNER + h * 64 + 32 * pt + 8 * q + 4 * hf); }
#pragma unroll
    for (int k = 0; k < 5; ++k) *(LAS v4u*)(lds + soff[k]) = stg[k];
    if (!ywave) { LAS bf16* Hs = (LAS bf16*)(lds + SS_HS);
#pragma unroll
        for (int i = 0; i < 16; ++i) { const int pr = 8 * (i >> 2) + 4 * hf + (i & 3);
            Hs[pr * 136 + 32 * w4 + l32] = (bf16)(cvt_pk_bf16(hs0[i], 0.f) & 0xffffu); Hs[(32 + pr) * 136 + 32 * w4 + l32] = (bf16)(cvt_pk_bf16(hs1[i], 0.f) & 0xffffu); } }
    __syncthreads();
    for (int c = 0; c < nch; ++c) {
        const int tokc = tok0 + 64 * c, buf = c & 1;
        LAS unsigned char* tb = lds + buf * SS_TILE;
        const LAS bf16* Xn = (const LAS bf16*)(tb + SS_XN); const LAS bf16* Bn = (const LAS bf16*)(tb + SS_BN); const LAS bf16* Cn = (const LAS bf16*)(tb + SS_CN);
        const LAS bf16* Hs = (const LAS bf16*)(lds + SS_HS + buf * SS_HSZ);
        const float dtc = dtn; float av = dtc * a_h;
        av += __int_as_float(__builtin_amdgcn_update_dpp(0, __float_as_int(av), 0x111, 0xf, 0xf, true));
        av += __int_as_float(__builtin_amdgcn_update_dpp(0, __float_as_int(av), 0x112, 0xf, 0xf, true));
        av += __int_as_float(__builtin_amdgcn_update_dpp(0, __float_as_int(av), 0x114, 0xf, 0xf, true));
        av += __int_as_float(__builtin_amdgcn_update_dpp(0, __float_as_int(av), 0x118, 0xf, 0xf, true));
        { const float t0 = __int_as_float(__builtin_amdgcn_readlane(__float_as_int(av), 15)), t1 = __int_as_float(__builtin_amdgcn_readlane(__float_as_int(av), 31)), t2 = __int_as_float(__builtin_amdgcn_readlane(__float_as_int(av), 47));
          const int rw = lane >> 4; av += (rw == 1) ? t0 : (rw == 2) ? (t0 + t1) : (rw == 3) ? ((t0 + t1) + t2) : 0.f; }
        acs[lane] = av; dtv[lane] = dtc;
        const v2u zc0 = zn[0], zc1 = zn[1], zc2 = zn[2], zc3 = zn[3];
        const bool more = (c + 1 < nch);
        if (more) {
#pragma unroll
            for (int k = 0; k < 5; ++k) stg[k] = *(const v4u*)(XBC + (size_t)(tokc + 64) * CONVC + goff[k]);
            dtn = DT[(size_t)(tokc + 64 + lane) * 32 + h];
            if (ywave) {
#pragma unroll
                for (int q = 0; q < 4; ++q) zn[q] = *(const v2u*)(Y + (size_t)(tokc + 64 + irow) * DINNER + h * 64 + 32 * pt + 8 * q + 4 * hf); }
        }
        if (ywave) {
            const int prow = 32 * pt + l32;
            f32x16 yo;
#pragma unroll
            for (int i = 0; i < 16; ++i) yo[i] = 0.f;
#pragma unroll
            for (int ks = 0; ks < 8; ++ks) { const bf16x8 av8 = *(const LAS bf16x8*)(Hs + prow * 136 + 16 * ks + 8 * hf), bv8 = *(const LAS bf16x8*)(Cn + irow * 136 + 16 * ks + 8 * hf); yo = MFMA32(av8, bv8, yo); }
            const float ai = acs[irow]; const float ei = __expf(ai);
#pragma unroll
            for (int i = 0; i < 16; ++i) yo[i] *= ei;
            for (int jt = 0; jt <= it; ++jt) {
                f32x16 s;
#pragma unroll
                for (int i = 0; i < 16; ++i) s[i] = 0.f;
#pragma unroll
                for (int ks = 0; ks < 8; ++ks) { const bf16x8 av8 = *(const LAS bf16x8*)(Bn + (32 * jt + l32) * 136 + 16 * ks + 8 * hf), bv8 = *(const LAS bf16x8*)(Cn + irow * 136 + 16 * ks + 8 * hf); s = MFMA32(av8, bv8, s); }
                float mv[16];
#pragma unroll
                for (int i = 0; i < 16; ++i) { const int j = 32 * jt + 8 * (i >> 2) + 4 * hf + (i & 3); mv[i] = (j <= irow) ? s[i] * __expf(ai - acs[j]) * dtv[j] : 0.f; }
#pragma unroll
                for (int jj = 0; jj < 2; ++jj) {
                    const v4u pk = pack8(mv + 8 * jj); bf16x8 bv8; __builtin_memcpy(&bv8, &pk, 16);
                    const int ja = 32 * jt + 16 * jj + 4 * hf;
                    const bf16x8 av8 = tr_frag(Xn, 72, ja, ja + 8, 32 * pt + l32, lane);
                    yo = MFMA32(av8, bv8, yo);
                }
            }
            float sq = 0.f; bf16* zp = Y + (size_t)(tokc + irow) * DINNER + h * 64 + 32 * pt + 4 * hf;
#pragma unroll
            for (int q = 0; q < 4; ++q) { const int p4 = 32 * pt + 8 * q + 4 * hf;
                const v2u xr = *(const LAS v2u*)(Xn + irow * 72 + p4); const v2u zr = (q == 0) ? zc0 : (q == 1) ? zc1 : (q == 2) ? zc2 : zc3;
                const float x0 = bf2f(xr.x & 0xffffu), x1 = __uint_as_float(xr.x & 0xffff0000u), x2 = bf2f(xr.y & 0xffffu), x3 = __uint_as_float(xr.y & 0xffff0000u);
                const float z0 = bf2f(zr.x & 0xffffu), z1 = __uint_as_float(zr.x & 0xffff0000u), z2 = bf2f(zr.y & 0xffffu), z3 = __uint_as_float(zr.y & 0xffff0000u);
                const float y0 = (yo[4 * q] + d_h * x0) * z0, y1 = (yo[4 * q + 1] + d_h * x1) * z1, y2 = (yo[4 * q + 2] + d_h * x2) * z2, y3 = (yo[4 * q + 3] + d_h * x3) * z3;
                sq += (y0 * y0 + y1 * y1) + (y2 * y2 + y3 * y3);
                v2u o; o.x = cvt_pk_bf16(y0, y1); o.y = cvt_pk_bf16(y2, y3); *(v2u*)(zp + 8 * q) = o; }
            ((LAS float*)(lds + SS_SQ))[buf * 256 + (pt * 2 + hf) * 64 + irow] = sq;
        } else {
            const float a63 = acs[63]; const float dec = __expf(a63);
#pragma unroll
            for (int i = 0; i < 16; ++i) { hs0[i] *= dec; hs1[i] *= dec; }
#pragma unroll
            for (int ks = 0; ks < 4; ++ks) {
                const int j0 = 16 * ks + 8 * hf;
                const bf16x8 bv8 = tr_frag(Bn, 136, j0, j0 + 4, 32 * w4 + l32, lane);
                float wj[8];
#pragma unroll
                for (int e = 0; e < 8; ++e) wj[e] = __expf(a63 - acs[j0 + e]) * dtv[j0 + e];
#pragma unroll
                for (int ptt = 0; ptt < 2; ++ptt) {
                    const bf16x8 xr = tr_frag(Xn, 72, j0, j0 + 4, 32 * ptt + l32, lane);
                    v4u xu; __builtin_memcpy(&xu, &xr, 16); float xf[8]; unpack8(xu, xf);
#pragma unroll
                    for (int e = 0; e < 8; ++e) xf[e] *= wj[e];
                    const v4u xp = pack8(xf); bf16x8 av8; __builtin_memcpy(&av8, &xp, 16);
                    if (ptt == 0) hs0 = MFMA32(av8, bv8, hs0); else hs1 = MFMA32(av8, bv8, hs1);
                }
            }
            if (more) { LAS bf16* Hn = (LAS bf16*)(lds + SS_HS + (buf ^ 1) * SS_HSZ);
#pragma unroll
                for (int i = 0; i < 16; ++i) { const int pr = 8 * (i >> 2) + 4 * hf + (i & 3);
                    Hn[pr * 136 + 32 * w4 + l32] = (bf16)(cvt_pk_bf16(hs0[i], 0.f) & 0xffffu); Hn[(32 + pr) * 136 + 32 * w4 + l32] = (bf16)(cvt_pk_bf16(hs1[i], 0.f) & 0xffffu); } }
        }
        if (more) {
#pragma unroll
            for (int k = 0; k < 5; ++k) *(LAS v4u*)(lds + (buf ^ 1) * SS_TILE + soff[k]) = stg[k]; }
        __syncthreads();
        if (tid < 64) { const LAS float* sq = (const LAS float*)(lds + SS_SQ) + buf * 256; SSQ[(size_t)(tokc + tid) * 32 + h] = (sq[tid] + sq[64 + tid]) + (sq[128 + tid] + sq[192 + tid]); }
    }
    if (!ywave) {
#pragma unroll
        for (int i = 0; i < 16; ++i) { const int pr = 8 * (i >> 2) + 4 * hf + (i & 3); __builtin_nontemporal_store(hs0[i], sout + (size_t)pr * 128 + 32 * w4 + l32); __builtin_nontemporal_store(hs1[i], sout + (size_t)(32 + pr) * 128 + 32 * w4 + l32); } }
    __syncthreads();
}

constexpr int SCW = 2116;
__device__ __forceinline__ unsigned sortable(float x) { x += 0.0f; const unsigned b = __float_as_uint(x); return (b & 0x80000000u) ? ~b : (b | 0x80000000u); }
__device__ __forceinline__ void topk_unit(LAS unsigned char* lds, int tid, int lane, int wave, bool isS, int b, int qb,
                                          const bf16* QI, const bf16* KIP, const bf16* KIS, const float* WI, unsigned* MASK) {
    const int tok0 = isS ? TP + b * DSEQ + qb * 16 : b * SEQ + qb * 16;
    const int pos0 = (isS ? PAST : 0) + qb * 16, limit = ((pos0 >> 6) + 1) << 6, nslots = limit >> 6, ntile = limit >> 4;
    const bf16* KI = isS ? KIS + (size_t)b * NKS * 64 : KIP + (size_t)b * NKP * 64;
    LAS float* sc = (LAS float*)lds;
    const int l16 = lane & 15, kg = lane >> 4;
    if (limit > 256) {
        bf16x8 qf[8][2]; float wq[8];
#pragma unroll
        for (int hd = 0; hd < 8; ++hd) {
#pragma unroll
            for (int ks = 0; ks < 2; ++ks) qf[hd][ks] = *(const bf16x8*)(QI + (size_t)(tok0 + l16) * 512 + hd * 64 + 32 * ks + 8 * kg);
            wq[hd] = WI[(size_t)(tok0 + l16) * 8 + hd]; }
        for (int kt = wave; kt < ntile; kt += 8) {
            const bf16x8 a0 = *(const bf16x8*)(KI + (size_t)(16 * kt + l16) * 64 + 8 * kg), a1 = *(const bf16x8*)(KI + (size_t)(16 * kt + l16) * 64 + 32 + 8 * kg);
            f32x4 s = (f32x4){0.f, 0.f, 0.f, 0.f};
#pragma unroll
            for (int hd = 0; hd < 8; ++hd) { f32x4 c = (f32x4){0.f, 0.f, 0.f, 0.f};
                c = __builtin_amdgcn_mfma_f32_16x16x32_bf16(a0, qf[hd][0], c, 0, 0, 0); c = __builtin_amdgcn_mfma_f32_16x16x32_bf16(a1, qf[hd][1], c, 0, 0, 0);
#pragma unroll
                for (int i = 0; i < 4; ++i) s[i] += wq[hd] * fmaxf(c[i], 0.f); }
            *(LAS f32x4*)(sc + l16 * SCW + 16 * kt + 4 * kg) = s;
        }
    }
    __syncthreads();
    for (int qq = 0; qq < 2; ++qq) {
        const int q = 2 * wave + qq; unsigned* mrow = MASK + (size_t)(tok0 + q) * MASKW;
        if (limit <= 256) {
            if (lane < 33) { const unsigned v = (lane < nslots) ? 0xffffffffu : 0u; mrow[2 * lane] = v; mrow[2 * lane + 1] = v; }
            continue;
        }
        unsigned u[33];
#pragma unroll
        for (int j = 0; j < 33; ++j) u[j] = (j < nslots) ? sortable(sc[q * SCW + 64 * j + lane]) : 0u;
        const int ng = (nslots + 10) / 11;
#define CNT_GE(dst, val) do { int _c = 0; \
            _Pragma("unroll") for (int j = 0; j < 11; ++j) _c += __popcll(__ballot(u[j] >= (val))); \
            if (ng > 1) { _Pragma("unroll") for (int j = 11; j < 22; ++j) _c += __popcll(__ballot(u[j] >= (val))); } \
            if (ng > 2) { _Pragma("unroll") for (int j = 22; j < 33; ++j) _c += __popcll(__ballot(u[j] >= (val))); } \
            dst = _c; } while (0)
        unsigned thr = 0u; bool exact = false;
        for (int bit = 31; bit >= 0; --bit) { const unsigned cand = thr | (1u << bit); int cnt; CNT_GE(cnt, cand);
            if (cnt >= 256) thr = cand;
            if (cnt == 256) { exact = true; break; } }
        int rem = 0;
        if (!exact) { int cgt; CNT_GE(cgt, thr + 1u); rem = 256 - cgt; }
#pragma unroll
        for (int j = 0; j < 33; ++j) {
            unsigned long long wv;
            if (exact) wv = __ballot(u[j] >= thr);
            else { const unsigned long long gt = __ballot(u[j] > thr); unsigned long long eq = __ballot(u[j] == thr), sel = 0ull;
                const int pe = __popcll(eq);
                if (pe <= rem) { sel = eq; rem -= pe; }
                else { while (rem > 0) { const unsigned long long low = eq & (0ull - eq); sel |= low; eq ^= low; --rem; } }
                wv = gt | sel; }
            if (lane == 0) { mrow[2 * j] = (unsigned)wv; mrow[2 * j + 1] = (unsigned)(wv >> 32); }
        }
#undef CNT_GE
    }
    __syncthreads();
}

constexpr int AT_K = 0, AT_V = 18432, AT_M = 59392, AT_VP = 160, AT_VSZ = 64 * AT_VP;
__device__ __forceinline__ void attn_unit(LAS unsigned char* lds, int tid, int lane, int wave, bool isS, int b, int c, int kvh,
                                          bf16* Q, const bf16* KP, const bf16* KSn, const bf16* VP, const bf16* VSn, const float* CK, const float* CV, const unsigned* MASK) {
    const int tok0 = isS ? TP + b * DSEQ : b * SEQ + 64 * c;
    const int limit = isS ? NKS : 64 * (c + 1), nt = limit >> 6;
    const bf16* Kb = isS ? KSn + (size_t)(b * 4 + kvh) * DSEQ * 64 : KP + (size_t)(b * 4 + kvh) * NKP * 64;
    const bf16* Vb = isS ? VSn + (size_t)(b * 4 + kvh) * DSEQ * 64 : VP + (size_t)(b * 4 + kvh) * NKP * 64;
    const float* Kc = CK + ((size_t)b * PAST * 4 + kvh) * 64; const float* Vc32 = CV + ((size_t)b * PAST * 4 + kvh) * 64;
    LAS bf16* Kt = (LAS bf16*)(lds + AT_K); LAS bf16* Vt = (LAS bf16*)(lds + AT_V); LAS unsigned* MK = (LAS unsigned*)(lds + AT_M);
    const int l32 = lane & 31, hf = lane >> 5, r = 32 * wave + l32, tl = r >> 2, gq = r & 3;
    bf16* qp = Q + (size_t)(tok0 + tl) * DM + (kvh * 4 + gq) * 64;
    bf16x8 qf[4];
#pragma unroll
    for (int ks = 0; ks < 4; ++ks) qf[ks] = *(const bf16x8*)(qp + hf * 32 + 8 * ks);
    const int srow = tid >> 3, sseg = tid & 7;
    v4u kr0, kr1, vr0, vr1;
#define AT_LOAD(kt_) do { if (isS && (kt_) < 32) { const float* kp_ = Kc + (size_t)(64 * (kt_) + srow) * 256 + 8 * sseg; const float* vp_ = Vc32 + (size_t)(64 * (kt_) + srow) * 256 + 8 * sseg; \
            kr0 = __builtin_nontemporal_load((const v4u*)kp_); kr1 = __builtin_nontemporal_load((const v4u*)(kp_ + 4)); vr0 = __builtin_nontemporal_load((const v4u*)vp_); vr1 = __builtin_nontemporal_load((const v4u*)(vp_ + 4)); } \
        else { const int kk_ = isS ? srow : 64 * (kt_) + srow; kr0 = *(const v4u*)(Kb + (size_t)kk_ * 64 + 8 * sseg); vr0 = *(const v4u*)(Vb + (size_t)kk_ * 64 + 8 * sseg); } } while (0)
#define AT_STORE(kt_, buf_) do { v4u ko_ = kr0, vo_ = vr0; \
        if (isS && (kt_) < 32) { ko_.x = cvt_pk_bf16(__uint_as_float(kr0.x), __uint_as_float(kr0.y)); ko_.y = cvt_pk_bf16(__uint_as_float(kr0.z), __uint_as_float(kr0.w)); ko_.z = cvt_pk_bf16(__uint_as_float(kr1.x), __uint_as_float(kr1.y)); ko_.w = cvt_pk_bf16(__uint_as_float(kr1.z), __uint_as_float(kr1.w)); \
            vo_.x = cvt_pk_bf16(__uint_as_float(vr0.x), __uint_as_float(vr0.y)); vo_.y = cvt_pk_bf16(__uint_as_float(vr0.z), __uint_as_float(vr0.w)); vo_.z = cvt_pk_bf16(__uint_as_float(vr1.x), __uint_as_float(vr1.y)); vo_.w = cvt_pk_bf16(__uint_as_float(vr1.z), __uint_as_float(vr1.w)); } \
        *(LAS v4u*)(Kt + (buf_) * 4608 + srow * 72 + 8 * sseg) = ko_; *(LAS v4u*)(Vt + (buf_) * AT_VSZ + srow * AT_VP + 8 * sseg) = vo_; } while (0)
    AT_LOAD(0);
    for (int i = tid; i < 64 * MASKW; i += 512) MK[i] = MASK[(size_t)tok0 * MASKW + i];
    AT_STORE(0, 0);
    __syncthreads();
    f32x16 o0, o1;
#pragma unroll
    for (int i = 0; i < 16; ++i) { o0[i] = 0.f; o1[i] = 0.f; }
    float lpart = 0.f;
    for (int kt = 0; kt < nt; ++kt) {
        const int buf = kt & 1;
        if (kt + 1 < nt) AT_LOAD(kt + 1);
        const LAS bf16* Kc2 = Kt + buf * 4608; const LAS bf16* Vc = Vt + buf * AT_VSZ;
        f32x16 s0, s1;
#pragma unroll
        for (int i = 0; i < 16; ++i) { s0[i] = 0.f; s1[i] = 0.f; }
#pragma unroll
        for (int ks = 0; ks < 4; ++ks) { const bf16x8 a0 = *(const LAS bf16x8*)(Kc2 + l32 * 72 + hf * 32 + 8 * ks), a1 = *(const LAS bf16x8*)(Kc2 + (32 + l32) * 72 + hf * 32 + 8 * ks);
            s0 = MFMA32(a0, qf[ks], s0); s1 = MFMA32(a1, qf[ks], s1); }
        const unsigned w0 = MK[tl * MASKW + 2 * kt] >> (4 * hf), w1 = MK[tl * MASKW + 2 * kt + 1] >> (4 * hf);
        float p0[16], p1[16], ls = 0.f;
#pragma unroll
        for (int i = 0; i < 16; ++i) { const int bp = 8 * (i >> 2) + (i & 3);
            p0[i] = ((w0 >> bp) & 1u) ? __builtin_amdgcn_exp2f(s0[i]) : 0.f; p1[i] = ((w1 >> bp) & 1u) ? __builtin_amdgcn_exp2f(s1[i]) : 0.f; ls += p0[i] + p1[i]; }
        lpart += ls;
#pragma unroll
        for (int sub = 0; sub < 2; ++sub)
#pragma unroll
            for (int jj = 0; jj < 2; ++jj) {
                const v4u pk = pack8((sub ? p1 : p0) + 8 * jj); bf16x8 bv; __builtin_memcpy(&bv, &pk, 16);
                const int ja = 32 * sub + 16 * jj + 4 * hf;
                const bf16x8 av0 = tr_frag(Vc, AT_VP, ja, ja + 8, l32, lane), av1 = tr_frag(Vc, AT_VP, ja, ja + 8, 32 + l32, lane);
                o0 = MFMA32(av0, bv, o0); o1 = MFMA32(av1, bv, o1);
            }
        if (kt + 1 < nt) AT_STORE(kt + 1, buf ^ 1);
        __syncthreads();
    }
#undef AT_LOAD
#undef AT_STORE
    const float lt = lpart + __shfl_xor(lpart, 32), inv = 1.f / lt;
#pragma unroll
    for (int q = 0; q < 4; ++q) {
        v2u a; a.x = cvt_pk_bf16(o0[4 * q] * inv, o0[4 * q + 1] * inv); a.y = cvt_pk_bf16(o0[4 * q + 2] * inv, o0[4 * q + 3] * inv); *(v2u*)(qp + 8 * q + 4 * hf) = a;
        v2u c2; c2.x = cvt_pk_bf16(o1[4 * q] * inv, o1[4 * q + 1] * inv); c2.y = cvt_pk_bf16(o1[4 * q + 2] * inv, o1[4 * q + 3] * inv); *(v2u*)(qp + 32 + 8 * q + 4 * hf) = c2;
    }
    __syncthreads();
}
constexpr int NPHASES = 12;

#ifdef NOSSD
#define SSDCALL(...) (void)0
#else
#define SSDCALL ssd_unit
#endif
#ifdef NOATT
#define ATTCALL(...) (void)0
#else
#define ATTCALL attn_unit
#endif
#define XB_TMO      128
#define XB_XCNT(j)  (256  + 64 * (j))
#define XB_XSUB(j)  (1280 + 64 * (j))
#define XB_XGEN(j)  (2304 + 64 * (j))
#define XB_TOP      3328
#define XB_TOPGEN   3392
#define XCD_BAR_WORDS 3456
#define XB_SPIN_CAP (1u << 18)

__device__ __forceinline__ unsigned xb_ld(unsigned* p)              { return __hip_atomic_load(p, __ATOMIC_RELAXED, __HIP_MEMORY_SCOPE_AGENT); }
__device__ __forceinline__ unsigned xb_add(unsigned* p, unsigned v) { return __hip_atomic_fetch_add(p, v, __ATOMIC_RELAXED, __HIP_MEMORY_SCOPE_AGENT); }
__device__ __forceinline__ unsigned xb_xcc_id() { return (unsigned)__builtin_amdgcn_s_getreg((3 << 11) | 20) & 0xFu; }
#define XB_SPIN(cond, bar) do { unsigned _sp = 0; while (cond) { __builtin_amdgcn_s_sleep(1); \
    if ((++_sp & 255u) == 0u) { if (xb_ld(&(bar)[XB_TMO])) break; if (_sp > XB_SPIN_CAP) { atomicAdd(&(bar)[XB_TMO], 1u); break; } } } } while (0)

struct XcdBarrier {
    unsigned* bar; unsigned x;
    volatile LAS unsigned* st;
};

__device__ __forceinline__ XcdBarrier xcd_barrier_post(unsigned* bar, volatile LAS unsigned* st) {
    XcdBarrier b; b.bar = bar; b.x = xb_xcc_id(); b.st = st;
    if (threadIdx.x == 0) (void)xb_add(&bar[XB_XCNT(b.x)], 1u);
    return b;
}
__device__ __forceinline__ void xcd_barrier_complete(unsigned* bar, unsigned x, unsigned& nloc, unsigned& nx) {
    const unsigned G = gridDim.x * gridDim.y * gridDim.z;
    unsigned sum, cnt, mine, sp = 0u;
    for (;;) {
        sum = 0u; cnt = 0u; mine = 0u;
#pragma unroll
        for (unsigned j = 0; j < 16; ++j) { const unsigned c = xb_ld(&bar[XB_XCNT(j)]); sum += c; cnt += (c > 0u) ? 1u : 0u; mine = (j == x) ? c : mine; }
        if (sum == G) break;
        __builtin_amdgcn_s_sleep(1);
        if ((++sp & 255u) == 0u) { if (xb_ld(&bar[XB_TMO])) break; if (sp > XB_SPIN_CAP) { atomicAdd(&bar[XB_TMO], 1u); break; } }
    }
    nloc = mine > 0u ? mine : 1u; nx = cnt > 0u ? cnt : 1u;
}

__device__ __forceinline__ void xcd_barrier(const XcdBarrier& b) {
    asm volatile("s_waitcnt vmcnt(0)" ::: "memory");
    __syncthreads();
    if (threadIdx.x == 0) {
        unsigned* bar = b.bar;
        __builtin_amdgcn_s_waitcnt(0);
        unsigned nloc = b.st[0], nx = b.st[1];
        if (nloc == 0u) { xcd_barrier_complete(bar, b.x, nloc, nx); b.st[0] = nloc; b.st[1] = nx; }
        const unsigned old = xb_add(&bar[XB_XSUB(b.x)], 1u);
        const unsigned gen = old / nloc;
        if (old + 1u == (gen + 1u) * nloc) {
            __builtin_amdgcn_fence(__ATOMIC_RELEASE, "agent");
            asm volatile("s_waitcnt vmcnt(0)" ::: "memory");
            const unsigned og = xb_add(&bar[XB_TOP], 1u);
            const unsigned tg = og / nx;
            if (og + 1u == (tg + 1u) * nx) xb_add(&bar[XB_TOPGEN], 1u);
            else XB_SPIN(xb_ld(&bar[XB_TOPGEN]) == tg, bar);
            __builtin_amdgcn_fence(__ATOMIC_ACQUIRE, "agent");
            xb_add(&bar[XB_XGEN(b.x)], 1u);
            asm volatile("s_waitcnt vmcnt(0)" ::: "memory");
        } else {
            XB_SPIN(xb_ld(&bar[XB_XGEN(b.x)]) == gen, bar);
            __builtin_amdgcn_fence(__ATOMIC_ACQUIRE, "agent");
            asm volatile("s_waitcnt vmcnt(0)" ::: "memory");
        }
    }
    __syncthreads();
}

__global__ void __launch_bounds__(512) mega(Params p) {
    extern __shared__ __attribute__((aligned(16))) unsigned char lds_raw[];
    LAS unsigned char* lds = (LAS unsigned char*)lds_raw;
    cg::grid_group grid = cg::this_grid();
    const int tid = threadIdx.x, lane = tid & 63, wave = __builtin_amdgcn_readfirstlane(tid >> 6);
    unsigned char* ws = p.ws;
#define IN(k) (p.ph_hi > (k))
#define SEAM(k) xcd_barrier(xbar)
    volatile LAS unsigned* xst = (volatile LAS unsigned*)(lds + LDS_BYTES - 16);
    if (tid < 4) xst[tid] = 0u;
    __syncthreads();
    if (p.ph_hi < 0) grid.sync();
    XcdBarrier xbar = xcd_barrier_post((unsigned*)(ws + WS_CTL), xst);
    bf16* Hb = (bf16*)(ws + WS_H);
    bf16* QIb = (bf16*)(p.out + O_SSMS); bf16* KIPb = QIb + (size_t)TT * 512; bf16* KISb = KIPb + (size_t)NBP * NKP * 64;
    bf16* Zb = (bf16*)(p.out + O_Y);

    if (IN(0)) phase0(p, lds, tid, lane, wave);
    SEAM(0);
    if (IN(1)) normmod_phase<true>(p, lds, tid, lane, wave, p.in[0], p.in[1], p.in[11], 0, 1024, Hb);
    SEAM(1);
    if (IN(2)) {
        pg8::Gemm g{Hb, (const bf16*)(ws + WS_WIN), TT, NIN, DM}; pg8::StaticOrder S; S.init(TT, NIN, gridDim.x, (int)blockIdx.x);
        EpiIn E{(bf16*)(ws + WS_Q), (bf16*)(ws + WS_KP), (bf16*)(ws + WS_KS), (bf16*)(ws + WS_VTP), (bf16*)(ws + WS_VTS), QIb, KIPb, KISb, Zb, (bf16*)(ws + WS_XBC),
                (float*)(ws + WS_WI), (float*)(ws + WS_DT), p.out, p.in[14], p.in[15], p.in[18], (const float*)(ws + WS_ROPE)};
        pg8::gemm_phase<EpiIn, pg8::StaticOrder, true, true>(lds, g, S, E);
    }
    SEAM(2);
    bf16* Qb = (bf16*)(ws + WS_Q); unsigned* MASKb = (unsigned*)(ws + WS_MASK); float* SSQb = (float*)(ws + WS_SSQ);
    bf16* GATESb = (bf16*)(ws + WS_GATES); bf16* P1b = (bf16*)(ws + WS_P1); bf16* MXb = (bf16*)(ws + WS_MIXED); bf16* ACTb = (bf16*)(ws + WS_ACT);
    const float* MODb = (const float*)(ws + WS_MOD);
    const int G = gridDim.x, bx = blockIdx.x;
    const int bxr = ((G & 7) == 0) ? ((G >> 3) - 1 - (bx >> 3)) * 8 + (bx & 7) : G - 1 - bx;
    if (IN(3)) {
        conv_phase(p, tid, (bf16*)(ws + WS_XBC));
        __syncthreads();
        for (int rd = 0; rd * G < 1152; ++rd) { const int u = rd * G + ((rd & 1) ? bxr : bx); if (u >= 1152) continue;
            bool us; int ub, uq;
            if (u < 128) { us = true; ub = u >> 2; uq = u & 3; } else { const int v = u - 128; us = false; ub = v & 7; uq = 127 - (v >> 3); }
            topk_unit(lds, tid, lane, wave, us, ub, uq, QIb, KIPb, KISb, (const float*)(ws + WS_WI), MASKb); }
    }
    SEAM(3);
    if (IN(4)) {
        for (int rd = 0; rd * G < 2432; ++rd) { const int u = rd * G + ((rd & 1) ? bxr : bx); if (u >= 2432) continue;
            int kind, ub, uc, uh; bool us;
            if (u < 256) { kind = 0; us = false; const int gi = ((u >> 5) << 3) + (u & 7); ub = gi >> 3; uh = ((gi & 7) << 2) + ((u >> 3) & 3); uc = 0; }
            else if (u < 384) { const int v = u - 256; kind = 1; us = true; ub = v >> 2; uh = v & 3; uc = 0; }
            else if (u < 1408) { const int v = u - 384, w = v & 31; kind = 1; us = false; ub = w >> 2; uh = w & 3; uc = 31 - (v >> 5); }
            else { const int v = u - 1408; kind = 0; us = true; const int gi = ((v >> 5) << 3) + (v & 7); ub = gi >> 3; uh = ((gi & 7) << 2) + ((v >> 3) & 3); uc = 0; }
            if (kind == 0) SSDCALL(p, lds, tid, lane, wave, us, ub, uh, (const bf16*)(ws + WS_XBC), (const float*)(ws + WS_DT), Zb, SSQb);
            else ATTCALL(lds, tid, lane, wave, us, ub, uc, uh, Qb, (const bf16*)(ws + WS_KP), (const bf16*)(ws + WS_KS), (const bf16*)(ws + WS_VTP), (const bf16*)(ws + WS_VTS), p.in[2], p.in[3], MASKb); }
    }
    SEAM(4);
    if (IN(5)) {
        ynorm_phase(p, lane, wave, Zb, SSQb);
        __syncthreads();
        { pg8::Gemm g{Hb, (const bf16*)(ws + WS_WG), TT, 2048, DM}; pg8::StaticOrder S; S.init(TT, 2048, G, bx);
          EpiGates E{GATESb};
          pg8::gemm_phase<EpiGates, pg8::StaticOrder, true, true>(lds, g, S, E); }
        { pg8::Gemm g{Qb, (const bf16*)(ws + WS_WBA), TT, DM, DM}; pg8::StaticOrder S; S.init(TT, DM, G, G - 1 - bx);
          EpiP1 E{GATESb, P1b};
          pg8::gemm_phase<EpiP1, pg8::StaticOrder, true, true>(lds, g, S, E); }
    }
    SEAM(5);
    if (IN(7)) {
        pg8::Gemm g{Zb, (const bf16*)(ws + WS_WBS), TT, DM, DINNER}; pg8::StaticOrder S; S.init(TT, DM, G, bx);
        EpiMixed E{GATESb, P1b, MXb};
        pg8::gemm_phase<EpiMixed, pg8::StaticOrder, true, true>(lds, g, S, E);
    }
    SEAM(7);
    if (IN(8)) {
        pg8::Gemm g{MXb, (const bf16*)(ws + WS_WOUT), TT, DM, DM}; pg8::StaticOrder S; S.init(TT, DM, G, bx);
        EpiRes E{p.in[0], p.in[1], MODb, 2048, p.out};
        pg8::gemm_phase<EpiRes, pg8::StaticOrder, true, true>(lds, g, S, E);
    }
    SEAM(8);
    if (IN(9)) normmod_phase<false>(p, lds, tid, lane, wave, p.out, p.out + (size_t)TP * DM, p.in[12], 3072, 4096, Hb);
    SEAM(9);
    if (IN(10)) {
        pg8::Gemm g{Hb, (const bf16*)(ws + WS_WGU), TT, 2 * DFF, DM}; pg8::StaticOrder S; S.init(TT, 2 * DFF, G, bx);
        EpiAct E{ACTb};
        pg8::gemm_phase<EpiAct, pg8::StaticOrder, true, true>(lds, g, S, E);
    }
    SEAM(10);
    if (IN(11)) {
        pg8::Gemm g{ACTb, (const bf16*)(ws + WS_WDN), TT, DM, DFF}; pg8::StaticOrder S; S.init(TT, DM, G, bx);
        EpiRes E{p.out, p.out + (size_t)TP * DM, MODb, 5120, p.out, true};
        pg8::gemm_phase<EpiRes, pg8::StaticOrder, true, true>(lds, g, S, E);
    }
#undef IN
#undef SEAM
}

extern "C" void kernel_launch(void* const* d_in, const int* in_sizes, int n_in, void* d_out, int out_size, void* d_ws, size_t ws_size, hipStream_t stream) {
    static int grid = 0;
    if (grid == 0) {
        if (n_in != 27 || ws_size < WS_END) { fprintf(stderr, "kernel_launch: unexpected n_in %d / ws %zu\n", n_in, ws_size); grid = -1; return; }
        int dev = 0, cus = 0, per_cu = 0;
        hipGetDevice(&dev); hipDeviceGetAttribute(&cus, hipDeviceAttributeMultiprocessorCount, dev);
        hipFuncSetAttribute((const void*)mega, hipFuncAttributeMaxDynamicSharedMemorySize, LDS_BYTES);
        hipOccupancyMaxActiveBlocksPerMultiprocessor(&per_cu, (const void*)mega, 512, LDS_BYTES);
        (void)hipGetLastError();
        if (per_cu < 1) per_cu = 1;
        grid = cus;
    }
    if (grid < 0) return;
    Params prm{};
    for (int i = 0; i < 27; ++i) prm.in[i] = (const float*)d_in[i];
    prm.out = (float*)d_out; prm.ws = (unsigned char*)d_ws; prm.ph_lo = 0; prm.ph_hi = NPHASES;
    (void)hipMemsetAsync((char*)d_ws + WS_CTL, 0, 16384, stream);
    void* args[] = {&prm};
    hipError_t e = hipLaunchCooperativeKernel((const void*)mega, dim3(grid), dim3(512), args, LDS_BYTES, stream);
    if (e != hipSuccess) fprintf(stderr, "cooperative launch failed: %s (grid %d)\n", hipGetErrorString(e), grid);
}
```
